# Optimizing an MI355X kernel written in HIP

```python
import math
import numpy as np
import jax, jax.numpy as jnp
from jax import lax

D_MODEL = 1024
BATCH = 16
SEQ = 2048
DEPTH = 2

HEAD_DIM = 64
ROT_DIM = HEAD_DIM // 4
ROPE_THETA = 500000.0
EPS = 1e-6
Q_BLOCK = 128
A_HEADS = 4
IDX_HEADS = 8
IDX_DIM = 64
INDEX_TOPK = 256
B_HEADS = 4
MOBA_BLOCK = 256
MOBA_TOPK = 3
MOBA_Q_CHUNK = 16
C_HEADS = 4
C_VDIM = 2 * HEAD_DIM
D_FF = 2816

WIDTH_A = A_HEADS * HEAD_DIM
WIDTH_B = B_HEADS * HEAD_DIM
WIDTH_C = C_HEADS * C_VDIM
MIX_WIDTH = WIDTH_A + WIDTH_B + WIDTH_C
IN_SPLITS = (A_HEADS * HEAD_DIM, HEAD_DIM, HEAD_DIM, IDX_HEADS * IDX_DIM, IDX_DIM, IDX_HEADS,
             B_HEADS * HEAD_DIM, B_HEADS * HEAD_DIM, B_HEADS * HEAD_DIM,
             C_HEADS * 2 * HEAD_DIM, C_HEADS * 2 * HEAD_DIM, C_HEADS * C_VDIM,
             D_MODEL, D_MODEL, D_MODEL)
IN_WIDTH = sum(IN_SPLITS)

kernel_name = 'hybrid_dsa_moba_diffattn_macaron'


def rmsnorm(x, g):
    xf = x.astype(jnp.float32)
    y = xf * lax.rsqrt(jnp.mean(xf * xf, axis=-1, keepdims=True) + EPS)
    return y.astype(x.dtype) * g


def rope_tables(positions):
    inv_freq = jnp.power(ROPE_THETA, -jnp.arange(0, ROT_DIM, 2, dtype=jnp.float32) / ROT_DIM)
    ang = positions.astype(jnp.float32)[..., None] * inv_freq
    return jnp.cos(ang), jnp.sin(ang)


def rope(x, cos, sin):
    shape = cos.shape[:2] + (1,) * (x.ndim - 3) + cos.shape[-1:]
    c = cos.reshape(shape).astype(x.dtype)
    s = sin.reshape(shape).astype(x.dtype)
    half = ROT_DIM // 2
    x1, x2 = x[..., :half], x[..., half:ROT_DIM]
    return jnp.concatenate([x1 * c - x2 * s, x2 * c + x1 * s, x[..., ROT_DIM:]], axis=-1)


def masked_softmax(scores, mask):
    return jax.nn.softmax(jnp.where(mask, scores.astype(jnp.float32), -jnp.inf), axis=-1)


def swiglu(h, w_gate, w_up, w_down):
    return (jax.nn.silu(h @ w_gate) * (h @ w_up)) @ w_down


def dsa_attention(q, k, v, qi, ki, wi):
    B, S = q.shape[:2]
    topk = min(INDEX_TOPK, S // 4)
    nb = S // Q_BLOCK
    s_pos = jnp.arange(S)
    b_idx = jnp.arange(B)[:, None, None]
    scale = HEAD_DIM ** -0.5

    def blk(t):
        return t.reshape((B, nb, Q_BLOCK) + t.shape[2:]).swapaxes(0, 1)

    def body(args):
        qb, qib, wib, start = args
        t = start + jnp.arange(Q_BLOCK)
        causal = s_pos[None, :] <= t[:, None]
        logits = jnp.einsum('bqhd,bsd->bqhs', qib, ki)
        iscore = jnp.einsum('bqhs,bqh->bqs', jax.nn.relu(logits).astype(jnp.float32), wib.astype(jnp.float32))
        iscore = jnp.where(causal[None], iscore, -jnp.inf)
        _, idx = lax.top_k(iscore, topk)
        k_sel = k[b_idx, idx]
        v_sel = v[b_idx, idx]
        sc = jnp.einsum('bqhd,bqkd->bhqk', qb, k_sel) * scale
        valid = (idx <= t[None, :, None])[:, None]
        p = masked_softmax(sc, valid).astype(v.dtype)
        return jnp.einsum('bhqk,bqkd->bqhd', p, v_sel)

    starts = jnp.arange(nb) * Q_BLOCK
    out = lax.map(body, (blk(q), blk(qi), blk(wi), starts))
    return out.swapaxes(0, 1).reshape(B, S, -1)


def moba_attention(q, k, v):
    B, S, H, d = q.shape
    nblk = -(-S // MOBA_BLOCK)
    pad = nblk * MOBA_BLOCK - S
    scale = d ** -0.5

    def to_blocks(t):
        t = jnp.pad(t, ((0, 0), (0, pad), (0, 0), (0, 0)))
        return t.reshape(B, nblk, MOBA_BLOCK, H, d).transpose(0, 3, 1, 2, 4)

    kbt, vbt = to_blocks(k), to_blocks(v)
    kmean = jnp.mean(kbt.astype(jnp.float32), axis=3).astype(k.dtype)
    n_sel = min(MOBA_TOPK, nblk)
    nc = S // MOBA_Q_CHUNK
    q_chunks = q.reshape(B, nc, MOBA_Q_CHUNK, H, d).transpose(1, 0, 3, 2, 4)
    b_idx = jnp.arange(B)[:, None, None, None]
    h_idx = jnp.arange(H)[None, :, None, None]
    blk_ids = jnp.arange(nblk)
    own_offsets = jnp.arange(MOBA_BLOCK)

    def body(args):
        qb, start = args
        t = start + jnp.arange(MOBA_Q_CHUNK)
        j = start // MOBA_BLOCK
        gate = jnp.einsum('bhqd,bhnd->bhqn', qb, kmean).astype(jnp.float32)
        gate = jnp.where(blk_ids < j, gate, -jnp.inf)
        _, sel = lax.top_k(gate, n_sel)
        sel_valid = sel < j
        k_sel = kbt[b_idx, h_idx, sel]
        v_sel = vbt[b_idx, h_idx, sel]
        s_sel = jnp.einsum('bhqd,bhqnkd->bhqnk', qb, k_sel) * scale
        s_sel = jnp.where(sel_valid[..., None], s_sel.astype(jnp.float32), -jnp.inf)
        s_sel = s_sel.reshape(B, H, MOBA_Q_CHUNK, n_sel * MOBA_BLOCK)
        k_own = lax.dynamic_index_in_dim(kbt, j, axis=2, keepdims=False)
        v_own = lax.dynamic_index_in_dim(vbt, j, axis=2, keepdims=False)
        s_own = jnp.einsum('bhqd,bhkd->bhqk', qb, k_own) * scale
        own_causal = (j * MOBA_BLOCK + own_offsets)[None, :] <= t[:, None]
        s_own = jnp.where(own_causal, s_own.astype(jnp.float32), -jnp.inf)
        p = jax.nn.softmax(jnp.concatenate([s_sel, s_own], axis=-1), axis=-1).astype(v.dtype)
        p_sel = p[..., :n_sel * MOBA_BLOCK].reshape(B, H, MOBA_Q_CHUNK, n_sel, MOBA_BLOCK)
        p_own = p[..., n_sel * MOBA_BLOCK:]
        return (jnp.einsum('bhqnk,bhqnkd->bhqd', p_sel, v_sel)
                + jnp.einsum('bhqk,bhkd->bhqd', p_own, v_own))

    starts = jnp.arange(nc) * MOBA_Q_CHUNK
    out = lax.map(body, (q_chunks, starts))
    return out.transpose(1, 0, 3, 2, 4).reshape(B, S, H * d)


def diff_attention(q, k, v, lam, lam_init, subln_g):
    B, S, H = q.shape[:3]
    nb = S // Q_BLOCK
    s_pos = jnp.arange(S)
    scale = HEAD_DIM ** -0.5
    q_blocks = q.reshape(B, nb, Q_BLOCK, H, 2, HEAD_DIM).swapaxes(0, 1)

    def body(args):
        qb, start = args
        t = start + jnp.arange(Q_BLOCK)
        causal = s_pos[None, :] <= t[:, None]
        sc = jnp.einsum('bqhcd,bshcd->bhcqs', qb, k) * scale
        p = masked_softmax(sc, causal)
        attn = (p[:, :, 0] - lam * p[:, :, 1]).astype(v.dtype)
        return jnp.einsum('bhqs,bshe->bqhe', attn, v)

    starts = jnp.arange(nb) * Q_BLOCK
    out = lax.map(body, (q_blocks, starts))
    out = out.swapaxes(0, 1).reshape(B, S, H, C_VDIM)
    out = rmsnorm(out, subln_g) * (1.0 - lam_init)
    return out.reshape(B, S, H * C_VDIM)


def hybrid_mixer(h, cos, sin, w_in, qk_g, lam_p, subln_g, w_branch, w_out, lam_init):
    B, S, _ = h.shape
    offsets = np.cumsum(IN_SPLITS)[:-1].tolist()
    proj = h @ w_in
    (qa, ka, va, qi, ki, wi, qb, kb, vb, qc, kc, vc, ga, gb, gc) = jnp.split(proj, offsets, axis=-1)
    qa = rope(rmsnorm(qa.reshape(B, S, A_HEADS, HEAD_DIM), qk_g[0]), cos, sin)
    ka = rope(rmsnorm(ka, qk_g[1]), cos, sin)
    qi = rope(qi.reshape(B, S, IDX_HEADS, IDX_DIM), cos, sin)
    ki = rope(ki, cos, sin)
    wi = wi * (IDX_HEADS * IDX_DIM) ** -0.5
    o_a = dsa_attention(qa, ka, va, qi, ki, wi)
    qb = rope(rmsnorm(qb.reshape(B, S, B_HEADS, HEAD_DIM), qk_g[2]), cos, sin)
    kb = rope(rmsnorm(kb.reshape(B, S, B_HEADS, HEAD_DIM), qk_g[3]), cos, sin)
    o_b = moba_attention(qb, kb, vb.reshape(B, S, B_HEADS, HEAD_DIM))
    qc = rope(rmsnorm(qc.reshape(B, S, C_HEADS, 2, HEAD_DIM), qk_g[4]), cos, sin)
    kc = rope(rmsnorm(kc.reshape(B, S, C_HEADS, 2, HEAD_DIM), qk_g[5]), cos, sin)
    lp = lam_p.astype(jnp.float32)
    lam = jnp.exp(jnp.sum(lp[0] * lp[1])) - jnp.exp(jnp.sum(lp[2] * lp[3])) + lam_init
    o_c = diff_attention(qc, kc, vc.reshape(B, S, C_HEADS, C_VDIM), lam, lam_init, subln_g)
    y_a = o_a @ w_branch[:WIDTH_A]
    y_b = o_b @ w_branch[WIDTH_A:WIDTH_A + WIDTH_B]
    y_c = o_c @ w_branch[WIDTH_A + WIDTH_B:]
    merged = jax.nn.sigmoid(ga) * y_a + jax.nn.sigmoid(gb) * y_b + jax.nn.sigmoid(gc) * y_c
    return merged @ w_out


def setup_inputs(seed: int = 0) -> dict:
    key = jax.random.key(seed)
    ks = jax.random.split(key, 14)
    x = jax.random.normal(ks[0], (BATCH, SEQ, D_MODEL), jnp.float32)
    offset = jax.random.randint(ks[1], (BATCH, 1), 0, 4096, dtype=jnp.int32)
    positions = (offset + jnp.arange(SEQ, dtype=jnp.int32)[None, :]).astype(jnp.int32)
    norm_g = 1.0 + 0.02 * jax.random.normal(ks[2], (DEPTH, 3, D_MODEL), jnp.float32)
    w_in = jax.random.normal(ks[3], (DEPTH, D_MODEL, IN_WIDTH), jnp.float32) * D_MODEL ** -0.5
    qk_norm_g = 1.0 + 0.02 * jax.random.normal(ks[4], (DEPTH, 6, HEAD_DIM), jnp.float32)
    lambda_params = 0.1 * jax.random.normal(ks[5], (DEPTH, 4, HEAD_DIM), jnp.float32)
    diff_subln_g = 1.0 + 0.02 * jax.random.normal(ks[6], (DEPTH, C_VDIM), jnp.float32)
    w_branch = jnp.concatenate([
        jax.random.normal(ks[7], (DEPTH, WIDTH_A, D_MODEL), jnp.float32) * WIDTH_A ** -0.5,
        jax.random.normal(ks[8], (DEPTH, WIDTH_B, D_MODEL), jnp.float32) * WIDTH_B ** -0.5,
        jax.random.normal(ks[9], (DEPTH, WIDTH_C, D_MODEL), jnp.float32) * WIDTH_C ** -0.5], axis=1)
    w_out = jax.random.normal(ks[10], (DEPTH, D_MODEL, D_MODEL), jnp.float32) * D_MODEL ** -0.5
    ffn_w_gate = jax.random.normal(ks[11], (DEPTH, 2, D_MODEL, D_FF), jnp.float32) * D_MODEL ** -0.5
    ffn_w_up = jax.random.normal(ks[12], (DEPTH, 2, D_MODEL, D_FF), jnp.float32) * D_MODEL ** -0.5
    ffn_w_down = jax.random.normal(ks[13], (DEPTH, 2, D_FF, D_MODEL), jnp.float32) * D_FF ** -0.5
    return {'x': x, 'positions': positions, 'norm_g': norm_g, 'w_in': w_in, 'qk_norm_g': qk_norm_g,
            'lambda_params': lambda_params, 'diff_subln_g': diff_subln_g, 'w_branch': w_branch,
            'w_out': w_out, 'ffn_w_gate': ffn_w_gate, 'ffn_w_up': ffn_w_up, 'ffn_w_down': ffn_w_down}


def reference(x, positions, norm_g, w_in, qk_norm_g, lambda_params, diff_subln_g, w_branch,
              w_out, ffn_w_gate, ffn_w_up, ffn_w_down):
    cos, sin = rope_tables(positions)
    for layer in range(DEPTH):
        lam_init = 0.8 - 0.6 * math.exp(-0.3 * layer)
        x = x + 0.5 * swiglu(rmsnorm(x, norm_g[layer, 0]), ffn_w_gate[layer, 0], ffn_w_up[layer, 0], ffn_w_down[layer, 0])
        x = x + hybrid_mixer(rmsnorm(x, norm_g[layer, 1]), cos, sin, w_in[layer], qk_norm_g[layer],
                             lambda_params[layer], diff_subln_g[layer], w_branch[layer], w_out[layer], lam_init)
        x = x + 0.5 * swiglu(rmsnorm(x, norm_g[layer, 2]), ffn_w_gate[layer, 1], ffn_w_up[layer, 1], ffn_w_down[layer, 1])
    return x
```

```cpp
#include <hip/hip_runtime.h>
#include <cstdio>
#include <cstdint>
#ifndef MK_N_LAUNCHES
#define MK_N_LAUNCHES 1
#endif
#ifndef MK_CHECKS
#define MK_CHECKS 0
#endif
__device__ __forceinline__ int fresh_tid() { int t = threadIdx.x; asm volatile("" : "+v"(t)); return t; }
#ifndef ATT_MASK
#define ATT_MASK 7
#endif
#ifndef ATT_REP
#define ATT_REP 0
#endif
#ifndef DSA_REP
#define DSA_REP 0
#endif
#ifndef DIFF_REP
#define DIFF_REP 0
#endif
namespace pg8 {
#define PG8_LAS __attribute__((address_space(3)))
typedef unsigned short bf16_t;
typedef short bf16x8 __attribute__((ext_vector_type(8)));
typedef float f32x4 __attribute__((ext_vector_type(4)));
typedef unsigned u32x4 __attribute__((ext_vector_type(4)));
constexpr int BM = 256, BK = 64, HALF = 128, HTB = HALF * BK * 2  , STAGE_BYTES = 8 * HTB, NXCD = 8, WGM = 8;

__host__ __device__ __forceinline__ int lds_byte(int r, int c) { const int st = (r >> 4) * 2 + (c >> 5), rr = r & 15, cc = c & 31, ob = rr * 64 + cc * 2; return st * 1024 + (ob ^ (((ob >> 9) & 1) << 5)); }
__host__ __device__ __forceinline__ void stage_rc(int b, int& R, int& C) { const int st = b / 1024, sb = b % 1024, swz = sb ^ (((sb >> 9) & 1) << 5); R = (st >> 1) * 16 + swz / 64; C = (st & 1) * 32 + (swz % 64) / 2; }
__host__ __device__ __forceinline__ int perm32(int rho) { const int n = rho >> 4, i = rho & 15; return 8 * (i >> 2) + 4 * n + (i & 3); }

struct Unit { int pm, pn, seg; };
struct Gemm { const bf16_t* A; const bf16_t* Bt; int M, N, K; size_t segA = 0, segB = 0; };

struct StaticOrder {
    int nM, nN, nwg, G, c;
    __host__ __device__ void init(int M, int N, int G_, int c_) { nM = M / BM; nN = N / BM; nwg = nM * nN; G = G_; c = c_; }
    __host__ __device__ bool next(int i, Unit& u) const {
        const long L = (long)i * G + c; if (L >= nwg) return false;
        int wgid = (int)L; { const int q = nwg / NXCD, r = nwg % NXCD, xcd = wgid % NXCD, off = wgid / NXCD; wgid = (xcd < r ? xcd * (q + 1) : r * (q + 1) + (xcd - r) * q) + off; }
        const int nig = WGM * nN, gid = wgid / nig, fm = gid * WGM, gsz = (nM - fm) < WGM ? (nM - fm) : WGM;
        u.pm = fm + ((wgid % nig) % gsz); u.pn = (wgid % nig) / gsz; u.seg = 0; return true;
    }
    __device__ __forceinline__ void a_ready(const Unit&) const {}
    __device__ __forceinline__ void done(const Unit&) const {}
};

__device__ __forceinline__ unsigned cvt_pk_bf16(float lo, float hi) { unsigned r; asm volatile("v_cvt_pk_bf16_f32 %0, %1, %2" : "=v"(r) : "v"(lo), "v"(hi)); return r; }
typedef float f32x2 __attribute__((ext_vector_type(2)));
typedef int i32x4 __attribute__((ext_vector_type(4)));
template <bool I8> struct MmaOp;
template <> struct MmaOp<false> { typedef f32x4 acc_t; static __device__ __forceinline__ f32x4 mma(bf16x8 b, bf16x8 a, f32x4 c) { return __builtin_amdgcn_mfma_f32_16x16x32_bf16(b, a, c, 0, 0, 0); } };
template <> struct MmaOp<true>  { typedef i32x4 acc_t; static __device__ __forceinline__ i32x4 mma(bf16x8 b, bf16x8 a, i32x4 c) { return __builtin_amdgcn_mfma_i32_16x16x64_i8(__builtin_bit_cast(i32x4, b), __builtin_bit_cast(i32x4, a), c, 0, 0, 0); } };
template <class Epi, class Sched, bool ALIGN_EPI = false, bool SP2 = false, bool I8 = false>
__device__ __forceinline__ void gemm_phase(PG8_LAS unsigned char* lds, const Gemm g, const Sched& S, const Epi& E) {
    const int tid = fresh_tid(), wid = __builtin_amdgcn_readfirstlane(tid >> 6), lane = tid & 63, wr = wid >> 2, wc = wid & 3, fr = lane & 15, fq = lane >> 4;
    const int K = g.K, nt = K / BK;
    unsigned voffA[2], voffB[2];
#pragma unroll
    for (int i = 0; i < 2; ++i) { int R, C; stage_rc(tid * 16 + i * 8192, R, C); const int Rb = Epi::PERM ? ((R & ~31) + perm32(R & 31)) : R;
        voffA[i] = (unsigned)(R * K + C) * 2u; voffB[i] = (unsigned)(Rb * K + C) * 2u; }
    const size_t kstep = (size_t)(BK * 2);
    const size_t hstep = (size_t)HALF * K * 2;
    const size_t tstep = 2 * hstep;
    const unsigned ldsw = (unsigned)wid * 1024u;
    const int aoff = lds_byte(wr * 64 + fr, fq * 8), boff = lds_byte(wc * 32 + fr, fq * 8);
#define PG8_SA(b, h) (((b) * 2 + (h)) * HTB)
#define PG8_SB(b, h) ((4 + (b) * 2 + (h)) * HTB)
#define PG8_STAGE(bufoff, gbase, voff) do { _Pragma("unroll") for (int _i = 0; _i < 2; ++_i) \
        __builtin_amdgcn_global_load_lds((const unsigned*)((const char*)(gbase) + (voff)[_i]), (PG8_LAS unsigned*)(lds + (bufoff) + ldsw + _i * 8192), 16, 0, 0); } while (0)
#define PG8_LDA(dst, b, h) do { _Pragma("unroll") for (int m = 0; m < 4; ++m) _Pragma("unroll") for (int k = 0; k < 2; ++k) dst[m][k] = *(const PG8_LAS bf16x8*)(lds + PG8_SA(b, h) + aoff + m * 2048 + k * 1024); } while (0)
#define PG8_LDB(dst, b, h) do { _Pragma("unroll") for (int n = 0; n < 2; ++n) _Pragma("unroll") for (int k = 0; k < 2; ++k) dst[n][k] = *(const PG8_LAS bf16x8*)(lds + PG8_SB(b, h) + boff + n * 2048 + k * 1024); } while (0)
#define PG8_MMA(ai, bj, At, Bt) do { __builtin_amdgcn_s_setprio(1); _Pragma("unroll") for (int m = 0; m < 4; ++m) _Pragma("unroll") for (int n = 0; n < 2; ++n) _Pragma("unroll") for (int k = 0; k < 2; ++k) \
        acc[ai][bj][m][n] = MmaOp<I8>::mma(Bt[n][k], At[m][k], acc[ai][bj][m][n]); __builtin_amdgcn_s_setprio(0); } while (0)
#define PG8_WAIT_V(n) asm volatile("s_waitcnt vmcnt(" #n ")" ::: "memory")
#define PG8_WAIT_L(n) asm volatile("s_waitcnt lgkmcnt(" #n ")" ::: "memory")
#define PG8_BAR __builtin_amdgcn_s_barrier()
#define PG8_SCHED __builtin_amdgcn_sched_barrier(0)
    Unit cur, nxt; int ui = 0;
    if (!S.next(0, cur)) return;
    typedef typename MmaOp<I8>::acc_t acc_t;
    acc_t acc[2][2][4][2];
#pragma unroll
    for (int a = 0; a < 2; ++a)
#pragma unroll
        for (int b = 0; b < 2; ++b)
#pragma unroll
            for (int m = 0; m < 4; ++m)
#pragma unroll
                for (int n = 0; n < 2; ++n) acc[a][b][m][n] = acc_t{};
    bf16x8 At[4][2], B0[2][2], B1[2][2];
    const char* cA = (const char*)g.A + (size_t)cur.pm * tstep + (size_t)cur.seg * g.segA; const char* cB = (const char*)g.Bt + (size_t)cur.pn * tstep + (size_t)cur.seg * g.segB;
    S.a_ready(cur);
    if constexpr (SP2) {
        PG8_STAGE(PG8_SB(0, 0), cB, voffB); PG8_STAGE(PG8_SB(0, 1), cB + hstep, voffB); PG8_STAGE(PG8_SA(0, 0), cA, voffA); PG8_STAGE(PG8_SA(0, 1), cA + hstep, voffA);
        if (wr == 1) PG8_BAR;
        PG8_WAIT_V(2); PG8_BAR;
        PG8_STAGE(PG8_SB(1, 0), cB + kstep, voffB); PG8_STAGE(PG8_SA(1, 0), cA + kstep, voffA); PG8_STAGE(PG8_SB(1, 1), cB + hstep + kstep, voffB);
        PG8_WAIT_V(6); PG8_BAR;
    } else {
        PG8_STAGE(PG8_SB(0, 0), cB, voffB); PG8_STAGE(PG8_SA(0, 0), cA, voffA); PG8_STAGE(PG8_SB(0, 1), cB + hstep, voffB); PG8_STAGE(PG8_SA(0, 1), cA + hstep, voffA);
        if (wr == 1) PG8_BAR;
        PG8_WAIT_V(4); PG8_BAR;
        PG8_STAGE(PG8_SB(1, 0), cB + kstep, voffB); PG8_STAGE(PG8_SA(1, 0), cA + kstep, voffA); PG8_STAGE(PG8_SB(1, 1), cB + hstep + kstep, voffB);
        PG8_WAIT_V(6); PG8_BAR;
    }
    for (;;) {
        const bool has_next = S.next(ui + 1, nxt);
        const char* nA = has_next ? (const char*)g.A + (size_t)nxt.pm * tstep + (size_t)nxt.seg * g.segA : cA; const char* nB = has_next ? (const char*)g.Bt + (size_t)nxt.pn * tstep + (size_t)nxt.seg * g.segB : cB;
        for (int t = 0; t < nt; t += 2) {
            const bool last = (t == nt - 2);
            const char* a1 = cA + (size_t)(t + 1) * kstep;
            const char* a2 = last ? nA : cA + (size_t)(t + 2) * kstep; const char* b2 = last ? nB : cB + (size_t)(t + 2) * kstep;
            const char* a3 = a2 + kstep; const char* b3 = b2 + kstep;
            if (last && has_next) S.a_ready(nxt);
            if constexpr (SP2) {
            PG8_LDB(B0, 0, 0); PG8_LDB(B1, 0, 1); PG8_SCHED; PG8_LDA(At, 0, 0); PG8_STAGE(PG8_SA(1, 1), a1 + hstep, voffA);
            PG8_WAIT_V(8); PG8_WAIT_L(0); PG8_BAR; PG8_MMA(0, 0, At, B0); PG8_MMA(0, 1, At, B1); PG8_BAR; PG8_SCHED;
            PG8_LDA(At, 0, 1); PG8_STAGE(PG8_SB(0, 0), b2, voffB); PG8_STAGE(PG8_SB(0, 1), b2 + hstep, voffB); PG8_STAGE(PG8_SA(0, 0), a2, voffA);
            PG8_WAIT_V(8); PG8_WAIT_L(0); PG8_BAR; PG8_MMA(1, 0, At, B0); PG8_MMA(1, 1, At, B1); PG8_BAR; PG8_SCHED;
            PG8_LDB(B0, 1, 0); PG8_LDB(B1, 1, 1); PG8_SCHED; PG8_LDA(At, 1, 0); PG8_STAGE(PG8_SA(0, 1), a2 + hstep, voffA);
            PG8_WAIT_V(8); PG8_WAIT_L(0); PG8_BAR; PG8_MMA(0, 0, At, B0); PG8_MMA(0, 1, At, B1); PG8_BAR; PG8_SCHED;
            PG8_LDA(At, 1, 1); PG8_STAGE(PG8_SB(1, 0), b3, voffB); PG8_STAGE(PG8_SB(1, 1), b3 + hstep, voffB); PG8_STAGE(PG8_SA(1, 0), a3, voffA);
            PG8_WAIT_V(8); PG8_WAIT_L(0); PG8_BAR; PG8_MMA(1, 0, At, B0); PG8_MMA(1, 1, At, B1); PG8_BAR; PG8_SCHED;
            } else {
            PG8_LDB(B0, 0, 0); PG8_SCHED; PG8_LDA(At, 0, 0); PG8_STAGE(PG8_SA(1, 1), a1 + hstep, voffA);
            PG8_WAIT_L(8); PG8_BAR; PG8_WAIT_L(0); PG8_MMA(0, 0, At, B0); PG8_BAR; PG8_SCHED;
            PG8_LDB(B1, 0, 1); PG8_STAGE(PG8_SB(0, 0), b2, voffB);
            PG8_BAR; PG8_WAIT_L(0); PG8_MMA(0, 1, At, B1); PG8_BAR;
            PG8_LDA(At, 0, 1); PG8_STAGE(PG8_SA(0, 0), a2, voffA);
            PG8_BAR; PG8_WAIT_L(0); PG8_MMA(1, 0, At, B0); PG8_BAR; PG8_SCHED;
            PG8_STAGE(PG8_SB(0, 1), b2 + hstep, voffB);
            PG8_WAIT_V(6); PG8_BAR; PG8_MMA(1, 1, At, B1); PG8_BAR;
            PG8_LDB(B0, 1, 0); PG8_SCHED; PG8_LDA(At, 1, 0); PG8_STAGE(PG8_SA(0, 1), a2 + hstep, voffA);
            PG8_WAIT_L(8); PG8_BAR; PG8_WAIT_L(0); PG8_MMA(0, 0, At, B0); PG8_BAR; PG8_SCHED;
            PG8_LDB(B1, 1, 1); PG8_STAGE(PG8_SB(1, 0), b3, voffB);
            PG8_BAR; PG8_WAIT_L(0); PG8_MMA(0, 1, At, B1); PG8_BAR;
            PG8_LDA(At, 1, 1); PG8_STAGE(PG8_SA(1, 0), a3, voffA);
            PG8_BAR; PG8_WAIT_L(0); PG8_MMA(1, 0, At, B0); PG8_BAR; PG8_SCHED;
            PG8_STAGE(PG8_SB(1, 1), b3 + hstep, voffB);
            PG8_WAIT_V(6); PG8_BAR; PG8_MMA(1, 1, At, B1); PG8_BAR;
            }
        }
        if constexpr (ALIGN_EPI) { if (wr == 0) PG8_BAR; }
        if constexpr (!Epi::AFTER_DRAIN) { E(acc, cur, wr, wc, fr, fq); S.done(cur); }
        if (!has_next) break;
        if (!E.keep(cur)) {
#pragma unroll
        for (int a = 0; a < 2; ++a)
#pragma unroll
            for (int b = 0; b < 2; ++b)
#pragma unroll
                for (int m = 0; m < 4; ++m)
#pragma unroll
                    for (int n = 0; n < 2; ++n) acc[a][b][m][n] = acc_t{};
        }
        cur = nxt; cA = nA; cB = nB; ++ui;
        if constexpr (ALIGN_EPI) { if (wr == 1) PG8_BAR; }
    }
    PG8_WAIT_V(0);
    if constexpr (!ALIGN_EPI) { if (wr == 0) PG8_BAR; }
    PG8_BAR;
    if constexpr (Epi::AFTER_DRAIN) { E.fused(acc, cur, wr, wc, fr, fq, lds, wid, lane); S.done(cur); }
#undef PG8_SA
#undef PG8_SB
#undef PG8_STAGE
#undef PG8_LDA
#undef PG8_LDB
#undef PG8_MMA
#undef PG8_WAIT_V
#undef PG8_WAIT_L
#undef PG8_BAR
#undef PG8_SCHED
}
}

#define LAS __attribute__((address_space(3)))
typedef unsigned short bf16_t;
typedef short bf16x8 __attribute__((ext_vector_type(8)));
typedef float f32x4 __attribute__((ext_vector_type(4)));
typedef float f32x16 __attribute__((ext_vector_type(16)));
typedef unsigned u32x4 __attribute__((ext_vector_type(4)));
typedef unsigned u32x2 __attribute__((ext_vector_type(2)));

constexpr int NB = 16, SEQ = 2048, T = NB * SEQ, D = 1024, DFF = 2816, NIN = 6344, NINP = 3328;
constexpr float EPS = 1e-6f;
constexpr float C2 = 0.125f * 1.4426950408889634f;
constexpr int NWAVES = 8, NTHREADS = 512;
constexpr int NPHASE = 23;

constexpr int CI_QA = 0, CI_KA = 256, CI_VA = 320, CI_QI = 384, CI_KI = 896, CI_WI = 960, CI_QB = 968, CI_KB = 1224, CI_VB = 1480, CI_QC = 1736, CI_KC = 2248, CI_VC = 2760, CI_G = 3272;

constexpr size_t MiB = 1u << 20;
constexpr size_t WS_CTL = 0, CTL_BYTES = 1 * MiB;
constexpr int CW_BAR = 4096;
constexpr size_t CTL_KMEAN = 65536;
constexpr size_t CTL_DIAG = 655360;
constexpr size_t CTL_CMAX = 720896;
constexpr int CMAX_PER_LAYER = 2 * 5632 + 3072 + 3328;
constexpr size_t CTL_SA = 901120;
constexpr size_t WS_ROPE = 1 * MiB;
constexpr size_t WS_W = 3 * MiB;
constexpr size_t WL_GU = 0, WL_DN = 2 * (size_t)5632 * 1024, WL_IN = WL_DN + 2 * (size_t)1024 * 2816, WL_GT = WL_IN + (size_t)NINP * 1024,
                 WL_BR = WL_GT + 3 * (size_t)1024 * 1024, WL_OUT = WL_BR + (size_t)1024 * 1024, WL_END = WL_OUT + (size_t)1024 * 1024;
static_assert(WL_END * 2 * 2 <= 99 * MiB, "weights");
constexpr size_t WS_XB = 102 * MiB;
constexpr size_t DO_H = 0, DO_O = 64 * MiB;
constexpr size_t WS_G = 166 * MiB;
constexpr size_t WS_A = 262 * MiB;
constexpr size_t A_QA = 0, A_KA = 16 * MiB, A_VAT = 20 * MiB, A_QI = 24 * MiB, A_KI = 56 * MiB, A_WI = 60 * MiB, A_QB = 61 * MiB, A_KB = 77 * MiB, A_VBT = 93 * MiB,
                 A_QC = 109 * MiB, A_KC = 141 * MiB, A_VCT = 173 * MiB, A_END = 205 * MiB;
constexpr size_t WS_H8 = WS_A + A_END;
constexpr size_t WS_END = WS_H8 + 32 * MiB;
static_assert(WS_END <= 512 * MiB && CTL_CMAX + 2 * CMAX_PER_LAYER * 4 <= CTL_SA && CTL_SA + (size_t)T * 4 <= CTL_BYTES, "workspace");

#define XB_TMO      128
#define XB_XCNT(j)  (256  + 64 * (j))
#define XB_XSUB(j)  (1280 + 64 * (j))
#define XB_XGEN(j)  (2304 + 64 * (j))
#define XB_TOP      3328
#define XB_TOPGEN   3392
#define XCD_BAR_WORDS 3456
#define XB_SPIN_CAP (1u << 18)
__device__ __forceinline__ unsigned xb_ld(unsigned* p)              { return __hip_atomic_load(p, __ATOMIC_RELAXED, __HIP_MEMORY_SCOPE_AGENT); }
__device__ __forceinline__ unsigned xb_add(unsigned* p, unsigned v) { return __hip_atomic_fetch_add(p, v, __ATOMIC_RELAXED, __HIP_MEMORY_SCOPE_AGENT); }
__device__ __forceinline__ unsigned xb_xcc_id() { return (unsigned)__builtin_amdgcn_s_getreg((3 << 11) | 20) & 0xFu; }
#define XB_SPIN(cond, bar) do { unsigned _sp = 0; while (cond) { __builtin_amdgcn_s_sleep(1); \
    if ((++_sp & 255u) == 0u) { if (xb_ld(&(bar)[XB_TMO])) break; if (_sp > XB_SPIN_CAP) { atomicAdd(&(bar)[XB_TMO], 1u); break; } } } } while (0)
struct XcdBarrier { unsigned* bar; unsigned x; volatile LAS unsigned* st; };
__device__ __forceinline__ XcdBarrier xcd_barrier_post(unsigned* bar, volatile LAS unsigned* st) {
    XcdBarrier b; b.bar = bar; b.x = xb_xcc_id(); b.st = st;
    if (threadIdx.x == 0) (void)xb_add(&bar[XB_XCNT(b.x)], 1u);
    return b;
}
__device__ __forceinline__ void xcd_barrier_complete(unsigned* bar, unsigned x, unsigned& nloc, unsigned& nx) {
    const unsigned G = gridDim.x * gridDim.y * gridDim.z;
    unsigned sum, cnt, mine, sp = 0u;
    for (;;) {
        sum = 0u; cnt = 0u; mine = 0u;
#pragma unroll
        for (unsigned j = 0; j < 16; ++j) { const unsigned c = xb_ld(&bar[XB_XCNT(j)]); sum += c; cnt += (c > 0u) ? 1u : 0u; mine = (j == x) ? c : mine; }
        if (sum == G) break;
        __builtin_amdgcn_s_sleep(1);
        if ((++sp & 255u) == 0u) { if (xb_ld(&bar[XB_TMO])) break; if (sp > XB_SPIN_CAP) { atomicAdd(&bar[XB_TMO], 1u); break; } }
    }
    nloc = mine > 0u ? mine : 1u; nx = cnt > 0u ? cnt : 1u;
}
__device__ __forceinline__ void xcd_barrier(const XcdBarrier& b) {
    asm volatile("s_waitcnt vmcnt(0)" ::: "memory");
    __syncthreads();
    if (threadIdx.x == 0) {
        unsigned* bar = b.bar;
        __builtin_amdgcn_s_waitcnt(0);
        unsigned nloc = b.st[0], nx = b.st[1];
        if (nloc == 0u) { xcd_barrier_complete(bar, b.x, nloc, nx); b.st[0] = nloc; b.st[1] = nx; }
        const unsigned old = xb_add(&bar[XB_XSUB(b.x)], 1u);
        const unsigned gen = old / nloc;
        if (old + 1u == (gen + 1u) * nloc) {
            __builtin_amdgcn_fence(__ATOMIC_RELEASE, "agent");
            asm volatile("s_waitcnt vmcnt(0)" ::: "memory");
            const unsigned og = xb_add(&bar[XB_TOP], 1u);
            const unsigned tg = og / nx;
            if (og + 1u == (tg + 1u) * nx) xb_add(&bar[XB_TOPGEN], 1u);
            else XB_SPIN(xb_ld(&bar[XB_TOPGEN]) == tg, bar);
            __builtin_amdgcn_fence(__ATOMIC_ACQUIRE, "agent");
            xb_add(&bar[XB_XGEN(b.x)], 1u);
            asm volatile("s_waitcnt vmcnt(0)" ::: "memory");
        } else {
            XB_SPIN(xb_ld(&bar[XB_XGEN(b.x)]) == gen, bar);
            __builtin_amdgcn_fence(__ATOMIC_ACQUIRE, "agent");
            asm volatile("s_waitcnt vmcnt(0)" ::: "memory");
        }
    }
    __syncthreads();
}

typedef float f32x2_t __attribute__((ext_vector_type(2))); typedef __bf16 bf16x2_t __attribute__((ext_vector_type(2)));
__device__ __forceinline__ unsigned pk2(float lo, float hi) { f32x2_t v = {lo, hi}; bf16x2_t b = __builtin_convertvector(v, bf16x2_t); return __builtin_bit_cast(unsigned, b); }
__device__ __forceinline__ float bf2f(unsigned short h) { return __uint_as_float((unsigned)h << 16); }
#define RORF_(v, n) __uint_as_float((unsigned)__builtin_amdgcn_update_dpp(0, (int)__float_as_uint(v), 0x120 + (n), 0xf, 0xf, false))
__device__ __forceinline__ float wave_sum(float v) {
    v += RORF_(v, 1); v += RORF_(v, 2); v += RORF_(v, 4); v += RORF_(v, 8);
    { auto r = __builtin_amdgcn_permlane16_swap(__float_as_uint(v), __float_as_uint(v), false, false); v = __uint_as_float(r[0]) + __uint_as_float(r[1]); }
    { auto r = __builtin_amdgcn_permlane32_swap(__float_as_uint(v), __float_as_uint(v), false, false); v = __uint_as_float(r[0]) + __uint_as_float(r[1]); }
    return v;
}
__device__ __forceinline__ float wave_max_f(float v) {
    v = fmaxf(v, RORF_(v, 1)); v = fmaxf(v, RORF_(v, 2)); v = fmaxf(v, RORF_(v, 4)); v = fmaxf(v, RORF_(v, 8));
    { auto r = __builtin_amdgcn_permlane16_swap(__float_as_uint(v), __float_as_uint(v), false, false); v = fmaxf(__uint_as_float(r[0]), __uint_as_float(r[1])); }
    { auto r = __builtin_amdgcn_permlane32_swap(__float_as_uint(v), __float_as_uint(v), false, false); v = fmaxf(__uint_as_float(r[0]), __uint_as_float(r[1])); }
    return v;
}
__device__ __forceinline__ float fast_exp2(float x) { return __builtin_amdgcn_exp2f(x); }
__device__ __forceinline__ float fast_rcp(float x) { return __builtin_amdgcn_rcpf(x); }
__device__ __forceinline__ float sigmoidf_(float x) { return fast_rcp(1.0f + fast_exp2(-1.4426950408889634f * x)); }

struct Ctx {
    const float* x_in; const int* pos; const float* norm_g; const float* w_in; const float* qk_g; const float* lam_p; const float* subln_g;
    const float* w_branch; const float* w_out; const float* w_gate; const float* w_up; const float* w_down;
    float* out; unsigned char* ws;
};
__device__ __forceinline__ bf16_t* wsb(const Ctx& c, size_t off) { return (bf16_t*)(c.ws + off); }
__device__ __forceinline__ bf16_t* wlayer(const Ctx& c, int layer) { return (bf16_t*)(c.ws + WS_W) + (size_t)layer * WL_END; }

struct EpiSwiglu {
    static constexpr bool PERM = true, AFTER_DRAIN = false;
    __device__ __forceinline__ bool keep(const pg8::Unit&) const { return false; }
    bf16_t* O;
    __device__ __forceinline__ void operator()(const f32x4 (&acc)[2][2][4][2], const pg8::Unit& u, int wr, int wc, int fr_in, int fq_in) const {
        int fr = fr_in, fq = fq_in; asm volatile("" : "+v"(fr), "+v"(fq));
        const int row0 = u.pm * 256 + wr * 64 + fr, col = u.pn * 128 + wc * 32 + 8 * fq;
#pragma unroll
        for (int ai = 0; ai < 2; ++ai)
#pragma unroll
            for (int m = 0; m < 4; ++m) {
                float a[8];
#pragma unroll
                for (int n = 0; n < 2; ++n)
#pragma unroll
                    for (int e = 0; e < 4; ++e) { const float g = acc[ai][0][m][n][e], up = acc[ai][1][m][n][e]; a[4 * n + e] = g * sigmoidf_(g) * up; }
                u32x4 w; w.x = pk2(a[0], a[1]); w.y = pk2(a[2], a[3]); w.z = pk2(a[4], a[5]); w.w = pk2(a[6], a[7]);
                *(u32x4*)(O + (size_t)(row0 + ai * 128 + m * 16) * DFF + col) = w;
            }
    }
};
typedef int i32x4 __attribute__((ext_vector_type(4)));
struct EpiSwigluI8 {
    static constexpr bool PERM = true, AFTER_DRAIN = false;
    __device__ __forceinline__ bool keep(const pg8::Unit&) const { return false; }
    bf16_t* O; const float* sa; const float* cmax;
    __device__ __forceinline__ void operator()(const i32x4 (&acc)[2][2][4][2], const pg8::Unit& u, int wr, int wc, int fr_in, int fq_in) const {
        int fr = fr_in, fq = fq_in; asm volatile("" : "+v"(fr), "+v"(fq));
        const int row0 = u.pm * 256 + wr * 64 + fr, col = u.pn * 128 + wc * 32 + 8 * fq, bcol = u.pn * 256 + wc * 32 + 8 * fq;
        float sg[8], su[8];
        { const f32x4 g0 = *(const f32x4*)(cmax + bcol), g1 = *(const f32x4*)(cmax + bcol + 4), u0 = *(const f32x4*)(cmax + bcol + 128), u1 = *(const f32x4*)(cmax + bcol + 132);
#pragma unroll
          for (int k = 0; k < 4; ++k) { sg[k] = g0[k] * (1.0f / 127.0f); sg[4 + k] = g1[k] * (1.0f / 127.0f); su[k] = u0[k] * (1.0f / 127.0f); su[4 + k] = u1[k] * (1.0f / 127.0f); } }
        float sr[8];
#pragma unroll
        for (int s_ = 0; s_ < 8; ++s_) sr[s_] = sa[row0 + (s_ >> 2) * 128 + (s_ & 3) * 16];
#pragma unroll
        for (int ai = 0; ai < 2; ++ai)
#pragma unroll
            for (int m = 0; m < 4; ++m) {
                const float s = sr[ai * 4 + m];
                float a[8];
#pragma unroll
                for (int n = 0; n < 2; ++n)
#pragma unroll
                    for (int e = 0; e < 4; ++e) { const float g = (float)acc[ai][0][m][n][e] * (s * sg[4 * n + e]), up = (float)acc[ai][1][m][n][e] * (s * su[4 * n + e]); a[4 * n + e] = g * sigmoidf_(g) * up; }
                u32x4 w; w.x = pk2(a[0], a[1]); w.y = pk2(a[2], a[3]); w.z = pk2(a[4], a[5]); w.w = pk2(a[6], a[7]);
                *(u32x4*)(O + (size_t)(row0 + ai * 128 + m * 16) * DFF + col) = w;
            }
    }
};
struct EpiGateI8 {
    static constexpr bool PERM = true, AFTER_DRAIN = false;
    __device__ __forceinline__ bool keep(const pg8::Unit&) const { return false; }
    unsigned char* G; const float* sa; const float* cmax;
    __device__ __forceinline__ void operator()(const i32x4 (&acc)[2][2][4][2], const pg8::Unit& u, int wr, int wc, int fr_in, int fq_in) const {
        int fr = fr_in, fq = fq_in; asm volatile("" : "+v"(fr), "+v"(fq));
        const int row0 = u.pm * 256 + wr * 64 + fr, col0 = u.pn * 256 + wc * 32 + 8 * fq;
        float sc[2][8];
#pragma unroll
        for (int bj = 0; bj < 2; ++bj) { const f32x4 c0 = *(const f32x4*)(cmax + col0 + bj * 128), c1 = *(const f32x4*)(cmax + col0 + bj * 128 + 4);
#pragma unroll
            for (int k = 0; k < 4; ++k) { sc[bj][k] = c0[k] * (1.0f / 127.0f); sc[bj][4 + k] = c1[k] * (1.0f / 127.0f); } }
        float sr[8];
#pragma unroll
        for (int s_ = 0; s_ < 8; ++s_) sr[s_] = sa[row0 + (s_ >> 2) * 128 + (s_ & 3) * 16];
#pragma unroll
        for (int ai = 0; ai < 2; ++ai)
#pragma unroll
            for (int m = 0; m < 4; ++m)
#pragma unroll
                for (int bj = 0; bj < 2; ++bj) {
                    const float s = sr[ai * 4 + m];
                    unsigned q[8];
#pragma unroll
                    for (int k = 0; k < 8; ++k) q[k] = (unsigned)__builtin_fmaxf(__builtin_rintf(255.0f * sigmoidf_((float)acc[ai][bj][m][k >> 2][k & 3] * (s * sc[bj][k]))), 1.0f);
                    u32x2 w; w.x = q[0] | (q[1] << 8) | (q[2] << 16) | (q[3] << 24); w.y = q[4] | (q[5] << 8) | (q[6] << 16) | (q[7] << 24);
                    *(u32x2*)(G + (size_t)(row0 + ai * 128 + m * 16) * 3072 + col0 + bj * 128) = w;
                }
    }
};

template <bool IN_BF16, bool OUT_BF16> struct EpiResid {
    static constexpr bool PERM = true, AFTER_DRAIN = false;
    __device__ __forceinline__ bool keep(const pg8::Unit&) const { return false; }
    const void* in; void* out; float alpha;
    __device__ __forceinline__ void operator()(const f32x4 (&acc)[2][2][4][2], const pg8::Unit& u, int wr, int wc, int fr_in, int fq_in) const {
        int fr = fr_in, fq = fq_in; asm volatile("" : "+v"(fr), "+v"(fq));
        const int row0 = u.pm * 256 + wr * 64 + fr, col0 = u.pn * 256 + wc * 32 + 8 * fq;
        constexpr int DEPTH = 4;
#define RS_OFF(s_, bj_) ((size_t)(row0 + ((s_) >> 2) * 128 + ((s_) & 3) * 16) * D + col0 + (bj_) * 128)
        f32x4 bufa[DEPTH][2], bufb[DEPTH][2];
#define RS_LOAD(s_, d_) do { _Pragma("unroll") for (int bj = 0; bj < 2; ++bj) { \
            if (IN_BF16) { bufa[d_][bj] = __builtin_bit_cast(f32x4, *(const u32x4*)((const bf16_t*)in + RS_OFF(s_, bj))); } \
            else { bufa[d_][bj] = *(const f32x4*)((const float*)in + RS_OFF(s_, bj)); bufb[d_][bj] = *(const f32x4*)((const float*)in + RS_OFF(s_, bj) + 4); } } } while (0)
#pragma unroll
        for (int s_ = 0; s_ < DEPTH; ++s_) RS_LOAD(s_, s_);
        asm volatile("" ::: "memory");
#pragma unroll
        for (int s_ = 0; s_ < 8; ++s_) {
            const int ai = s_ >> 2, m = s_ & 3;
#pragma unroll
            for (int bj = 0; bj < 2; ++bj) {
                f32x4 x0, x1;
                if (IN_BF16) { const u32x4 w = __builtin_bit_cast(u32x4, bufa[s_ % DEPTH][bj]);
                    x0 = (f32x4){__uint_as_float(w.x << 16), __uint_as_float(w.x & 0xffff0000u), __uint_as_float(w.y << 16), __uint_as_float(w.y & 0xffff0000u)};
                    x1 = (f32x4){__uint_as_float(w.z << 16), __uint_as_float(w.z & 0xffff0000u), __uint_as_float(w.w << 16), __uint_as_float(w.w & 0xffff0000u)}; }
                else { x0 = bufa[s_ % DEPTH][bj]; x1 = bufb[s_ % DEPTH][bj]; }
                x0 = x0 + alpha * acc[ai][bj][m][0]; x1 = x1 + alpha * acc[ai][bj][m][1];
                if (OUT_BF16) { u32x4 w; w.x = pk2(x0[0], x0[1]); w.y = pk2(x0[2], x0[3]); w.z = pk2(x1[0], x1[1]); w.w = pk2(x1[2], x1[3]); *(u32x4*)((bf16_t*)out + RS_OFF(s_, bj)) = w; }
                else { *(f32x4*)((float*)out + RS_OFF(s_, bj)) = x0; *(f32x4*)((float*)out + RS_OFF(s_, bj) + 4) = x1; }
            }
            asm volatile("" ::: "memory");
            if (s_ + DEPTH < 8) { RS_LOAD(s_ + DEPTH, s_ % DEPTH); asm volatile("" ::: "memory"); }
        }
#undef RS_LOAD
#undef RS_OFF
    }
};
struct EpiGate {
    static constexpr bool PERM = true, AFTER_DRAIN = false;
    __device__ __forceinline__ bool keep(const pg8::Unit&) const { return false; }
    unsigned char* G;
    __device__ __forceinline__ void operator()(const f32x4 (&acc)[2][2][4][2], const pg8::Unit& u, int wr, int wc, int fr_in, int fq_in) const {
        int fr = fr_in, fq = fq_in; asm volatile("" : "+v"(fr), "+v"(fq));
        const int row0 = u.pm * 256 + wr * 64 + fr, col0 = u.pn * 256 + wc * 32 + 8 * fq;
#pragma unroll
        for (int ai = 0; ai < 2; ++ai)
#pragma unroll
            for (int m = 0; m < 4; ++m)
#pragma unroll
                for (int bj = 0; bj < 2; ++bj) {
                    unsigned q[8];
#pragma unroll
                    for (int k = 0; k < 8; ++k) q[k] = (unsigned)__builtin_fmaxf(__builtin_rintf(255.0f * sigmoidf_(acc[ai][bj][m][k >> 2][k & 3])), 1.0f);
                    u32x2 w; w.x = q[0] | (q[1] << 8) | (q[2] << 16) | (q[3] << 24); w.y = q[4] | (q[5] << 8) | (q[6] << 16) | (q[7] << 24);
                    *(u32x2*)(G + (size_t)(row0 + ai * 128 + m * 16) * 3072 + col0 + bj * 128) = w;
                }
    }
};
struct EpiMerge {
    static constexpr bool PERM = true, AFTER_DRAIN = false;
    __device__ __forceinline__ bool keep(const pg8::Unit&) const { return false; }
    const unsigned char* G; bf16_t* Mg; int first;
    __device__ __forceinline__ void operator()(const f32x4 (&acc)[2][2][4][2], const pg8::Unit& u, int wr, int wc, int fr_in, int fq_in) const {
        int fr = fr_in, fq = fq_in; asm volatile("" : "+v"(fr), "+v"(fq));
        const int row0 = u.pm * 256 + wr * 64 + fr, col0 = u.pn * 256 + wc * 32 + 8 * fq;
        constexpr int DEPTH = 4;
        u32x2 gb[DEPTH][2]; u32x4 mb[DEPTH][2];
#define MS_OFF(s_, bj_) ((size_t)(row0 + ((s_) >> 2) * 128 + ((s_) & 3) * 16) * D + col0 + (bj_) * 128)
#define GS_OFF(s_, bj_) ((size_t)(row0 + ((s_) >> 2) * 128 + ((s_) & 3) * 16) * 3072 + col0 + (bj_) * 128)
#pragma unroll
        for (int s_ = 0; s_ < DEPTH; ++s_)
#pragma unroll
            for (int bj = 0; bj < 2; ++bj) { gb[s_][bj] = *(const u32x2*)(G + GS_OFF(s_, bj)); mb[s_][bj] = (u32x4){0u, 0u, 0u, 0u}; if (!first) mb[s_][bj] = *(const u32x4*)(Mg + MS_OFF(s_, bj)); }
        asm volatile("" ::: "memory");
#pragma unroll
        for (int s_ = 0; s_ < 8; ++s_) {
            const int ai = s_ >> 2, m = s_ & 3;
#pragma unroll
            for (int bj = 0; bj < 2; ++bj) {
                const u32x2 g = gb[s_ % DEPTH][bj]; const u32x4 pm_ = mb[s_ % DEPTH][bj];
                float r[8];
#pragma unroll
                for (int k = 0; k < 4; ++k) {
                    const unsigned mw = pm_[k], gw = g[k >> 1] >> (16 * (k & 1));
                    const float a0 = acc[ai][bj][m][k >> 1][(k & 1) * 2], a1 = acc[ai][bj][m][k >> 1][(k & 1) * 2 + 1];
                    r[2 * k] = __uint_as_float(mw << 16) + (float)(gw & 0xffu) * (1.0f / 255.0f) * a0;
                    r[2 * k + 1] = __uint_as_float(mw & 0xffff0000u) + (float)((gw >> 8) & 0xffu) * (1.0f / 255.0f) * a1;
                }
                u32x4 w; w.x = pk2(r[0], r[1]); w.y = pk2(r[2], r[3]); w.z = pk2(r[4], r[5]); w.w = pk2(r[6], r[7]);
                *(u32x4*)(Mg + MS_OFF(s_, bj)) = w;
            }
            asm volatile("" ::: "memory");
            if (s_ + DEPTH < 8) {
#pragma unroll
                for (int bj = 0; bj < 2; ++bj) { gb[s_ % DEPTH][bj] = *(const u32x2*)(G + GS_OFF(s_ + DEPTH, bj)); if (!first) mb[s_ % DEPTH][bj] = *(const u32x4*)(Mg + MS_OFF(s_ + DEPTH, bj)); }
                asm volatile("" ::: "memory");
            }
        }
#undef MS_OFF
#undef GS_OFF
    }
};

struct EpiMergeSeg {
    static constexpr bool PERM = true, AFTER_DRAIN = false;
    const unsigned char* G3; bf16_t* Mg;
    __device__ __forceinline__ bool keep(const pg8::Unit& u) const { return u.seg != 3; }
    __device__ __forceinline__ void operator()(f32x4 (&acc)[2][2][4][2], const pg8::Unit& u, int wr, int wc, int fr_in, int fq_in) const {
        if (u.seg == 2) return;
        int fr = fr_in, fq = fq_in; asm volatile("" : "+v"(fr), "+v"(fq));
        const int row0 = u.pm * 256 + wr * 64 + fr, col0 = u.pn * 256 + wc * 32 + 8 * fq;
        const bool last = u.seg == 3;
        const unsigned char* Gn = G3 + (last ? 2 : u.seg) * 1024;
        const unsigned char* Gd = G3 + (u.seg + 1) * 1024;
        constexpr int DEPTH = 4;
        u32x2 nb[DEPTH][2], db[DEPTH][2];
#define GS_OFF(s_, bj_) ((size_t)(row0 + ((s_) >> 2) * 128 + ((s_) & 3) * 16) * 3072 + col0 + (bj_) * 128)
#define MS_OFF(s_, bj_) ((size_t)(row0 + ((s_) >> 2) * 128 + ((s_) & 3) * 16) * D + col0 + (bj_) * 128)
#pragma unroll
        for (int s_ = 0; s_ < DEPTH; ++s_)
#pragma unroll
            for (int bj = 0; bj < 2; ++bj) { nb[s_][bj] = *(const u32x2*)(Gn + GS_OFF(s_, bj)); db[s_][bj] = (u32x2){0x01010101u, 0x01010101u}; if (!last) db[s_][bj] = *(const u32x2*)(Gd + GS_OFF(s_, bj)); }
        asm volatile("" ::: "memory");
#pragma unroll
        for (int s_ = 0; s_ < 8; ++s_) {
            const int ai = s_ >> 2, m = s_ & 3;
#pragma unroll
            for (int bj = 0; bj < 2; ++bj) {
                const u32x2 gn = nb[s_ % DEPTH][bj], gd = db[s_ % DEPTH][bj];
                float r[8];
#pragma unroll
                for (int k = 0; k < 8; ++k) {
                    const float fn = (float)((gn[k >> 2] >> (8 * (k & 3))) & 0xffu), fd = last ? 255.0f : (float)((gd[k >> 2] >> (8 * (k & 3))) & 0xffu);
                    r[k] = acc[ai][bj][m][k >> 2][k & 3] * (fn * fast_rcp(fd));
                    acc[ai][bj][m][k >> 2][k & 3] = r[k];
                }
                if (last) { u32x4 w; w.x = pk2(r[0], r[1]); w.y = pk2(r[2], r[3]); w.z = pk2(r[4], r[5]); w.w = pk2(r[6], r[7]); *(u32x4*)(Mg + MS_OFF(s_, bj)) = w; }
            }
            asm volatile("" ::: "memory");
            if (s_ + DEPTH < 8) {
#pragma unroll
                for (int bj = 0; bj < 2; ++bj) { nb[s_ % DEPTH][bj] = *(const u32x2*)(Gn + GS_OFF(s_ + DEPTH, bj)); if (!last) db[s_ % DEPTH][bj] = *(const u32x2*)(Gd + GS_OFF(s_ + DEPTH, bj)); }
                asm volatile("" ::: "memory");
            }
        }
#undef GS_OFF
#undef MS_OFF
    }
};
struct SegOrder {
    pg8::StaticOrder base;
    __device__ __forceinline__ bool next(int i, pg8::Unit& u) const { if (!base.next(i >> 2, u)) return false; u.seg = i & 3; return true; }
    __device__ __forceinline__ void a_ready(const pg8::Unit&) const {}
    __device__ __forceinline__ void done(const pg8::Unit&) const {}
};

struct RevOrder {
    pg8::StaticOrder base; int rounds;
    __device__ __forceinline__ void init(int M, int N, int G_, int c_) { base.init(M, N, G_, c_); rounds = (base.nwg - c_ + G_ - 1) / G_; }
    __device__ __forceinline__ bool next(int i, pg8::Unit& u) const { return i < rounds && base.next(rounds - 1 - i, u); }
    __device__ __forceinline__ void a_ready(const pg8::Unit&) const {}
    __device__ __forceinline__ void done(const pg8::Unit&) const {}
};

struct GateOrder {
    pg8::StaticOrder base;
    __device__ __forceinline__ bool next(int i, pg8::Unit& u) const { if (!base.next(i / 3, u)) return false; u.pn += 4 * (i % 3); return true; }
    __device__ __forceinline__ void a_ready(const pg8::Unit&) const {}
    __device__ __forceinline__ void done(const pg8::Unit&) const {}
};

template <bool I8> struct EpiInProjT {
    typedef typename pg8::MmaOp<I8>::acc_t acc_t;
    static constexpr bool PERM = true, AFTER_DRAIN = false;
    __device__ __forceinline__ bool keep(const pg8::Unit&) const { return false; }
    unsigned char* ws;
    const LAS unsigned char* gains_lds;
    int layer;
    __device__ __forceinline__ void operator()(const acc_t (&acc)[2][2][4][2], const pg8::Unit& u, int wr, int wc, int fr_in, int fq_in) const {
        int fr = fr_in, fq = fq_in; asm volatile("" : "+v"(fr), "+v"(fq));
        const int pn = u.pn;
        unsigned char* A = ws + WS_A; const float* rope = (const float*)(ws + WS_ROPE);
        float* kmean = (float*)(ws + WS_CTL + CTL_KMEAN) + (size_t)layer * (16 * 4 * 8 * 2 * 64);
        int kind = 0;
        int ng = -1;
        bool do_rope = false; float scale = 1.0f; bool do_kmean = false;
        bf16_t* dst = nullptr; int pitch = 0, coloff = 0; int vdims = 0, vdimoff = 0;
        if (pn == 0)      { dst = (bf16_t*)(A + A_QA); pitch = 256; coloff = 64 * wc; ng = 0; do_rope = true; scale = C2; }
        else if (pn == 1) {
            if (wc == 0)      { dst = (bf16_t*)(A + A_KA); pitch = 64; coloff = 0; ng = 1; do_rope = true; }
            else if (wc == 1) { kind = 1; dst = (bf16_t*)(A + A_VAT); vdims = 64; vdimoff = 0; }
            else if (wc == 2) { dst = (bf16_t*)(A + A_KI); pitch = 64; coloff = 0; do_rope = true; }
            else              { kind = 2; }
        }
        else if (pn <= 3) { dst = (bf16_t*)(A + A_QI); pitch = 512; coloff = 64 * (4 * (pn - 2) + wc); do_rope = true; }
        else if (pn == 4) { dst = (bf16_t*)(A + A_QB); pitch = 256; coloff = 64 * wc; ng = 2; do_rope = true; scale = C2; }
        else if (pn == 5) { dst = (bf16_t*)(A + A_KB); pitch = 256; coloff = 64 * wc; ng = 3; do_rope = true; do_kmean = true; }
        else if (pn == 6) { kind = 1; dst = (bf16_t*)(A + A_VBT); vdims = 256; vdimoff = 64 * wc; }
        else if (pn <= 8) { dst = (bf16_t*)(A + A_QC); pitch = 512; coloff = 64 * (4 * (pn - 7) + wc); ng = 4; do_rope = true; scale = C2; }
        else if (pn <= 10){ dst = (bf16_t*)(A + A_KC); pitch = 512; coloff = 64 * (4 * (pn - 9) + wc); ng = 5; do_rope = true; }
        else              { kind = 1; dst = (bf16_t*)(A + A_VCT); vdims = 512; vdimoff = 64 * (4 * (pn - 11) + wc); }
        const int row0 = u.pm * 256 + wr * 64 + fr;
        const float* sa = (const float*)(ws + WS_CTL + CTL_SA);
        const LAS float* scp = (const LAS float*)(gains_lds + 1536) + u.pn * 256 + wc * 32 + 8 * fq;
#define IPS(ai_, m_) (sa[row0 + (ai_) * 128 + (m_) * 16])
#define IPSC() float sc_[16]; if (I8) { const LAS float* q_ = scp; asm volatile("" : "+v"(q_)); const f32x4 a_ = *(const LAS f32x4*)q_, b_ = *(const LAS f32x4*)(q_ + 4), c_ = *(const LAS f32x4*)(q_ + 128), d_ = *(const LAS f32x4*)(q_ + 132); \
        _Pragma("unroll") for (int k_ = 0; k_ < 4; ++k_) { sc_[k_] = a_[k_]; sc_[4 + k_] = b_[k_]; sc_[8 + k_] = c_[k_]; sc_[12 + k_] = d_[k_]; } }
#define IPV(ai_, bj_, m_, n_, e_) (I8 ? (float)acc[ai_][bj_][m_][n_][e_] * (rs_ * sc_[8 * (bj_) + 4 * (n_) + (e_)]) : (float)acc[ai_][bj_][m_][n_][e_])
        if (kind == 2) {
            if (fq == 0) {
                float* WI = (float*)(A + A_WI);
#pragma unroll
                for (int ai = 0; ai < 2; ++ai)
#pragma unroll
                    for (int m = 0; m < 4; ++m) { const size_t tok = (size_t)(row0 + ai * 128 + m * 16); const float rs_ = I8 ? IPS(ai, m) : 1.0f; IPSC();
                        *(f32x4*)(WI + tok * 8) = (f32x4){IPV(ai, 0, m, 0, 0), IPV(ai, 0, m, 0, 1), IPV(ai, 0, m, 0, 2), IPV(ai, 0, m, 0, 3)} * 0.04419417382415922f;
                        *(f32x4*)(WI + tok * 8 + 4) = (f32x4){IPV(ai, 0, m, 1, 0), IPV(ai, 0, m, 1, 1), IPV(ai, 0, m, 1, 2), IPV(ai, 0, m, 1, 3)} * 0.04419417382415922f; }
            }
            return;
        }
        if (kind == 1) {
            const int b = u.pm >> 3;
#pragma unroll
            for (int ai = 0; ai < 2; ++ai)
#pragma unroll
                for (int m = 0; m < 4; ++m) {
                    const float rs_ = I8 ? IPS(ai, m) : 1.0f; IPSC();
                    const int s = (row0 + ai * 128 + m * 16) & (SEQ - 1);
                    bf16_t* base = dst + ((size_t)b * vdims + vdimoff + 16 * fq) * SEQ + s;
#pragma unroll
                    for (int bj = 0; bj < 2; ++bj)
#pragma unroll
                        for (int n = 0; n < 2; ++n)
#pragma unroll
                            for (int e = 0; e < 4; e += 2) { const unsigned w = pk2(IPV(ai, bj, m, n, e), IPV(ai, bj, m, n, e + 1));
                                base[(size_t)(8 * bj + 4 * n + e) * SEQ] = (bf16_t)(w & 0xffffu); base[(size_t)(8 * bj + 4 * n + e + 1) * SEQ] = (bf16_t)(w >> 16); }
                }
            return;
        }
        const LAS float* gp = (const LAS float*)gains_lds + (ng >= 0 ? ng : 0) * 64 + 16 * fq;
        float ksum[16];
#pragma unroll
        for (int k = 0; k < 16; ++k) ksum[k] = 0.0f;
        const bool roper = do_rope && fq == 0;
        const unsigned* ropeu = (const unsigned*)rope;
        float rs_n = I8 ? IPS(0, 0) : 1.0f;
        u32x4 rt_n[2];
        if (roper) { const unsigned* rp = ropeu + (size_t)row0 * 8; rt_n[0] = *(const u32x4*)rp; rt_n[1] = *(const u32x4*)(rp + 4); }
#pragma unroll
        for (int sl = 0; sl < 8; ++sl) {
                const int ai = sl >> 2, m = sl & 3;
                const size_t tok = (size_t)(row0 + ai * 128 + m * 16);
                const float rs_ = rs_n;
                const u32x4 t0 = rt_n[0], t1 = rt_n[1];
                if (sl < 7) {
                    const int ai1 = (sl + 1) >> 2, m1 = (sl + 1) & 3;
                    if (I8) rs_n = IPS(ai1, m1);
                    if (roper) { const unsigned* rp = ropeu + (size_t)(row0 + ai1 * 128 + m1 * 16) * 8; rt_n[0] = *(const u32x4*)rp; rt_n[1] = *(const u32x4*)(rp + 4); }
                }
                float v[16];
                { IPSC();
#pragma unroll
                for (int bj = 0; bj < 2; ++bj)
#pragma unroll
                    for (int n = 0; n < 2; ++n)
#pragma unroll
                        for (int e = 0; e < 4; ++e) v[8 * bj + 4 * n + e] = IPV(ai, bj, m, n, e); }
                if (ng >= 0) {
                    float ss = 0.0f;
#pragma unroll
                    for (int k = 0; k < 16; ++k) ss += v[k] * v[k];
                    ss += __shfl_xor(ss, 16); ss += __shfl_xor(ss, 32);
                    const float rstd = rsqrtf(ss * (1.0f / 64.0f) + EPS);
                    const f32x4 g0 = *(const LAS f32x4*)gp, g1 = *(const LAS f32x4*)(gp + 4), g2 = *(const LAS f32x4*)(gp + 8), g3 = *(const LAS f32x4*)(gp + 12);
#pragma unroll
                    for (int k = 0; k < 4; ++k) { v[k] = v[k] * rstd * g0[k]; v[4 + k] = v[4 + k] * rstd * g1[k]; v[8 + k] = v[8 + k] * rstd * g2[k]; v[12 + k] = v[12 + k] * rstd * g3[k]; }
                }
                if (roper) {
#pragma unroll
                    for (int i = 0; i < 8; ++i) { const unsigned cs_ = i < 4 ? t0[i & 3] : t1[i & 3]; const float c = __uint_as_float(cs_ << 16), s = __uint_as_float(cs_ & 0xffff0000u);
                        const float x1 = v[i], x2 = v[8 + i]; v[i] = x1 * c - x2 * s; v[8 + i] = x2 * c + x1 * s; }
                }
                if (do_kmean) {
#pragma unroll
                    for (int k = 0; k < 16; ++k) ksum[k] += v[k];
                }
#pragma unroll
                for (int k = 0; k < 16; ++k) v[k] *= scale;
                bf16_t* p = dst + tok * pitch + coloff + 16 * fq;
                u32x4 w0, w1; w0.x = pk2(v[0], v[1]); w0.y = pk2(v[2], v[3]); w0.z = pk2(v[4], v[5]); w0.w = pk2(v[6], v[7]);
                w1.x = pk2(v[8], v[9]); w1.y = pk2(v[10], v[11]); w1.z = pk2(v[12], v[13]); w1.w = pk2(v[14], v[15]);
                *(u32x4*)p = w0; *(u32x4*)(p + 8) = w1;
            }
        if (do_kmean) {
#pragma unroll
            for (int k = 0; k < 16; ++k) { float s = ksum[k]; s += __shfl_xor(s, 1); s += __shfl_xor(s, 2); s += __shfl_xor(s, 4); s += __shfl_xor(s, 8); ksum[k] = s; }
            if (fr == 0) {
                float* km = kmean + (((size_t)((u.pm >> 3) * 4 + wc) * 8 + (u.pm & 7)) * 2 + wr) * 64 + 16 * fq;
#pragma unroll
                for (int k = 0; k < 16; k += 4) *(f32x4*)(km + k) = (f32x4){ksum[k], ksum[k + 1], ksum[k + 2], ksum[k + 3]};
            }
        }
    }
};
#undef IPV
#undef IPS
#undef IPSC

template <class Map> __device__ __forceinline__ void conv_item(const Map& map, int ld, int K, bf16_t* WT, const float* gk, LAS float* scr, int item, int nblk, int lane) {
    const int kb = item / nblk, nb = item % nblk, k0 = 64 * kb, n0 = 32 * nb;
    typedef const __attribute__((address_space(1))) float* gptr;
    const float* src0 = map(n0 + (lane & 31)); const bool valid = src0 != nullptr; const gptr src = (gptr)(uintptr_t)(valid ? src0 : map(0));
    float tv[32];
#pragma unroll
    for (int i = 0; i < 32; ++i) { const int kk = 2 * i + (lane >> 5); tv[i] = src[(size_t)(k0 + kk) * ld]; }
#pragma unroll
    for (int i = 0; i < 32; ++i) { const int kk = 2 * i + (lane >> 5); float v = valid ? tv[i] : 0.0f; if (gk) v *= gk[k0 + kk]; scr[kk * 33 + (lane & 31)] = v; }
    asm volatile("s_waitcnt lgkmcnt(0)" ::: "memory");
    const int c = lane & 7;
#pragma unroll
    for (int j = 0; j < 4; ++j) { const int n = (lane >> 3) + 8 * j; const LAS float* s = scr + (8 * c) * 33 + n;
        u32x4 o; o.x = pk2(s[0 * 33], s[1 * 33]); o.y = pk2(s[2 * 33], s[3 * 33]); o.z = pk2(s[4 * 33], s[5 * 33]); o.w = pk2(s[6 * 33], s[7 * 33]);
        *(u32x4*)(WT + (size_t)(n0 + n) * K + k0 + 8 * c) = o; }
    asm volatile("s_waitcnt lgkmcnt(0)" ::: "memory");
}
struct MapPlain { const float* W; __device__ __forceinline__ const float* operator()(int n) const { return W + n; } };
struct MapGU { const float* Wg; const float* Wu; __device__ __forceinline__ const float* operator()(int n) const { const int t = n >> 8, w = n & 255;
    const uintptr_t a = (uintptr_t)Wg, d = (uintptr_t)Wu - (uintptr_t)Wg; return (const float*)(a + d * (uintptr_t)(w >> 7)) + t * 128 + (w & 127); } };
struct MapIn { const float* W;
    __device__ __forceinline__ const float* operator()(int n) const {
        const int pn = n >> 8, w = n & 255, bj = w >> 7, wc = (w >> 5) & 3, fq = (w >> 3) & 3, j = w & 7, dim = 16 * fq + 8 * bj + j;
        int base;
        if (pn == 0) base = CI_QA + 64 * wc;
        else if (pn == 1) { if (wc == 0) base = CI_KA; else if (wc == 1) base = CI_VA; else if (wc == 2) base = CI_KI; else { if (dim >= 8) return nullptr; base = CI_WI; } }
        else if (pn <= 3) base = CI_QI + 64 * (4 * (pn - 2) + wc);
        else if (pn == 4) base = CI_QB + 64 * wc;
        else if (pn == 5) base = CI_KB + 64 * wc;
        else if (pn == 6) base = CI_VB + 64 * wc;
        else if (pn <= 8) base = CI_QC + 64 * (4 * (pn - 7) + wc);
        else if (pn <= 10) base = CI_KC + 64 * (4 * (pn - 9) + wc);
        else base = CI_VC + 64 * (4 * (pn - 11) + wc);
        return W + base + dim;
    } };

template <bool G64, class Map> __device__ __forceinline__ void colmax_item(const Map& map, int ld, const float* gk, unsigned* cmax, int item, int nblk, int lane) {
    const int kb = item / nblk, nb = item % nblk, k0 = 64 * kb, n0 = 32 * nb;
    typedef const __attribute__((address_space(1))) float* gptr;
    const float* src0 = map(n0 + (lane & 31)); const bool valid = src0 != nullptr; const gptr src = (gptr)(uintptr_t)(valid ? src0 : map(0));
    float tv[32];
#pragma unroll
    for (int i = 0; i < 32; ++i) { const int kk = 2 * i + (lane >> 5); tv[i] = src[(size_t)(k0 + kk) * ld]; }
    float mx = 0.0f;
#pragma unroll
    for (int i = 0; i < 32; ++i) { const int kk = 2 * i + (lane >> 5); mx = fmaxf(mx, valid ? fabsf(tv[i] * gk[k0 + kk]) : 0.0f); }
    mx = fmaxf(mx, __shfl_xor(mx, 32));
    if (G64) { mx = wave_max_f(mx); if (lane == 0) atomicMax(cmax + (n0 >> 8) * 4 + ((n0 >> 5) & 3), __float_as_uint(mx)); }
    else if (lane < 32) atomicMax(cmax + n0 + lane, __float_as_uint(mx));
}
template <bool G64, class Map> __device__ __forceinline__ void conv_item_i8(const Map& map, int ld, int K, signed char* WT, const float* gk, const float* cmax, LAS float* scr, int item, int nblk, int lane) {
    const int kb = item / nblk, nb = item % nblk, k0 = 64 * kb, n0 = 32 * nb;
    typedef const __attribute__((address_space(1))) float* gptr;
    const float* src0 = map(n0 + (lane & 31)); const bool valid = src0 != nullptr; const gptr src = (gptr)(uintptr_t)(valid ? src0 : map(0));
    const float am = G64 ? cmax[(n0 >> 8) * 4 + ((n0 >> 5) & 3)] : cmax[n0 + (lane & 31)], qs = (valid && am > 0.0f) ? 127.0f / am : 0.0f;
    float tv[32];
#pragma unroll
    for (int i = 0; i < 32; ++i) { const int kk = 2 * i + (lane >> 5); tv[i] = src[(size_t)(k0 + kk) * ld]; }
#pragma unroll
    for (int i = 0; i < 32; ++i) { const int kk = 2 * i + (lane >> 5); scr[kk * 33 + (lane & 31)] = __builtin_rintf(tv[i] * gk[k0 + kk] * qs); }
    asm volatile("s_waitcnt lgkmcnt(0)" ::: "memory");
    const int c = lane & 7;
#pragma unroll
    for (int j = 0; j < 4; ++j) { const int n = (lane >> 3) + 8 * j; const LAS float* s = scr + (8 * c) * 33 + n;
        unsigned b[8];
#pragma unroll
        for (int k = 0; k < 8; ++k) b[k] = (unsigned)(int)s[k * 33] & 0xffu;
        u32x2 o; o.x = b[0] | (b[1] << 8) | (b[2] << 16) | (b[3] << 24); o.y = b[4] | (b[5] << 8) | (b[6] << 16) | (b[7] << 24);
        *(u32x2*)(WT + (size_t)(n0 + n) * K + k0 + 8 * c) = o; }
    asm volatile("s_waitcnt lgkmcnt(0)" ::: "memory");
}
template <int PASS> __device__ __forceinline__ void prologue_i8(const Ctx& c, LAS unsigned char* lds) {
    const int tid = fresh_tid(), lane = tid & 63, wave = __builtin_amdgcn_readfirstlane(tid >> 6);
    LAS float* scr = (LAS float*)(lds + wave * 16384);
    const int gw = blockIdx.x * NWAVES + wave, NGW = gridDim.x * NWAVES;
    constexpr int I_GU = 16 * 176, I_GT3 = 16 * 96, I_IN8 = 16 * 104, PER_LAYER = 2 * I_GU + I_GT3 + I_IN8;
    for (int it = gw; it < 2 * PER_LAYER; it += NGW) {
        const int layer = it / PER_LAYER; int r = it % PER_LAYER;
        bf16_t* WL = wlayer(c, layer);
        const float* ng = c.norm_g + (size_t)layer * 3 * D;
        float* cm = (float*)(c.ws + WS_CTL + CTL_CMAX) + (size_t)layer * CMAX_PER_LAYER;
        if (r < 2 * I_GU) { const int f = r / I_GU; r %= I_GU; const size_t wo = ((size_t)layer * 2 + f) * D * DFF; const MapGU map{c.w_gate + wo, c.w_up + wo};
            if (PASS == 0) colmax_item<false>(map, DFF, ng + (f ? 2 : 0) * D, (unsigned*)cm + f * 5632, r, 176, lane);
            else conv_item_i8<false>(map, DFF, D, (signed char*)(WL + WL_GU + (size_t)f * 5632 * 1024), ng + (f ? 2 : 0) * D, cm + f * 5632, scr, r, 176, lane);
            continue; }
        r -= 2 * I_GU;
        if (r < I_GT3) { const MapPlain map{c.w_in + (size_t)layer * D * NIN + CI_G};
          if (PASS == 0) colmax_item<false>(map, NIN, ng + D, (unsigned*)cm + 2 * 5632, r, 96, lane);
          else conv_item_i8<false>(map, NIN, D, (signed char*)(WL + WL_GT), ng + D, cm + 2 * 5632, scr, r, 96, lane);
          continue; }
        r -= I_GT3;
        { const MapIn map{c.w_in + (size_t)layer * D * NIN};
          if (PASS == 0) colmax_item<false>(map, NIN, ng + D, (unsigned*)cm + 2 * 5632 + 3072, r, 104, lane);
          else conv_item_i8<false>(map, NIN, D, (signed char*)(WL + WL_IN), ng + D, cm + 2 * 5632 + 3072, scr, r, 104, lane); }
    }
}

__device__ __forceinline__ void phase_prologue(const Ctx& c, LAS unsigned char* lds) {
    const int tid = fresh_tid(), lane = tid & 63, wave = __builtin_amdgcn_readfirstlane(tid >> 6);
    LAS float* scr = (LAS float*)(lds + wave * 16384);
    const int gw = blockIdx.x * NWAVES + wave, NGW = gridDim.x * NWAVES;
    constexpr int I_GU = 16 * 176, I_DN = 44 * 32, I_IN = 16 * 104, I_GT = 16 * 32, I_BA = 4 * 32, I_BC = 8 * 32, I_OUT = 16 * 32;
    constexpr int PER_LAYER = 2 * I_DN + 4 * I_BA + I_OUT;
    for (int it = gw; it < 2 * PER_LAYER; it += NGW) {
        const int layer = it / PER_LAYER; int r = it % PER_LAYER;
        bf16_t* WL = wlayer(c, layer);
        const float* ng = c.norm_g + (size_t)layer * 3 * D;
        if (r < 2 * I_DN) { const int f = r / I_DN; r %= I_DN; const size_t wo = ((size_t)layer * 2 + f) * D * DFF;
            conv_item(MapPlain{c.w_down + wo}, D, DFF, WL + WL_DN + (size_t)f * 1024 * 2816, nullptr, scr, r, 32, lane); continue; } r -= 2 * I_DN;
        if (r < 4 * I_BA) { const int i = r / I_BA; r %= I_BA; conv_item(MapPlain{c.w_branch + (size_t)layer * D * D + (size_t)i * 256 * D}, D, 256, WL + WL_BR + (size_t)i * 1024 * 256, nullptr, scr, r, 32, lane); continue; } r -= 4 * I_BA;
        conv_item(MapPlain{c.w_out + (size_t)layer * D * D}, D, D, WL + WL_OUT, nullptr, scr, r, 32, lane);
    }
    unsigned* rope = (unsigned*)(c.ws + WS_ROPE);
    for (int idx = blockIdx.x * NTHREADS + tid; idx < T * 8; idx += gridDim.x * NTHREADS) {
        const int tok = idx >> 3, i = idx & 7;
        const float inv = i == 0 ? 1.0f : i == 1 ? 0x1.8d275ep-3f : i == 2 ? 0x1.341190p-5f : i == 3 ? 0x1.ddee9cp-8f : i == 4 ? 0x1.72ba44p-10f : i == 5 ? 0x1.1f91f0p-12f : i == 6 ? 0x1.be2188p-15f : 0x1.5a0f4ep-17f;
        const float ang = (float)c.pos[tok] * inv;
        const double rev = (double)ang * 0.15915494309189535;
        const float fr_ = (float)(rev - __builtin_rint(rev));
        rope[(size_t)tok * 8 + i] = pk2(__builtin_amdgcn_cosf(fr_), __builtin_amdgcn_sinf(fr_));
    }
}

template <bool IN_BF16, bool OUT_BF, bool OUT_I8> __device__ __forceinline__ void phase_norm(const void* xin, bf16_t* h, signed char* h8, float* sa) {
    const int tid = fresh_tid(), lane = tid & 63, wave = tid >> 6;
    const int gw = blockIdx.x * NWAVES + wave, NGW = gridDim.x * NWAVES;
    constexpr int NR = 4;
    for (int row0 = gw; row0 < T; row0 += NR * NGW) {
        float v[NR][16];
#pragma unroll
        for (int k = 0; k < NR; ++k) {
            const int row = min(row0 + k * NGW, T - 1);
            if (IN_BF16) {
                const u32x4* xr = (const u32x4*)((const bf16_t*)xin + (size_t)row * D) + 2 * lane;
                const u32x4 a = xr[0], b = xr[1]; const unsigned w[8] = {a.x, a.y, a.z, a.w, b.x, b.y, b.z, b.w};
#pragma unroll
                for (int j = 0; j < 8; ++j) { v[k][2 * j] = __uint_as_float(w[j] << 16); v[k][2 * j + 1] = __uint_as_float(w[j] & 0xffff0000u); }
            } else {
                const f32x4* xr = (const f32x4*)((const float*)xin + (size_t)row * D) + lane;
#pragma unroll
                for (int j = 0; j < 4; ++j) { const f32x4 t = xr[64 * j]; v[k][4 * j] = t.x; v[k][4 * j + 1] = t.y; v[k][4 * j + 2] = t.z; v[k][4 * j + 3] = t.w; }
            }
        }
#pragma unroll
        for (int k = 0; k < NR; ++k) {
            const int row = row0 + k * NGW;
            if (row >= T) break;
            float s = 0.0f, am = 0.0f;
#pragma unroll
            for (int j = 0; j < 16; ++j) { s += v[k][j] * v[k][j]; am = fmaxf(am, fabsf(v[k][j])); }
            const float rstd = rsqrtf(wave_sum(s) * (1.0f / D) + EPS);
            if (OUT_BF) {
                if (IN_BF16) {
                    u32x4* o = (u32x4*)(h + (size_t)row * D) + 2 * lane;
                    u32x4 a, b; a.x = pk2(v[k][0] * rstd, v[k][1] * rstd); a.y = pk2(v[k][2] * rstd, v[k][3] * rstd); a.z = pk2(v[k][4] * rstd, v[k][5] * rstd); a.w = pk2(v[k][6] * rstd, v[k][7] * rstd);
                    b.x = pk2(v[k][8] * rstd, v[k][9] * rstd); b.y = pk2(v[k][10] * rstd, v[k][11] * rstd); b.z = pk2(v[k][12] * rstd, v[k][13] * rstd); b.w = pk2(v[k][14] * rstd, v[k][15] * rstd);
                    o[0] = a; o[1] = b;
                } else {
                    u32x2* o = (u32x2*)(h + (size_t)row * D) + lane;
#pragma unroll
                    for (int j = 0; j < 4; ++j) { u32x2 w; w.x = pk2(v[k][4 * j] * rstd, v[k][4 * j + 1] * rstd); w.y = pk2(v[k][4 * j + 2] * rstd, v[k][4 * j + 3] * rstd); o[64 * j] = w; }
                }
            }
            if (OUT_I8) {
                am = wave_max_f(am);
                const float qs = am > 0.0f ? 127.0f / am : 0.0f;
                unsigned b[16];
#pragma unroll
                for (int j = 0; j < 16; ++j) b[j] = (unsigned)(int)__builtin_rintf(v[k][j] * qs) & 0xffu;
                if (IN_BF16) { u32x4 w; w.x = b[0] | (b[1] << 8) | (b[2] << 16) | (b[3] << 24); w.y = b[4] | (b[5] << 8) | (b[6] << 16) | (b[7] << 24);
                               w.z = b[8] | (b[9] << 8) | (b[10] << 16) | (b[11] << 24); w.w = b[12] | (b[13] << 8) | (b[14] << 16) | (b[15] << 24);
                               *((u32x4*)(h8 + (size_t)row * D) + lane) = w; }
                else {
#pragma unroll
                    for (int j = 0; j < 4; ++j) *((unsigned*)(h8 + (size_t)row * D) + lane + 64 * j) = b[4 * j] | (b[4 * j + 1] << 8) | (b[4 * j + 2] << 16) | (b[4 * j + 3] << 24); }
                if (lane == 0) sa[row] = rstd * am * (1.0f / 127.0f);
            }
        }
    }
}

namespace att {
constexpr int KP = 144;
constexpr int KT_BYTES = 64 * KP;
constexpr float NEG = -INFINITY;
__device__ __forceinline__ int pi32(int m) { return (m & ~12) | ((m & 8) >> 1) | ((m & 4) << 1); }
__device__ __forceinline__ f32x16 mfma32(bf16x8 a, bf16x8 b, f32x16 c) { return __builtin_amdgcn_mfma_f32_32x32x16_bf16(a, b, c, 0, 0, 0); }

__device__ __forceinline__ void qk_tile(f32x16& p0, f32x16& p1, const LAS unsigned char* Kt, const bf16x8 (&qr)[4], int koff) {
    bf16x8 kf[2][2];
    kf[0][0] = *(const LAS bf16x8*)(Kt + koff); kf[0][1] = *(const LAS bf16x8*)(Kt + koff + 32 * KP);
    const f32x16 z = {0.f, 0.f, 0.f, 0.f, 0.f, 0.f, 0.f, 0.f, 0.f, 0.f, 0.f, 0.f, 0.f, 0.f, 0.f, 0.f};
#pragma unroll
    for (int d0 = 0; d0 < 4; ++d0) {
        if (d0 < 3) { kf[(d0 + 1) & 1][0] = *(const LAS bf16x8*)(Kt + koff + (d0 + 1) * 32); kf[(d0 + 1) & 1][1] = *(const LAS bf16x8*)(Kt + koff + 32 * KP + (d0 + 1) * 32); }
        if (d0 == 0) { p0 = mfma32(kf[0][0], qr[0], z); p1 = mfma32(kf[0][1], qr[0], z); }
        else { p0 = mfma32(kf[d0 & 1][0], qr[d0], p0); p1 = mfma32(kf[d0 & 1][1], qr[d0], p1); }
    }
}
struct SoftState { float mref, l; bool valid; };
constexpr float SM_THR = 6.0f;
template <int NDB, int PMASK> __device__ __forceinline__ void softmax_tile(const f32x16& p0, const f32x16& p1, SoftState& st, f32x16 (&o)[NDB], bf16x8 (&pb)[4], unsigned w0, unsigned w1) {
    float a = __builtin_fmaxf(__builtin_fmaxf(p0[0], p0[1]), p1[0]), b = __builtin_fmaxf(__builtin_fmaxf(p0[2], p0[3]), p1[1]);
    a = __builtin_fmaxf(__builtin_fmaxf(a, p1[2]), p1[3]);
#pragma unroll
    for (int r = 4; r < 16; r += 4) { a = __builtin_fmaxf(__builtin_fmaxf(a, p0[r]), p0[r + 1]); b = __builtin_fmaxf(__builtin_fmaxf(b, p0[r + 2]), p0[r + 3]);
                                      a = __builtin_fmaxf(__builtin_fmaxf(a, p1[r]), p1[r + 1]); b = __builtin_fmaxf(__builtin_fmaxf(b, p1[r + 2]), p1[r + 3]); }
    float rm = __builtin_fmaxf(a, b);
    { auto rr = __builtin_amdgcn_permlane32_swap(__float_as_uint(rm), __float_as_uint(rm), false, false); rm = __builtin_fmaxf(__uint_as_float(rr[0]), __uint_as_float(rr[1])); }
    const bool seen = rm > -1e30f;
    const bool need = (rm - st.mref > SM_THR) || (!st.valid && seen);
    st.valid = st.valid || seen;
    if (__ballot(need) != 0ull) {
        const float mnew = need ? rm : st.mref;
        const float f = fast_exp2(st.mref - mnew);
        st.mref = mnew;
        st.l *= f;
#pragma unroll
        for (int db = 0; db < NDB; ++db)
#pragma unroll
            for (int r = 0; r < 16; ++r) o[db][r] *= f;
    }
    float sum = 0.0f;
    const float mr = (PMASK == 2 && w0 == 0u) ? INFINITY : st.mref;
#pragma unroll
    for (int ks = 0; ks < 4; ++ks) {
        float e[8];
#pragma unroll
        for (int k = 0; k < 8; ++k) {
            const int r = 8 * (ks & 1) + k; const int bit = 16 * (r >> 3) + (r & 7);
            float v = fast_exp2((ks < 2 ? p0[r] : p1[r]) - mr);
            if (PMASK == 1) v = __uint_as_float(__float_as_uint(v) & (unsigned)__builtin_amdgcn_sbfe((int)(ks < 2 ? w0 : w1), bit, 1));
            e[k] = v; sum += v;
        }
        u32x4 w; w.x = pk2(e[0], e[1]); w.y = pk2(e[2], e[3]); w.z = pk2(e[4], e[5]); w.w = pk2(e[6], e[7]);
        pb[ks] = __builtin_bit_cast(bf16x8, w);
    }
    st.l += sum;
}
template <int NDB> __device__ __forceinline__ void pv_tile(f32x16 (&o)[NDB], const bf16x8 (&pb)[4], const LAS unsigned char* Vt, int voff) {
    constexpr int NS = 4 * NDB;
    bf16x8 vf[2][2];
#define VF_LD(s_) (*(const LAS bf16x8*)(Vt + voff + ((s_) % NDB) * 32 * KP + ((s_) / NDB) * 32))
    vf[0][0] = VF_LD(0); vf[0][1] = VF_LD(1);
#pragma unroll
    for (int s_ = 0; s_ < NS; s_ += 2) {
        const int cur = (s_ >> 1) & 1;
        if (s_ + 2 < NS) { vf[cur ^ 1][0] = VF_LD(s_ + 2); vf[cur ^ 1][1] = VF_LD(s_ + 3); }
        o[s_ % NDB] = mfma32(vf[cur][0], pb[s_ / NDB], o[s_ % NDB]);
        o[(s_ + 1) % NDB] = mfma32(vf[cur][1], pb[(s_ + 1) / NDB], o[(s_ + 1) % NDB]);
    }
#undef VF_LD
}
#define LDS_BAR() asm volatile("s_waitcnt lgkmcnt(0)\n\ts_barrier" ::: "memory")
template <int NK, int NV, int PMASK, class MaskF>
__device__ __forceinline__ void flash_run(LAS unsigned char* lds, const bf16_t* const (&ksrc)[NK], size_t ktile, const bf16_t* const (&vsrc)[NV], int NT, int nact, int ksel,
                                          const bf16x8 (&qr)[4], const MaskF& maskf, f32x16 (&o)[2 * NV], float& l_out, int tid, int r32, int hi) {
    constexpr int KB = NK * KT_BYTES, VB = NV * KT_BYTES, VBASE = 2 * KB;
    const int srow = tid >> 3, sch = tid & 7, sdst = srow * KP + sch * 16;
    const int koff = pi32(r32) * KP + hi * 16 + ksel * KT_BYTES, voff = r32 * KP + hi * 16;
    u32x4 kreg[2][NK], vreg[2][NV];
#pragma unroll
    for (int i = 0; i < NK; ++i) { kreg[0][i] = *(const u32x4*)ksrc[i]; *(LAS u32x4*)(lds + i * KT_BYTES + sdst) = kreg[0][i]; }
    if (NT > 1) {
#pragma unroll
        for (int i = 0; i < NK; ++i) { kreg[0][i] = *(const u32x4*)(ksrc[i] + ktile); *(LAS u32x4*)(lds + KB + i * KT_BYTES + sdst) = kreg[0][i]; } }
#pragma unroll
    for (int i = 0; i < NV; ++i) { vreg[0][i] = *(const u32x4*)vsrc[i]; *(LAS u32x4*)(lds + VBASE + i * KT_BYTES + sdst) = vreg[0][i]; }
    if (NT > 2) {
#pragma unroll
        for (int i = 0; i < NK; ++i) kreg[1][i] = *(const u32x4*)(ksrc[i] + 2 * ktile); }
    if (NT > 1) {
#pragma unroll
        for (int i = 0; i < NV; ++i) vreg[1][i] = *(const u32x4*)(vsrc[i] + 64); }
    LDS_BAR();
    SoftState st; st.mref = 0.0f; st.l = 0.0f; st.valid = false;
    f32x16 s0, s1, u0, u1;
    if (nact > 0) { qk_tile(s0, s1, lds, qr, koff); maskf.pre(s0, s1, 0); }
#define FLASH_STEP(t, LD, ST, C0, C1, N0, N1) do { \
        if ((t) + 3 < NT) { _Pragma("unroll") for (int i = 0; i < NK; ++i) kreg[LD][i] = *(const u32x4*)(ksrc[i] + (size_t)((t) + 3) * ktile); } \
        if ((t) + 2 < NT) { _Pragma("unroll") for (int i = 0; i < NV; ++i) vreg[LD][i] = *(const u32x4*)(vsrc[i] + ((t) + 2) * 64); } \
        if ((t) < nact) { \
            bf16x8 pb[4]; unsigned w0 = 0u, w1 = 0u; \
            if (PMASK) maskf.pbits((t), w0, w1); \
            softmax_tile<2 * NV, PMASK>(C0, C1, st, o, pb, w0, w1); \
            if ((t) + 1 < nact) { qk_tile(N0, N1, lds + (((t) + 1) & 1) * KB, qr, koff); maskf.pre(N0, N1, (t) + 1); } \
            pv_tile<2 * NV>(o, pb, lds + VBASE + ((t) & 1) * VB, voff); \
        } \
        if ((t) + 2 < NT) { _Pragma("unroll") for (int i = 0; i < NK; ++i) *(LAS u32x4*)(lds + ((t) & 1) * KB + i * KT_BYTES + sdst) = kreg[ST][i]; } \
        if ((t) + 1 < NT) { _Pragma("unroll") for (int i = 0; i < NV; ++i) *(LAS u32x4*)(lds + VBASE + (((t) + 1) & 1) * VB + i * KT_BYTES + sdst) = vreg[ST][i]; } \
        LDS_BAR(); \
    } while (0)
    int t = 0;
    for (; t + 1 < NT; t += 2) { FLASH_STEP(t, 0, 1, s0, s1, u0, u1); FLASH_STEP(t + 1, 1, 0, u0, u1, s0, s1); }
    if (t < NT) FLASH_STEP(t, 0, 1, s0, s1, u0, u1);
#undef FLASH_STEP
    asm volatile("s_waitcnt vmcnt(0)" ::: "memory");
    l_out = st.l;
}
__device__ __forceinline__ void causal_mask(f32x16& p0, f32x16& p1, int kb, int q, int hi) {
#pragma unroll
    for (int r = 0; r < 16; ++r) { const int key = kb + 16 * (r >> 3) + 8 * hi + (r & 7); if (key > q) p0[r] = NEG; if (key + 32 > q) p1[r] = NEG; }
}
__device__ __forceinline__ void store_pair16(bf16_t* dst, u32x2 a, u32x2 b, int hi) {
    { auto r = __builtin_amdgcn_permlane32_swap(a.x, b.x, false, false); a.x = r[0]; b.x = r[1]; }
    { auto r = __builtin_amdgcn_permlane32_swap(a.y, b.y, false, false); a.y = r[0]; b.y = r[1]; }
    u32x4 w; w.x = a.x; w.y = a.y; w.z = b.x; w.w = b.y;
    *(u32x4*)(dst + 8 * hi) = w;
}
template <int NDB> __device__ __forceinline__ void store_o(const f32x16 (&o)[NDB], float inv, bf16_t* dst, int hi) {
#pragma unroll
    for (int db = 0; db < NDB; ++db)
#pragma unroll
        for (int g = 0; g < 4; g += 2) {
            u32x2 a, b;
            a.x = pk2(o[db][4 * g] * inv, o[db][4 * g + 1] * inv); a.y = pk2(o[db][4 * g + 2] * inv, o[db][4 * g + 3] * inv);
            b.x = pk2(o[db][4 * g + 4] * inv, o[db][4 * g + 5] * inv); b.y = pk2(o[db][4 * g + 6] * inv, o[db][4 * g + 7] * inv);
            store_pair16(dst + 32 * db + 8 * g, a, b, hi);
        }
}

__device__ __forceinline__ void moba_unit(const bf16_t* QB, const bf16_t* KB, const bf16_t* VBT, const float* kmean, bf16_t* OB, LAS unsigned char* lds, int b, int h, int j) {
    const int tid = fresh_tid(), lane = tid & 63, r32 = lane & 31, hi = lane >> 5, wid = __builtin_amdgcn_readfirstlane(tid >> 6);
    const size_t tok0 = (size_t)b * SEQ;
    const int q = 256 * j + 32 * wid + r32;
    bf16x8 qr[4];
    { const bf16_t* qp = QB + (tok0 + q) * 256 + h * 64 + hi * 8;
#pragma unroll
      for (int d0 = 0; d0 < 4; ++d0) qr[d0] = *(const bf16x8*)(qp + d0 * 16); }
    unsigned sel = 0u;
    if (j > 0) {
        if (j <= 3) sel = (1u << j) - 1u;
        else {
            float gate[7];
#pragma unroll
            for (int n = 0; n < 7; ++n) {
                gate[n] = NEG;
                if (n < j) {
                    const float* km = kmean + ((size_t)(b * 4 + h) * 8 + n) * 128 + hi * 8; float s = 0.0f;
#pragma unroll
                    for (int d0 = 0; d0 < 4; ++d0) { const f32x4 a = *(const f32x4*)(km + d0 * 16) + *(const f32x4*)(km + 64 + d0 * 16), c = *(const f32x4*)(km + d0 * 16 + 4) + *(const f32x4*)(km + 64 + d0 * 16 + 4);
#pragma unroll
                        for (int e = 0; e < 4; ++e) { s += bf2f((unsigned short)qr[d0][e]) * a[e]; s += bf2f((unsigned short)qr[d0][4 + e]) * c[e]; } }
                    s += __shfl_xor(s, 32); gate[n] = s;
                }
            }
#pragma unroll
            for (int it = 0; it < 3; ++it) { float best = 0.0f; int bi = -1;
#pragma unroll
                for (int n = 0; n < 7; ++n) { if (n < j && !((sel >> n) & 1u) && (bi < 0 || gate[n] > best)) { best = gate[n]; bi = n; } }
                sel |= 1u << bi; }
        }
    }
    const int NT = 4 * (j + 1);
    const int srow = tid >> 3, sch = tid & 7;
    const bf16_t* const ksrc[1] = {KB + (tok0 + srow) * 256 + h * 64 + sch * 8};
    const bf16_t* const vsrc[1] = {VBT + ((size_t)(b * 4 + h) * 64 + srow) * SEQ + sch * 8};
    f32x16 o[2]; float l = 0.0f;
#pragma unroll
    for (int db = 0; db < 2; ++db)
#pragma unroll
        for (int r = 0; r < 16; ++r) o[db][r] = 0.0f;
    const int qmin = 256 * j + 32 * wid;
    struct MaskMoba { unsigned sel; int j, qmin, q, hi;
        __device__ __forceinline__ void pre(f32x16& p0, f32x16& p1, int t) const { const int kb = 64 * t; if ((t >> 2) >= j && kb + 63 > qmin) causal_mask(p0, p1, kb, q, hi); }
        __device__ __forceinline__ void pbits(int t, unsigned& w0, unsigned& w1) const { const int blk = t >> 2; const unsigned m_ = (blk >= j || ((sel >> blk) & 1u)) ? 0xffffffffu : 0u; w0 = m_; w1 = m_; } };
    const MaskMoba maskf{sel, j, qmin, q, hi};
    flash_run<1, 1, 2>(lds, ksrc, (size_t)64 * 256, vsrc, NT, (qmin + 31) / 64 + 1, 0, qr, maskf, o, l, tid, r32, hi);
    l += __shfl_xor(l, 32);
    store_o<2>(o, 1.0f / l, OB + (tok0 + q) * 256 + h * 64, hi);
}

__device__ __forceinline__ void diff_unit(const bf16_t* QC, const bf16_t* KC, const bf16_t* VCT, bf16_t* OC, LAS unsigned char* lds, int b, int h, int qblk, float lam, float outscale, const float* subg) {
    const int tid = fresh_tid(), lane = tid & 63, r32 = lane & 31, hi = lane >> 5, wid = __builtin_amdgcn_readfirstlane(tid >> 6);
    const int cmp = wid & 1, sub = wid >> 1;
    const size_t tok0 = (size_t)b * SEQ;
    const int q = 128 * qblk + 32 * sub + r32;
    bf16x8 qr[4];
    { const bf16_t* qp = QC + (tok0 + q) * 512 + (2 * h + cmp) * 64 + hi * 8;
#pragma unroll
      for (int d0 = 0; d0 < 4; ++d0) qr[d0] = *(const bf16x8*)(qp + d0 * 16); }
    const int NT = 2 * (qblk + 1);
    const int srow = tid >> 3, sch = tid & 7;
    const bf16_t* const k0p = KC + (tok0 + srow) * 512 + (2 * h) * 64 + sch * 8;
    const bf16_t* const v0p = VCT + ((size_t)(b * 4 + h) * 128 + srow) * SEQ + sch * 8;
    const bf16_t* const ksrc[2] = {k0p, k0p + 64};
    const bf16_t* const vsrc[2] = {v0p, v0p + (size_t)64 * SEQ};
    f32x16 o[4]; float l = 0.0f;
#pragma unroll
    for (int db = 0; db < 4; ++db)
#pragma unroll
        for (int r = 0; r < 16; ++r) o[db][r] = 0.0f;
    const int qmin = 128 * qblk + 32 * sub;
    struct MaskCausal { int qmin, q, hi;
        __device__ __forceinline__ void pre(f32x16& p0, f32x16& p1, int t) const { const int kb = 64 * t; if (kb + 63 > qmin) causal_mask(p0, p1, kb, q, hi); }
        __device__ __forceinline__ void pbits(int, unsigned&, unsigned&) const {} };
    const MaskCausal maskf{qmin, q, hi};
    for (int repd = 0; repd < 1 + (DIFF_REP & 1); ++repd) {
        if (repd) {
#pragma unroll
            for (int db = 0; db < 4; ++db)
#pragma unroll
                for (int r = 0; r < 16; ++r) o[db][r] = 0.0f; }
        flash_run<2, 2, 0>(lds, ksrc, (size_t)64 * 512, vsrc, NT, (qmin + 31) / 64 + 1, cmp, qr, maskf, o, l, tid, r32, hi);
    }
    l += __shfl_xor(l, 32);
    const float inv = 1.0f / l;
    LAS float* xch = (LAS float*)lds + (size_t)sub * 64 * 64 + lane;
    if (cmp == 1) {
#pragma unroll
        for (int db = 0; db < 4; ++db)
#pragma unroll
            for (int r = 0; r < 16; ++r) xch[(db * 16 + r) * 64] = o[db][r] * inv;
    }
    __syncthreads();
    if (cmp == 0) {
        float ss = 0.0f;
#pragma unroll
        for (int db = 0; db < 4; ++db)
#pragma unroll
            for (int r = 0; r < 16; ++r) { const float v = o[db][r] * inv - lam * xch[(db * 16 + r) * 64]; o[db][r] = v; ss += v * v; }
        ss += __shfl_xor(ss, 32);
        const float rstd = rsqrtf(ss * (1.0f / 128.0f) + EPS) * outscale;
        bf16_t* dst = OC + (size_t)(h >> 1) * T * 256 + (tok0 + q) * 256 + (h & 1) * 128;
#pragma unroll
        for (int db = 0; db < 4; ++db)
#pragma unroll
            for (int g = 0; g < 4; g += 2) { const int d = 32 * db + 8 * g + 4 * hi; const f32x4 sg = *(const f32x4*)(subg + d), sh = *(const f32x4*)(subg + d + 8);
                u32x2 a, b; a.x = pk2(o[db][4 * g] * rstd * sg[0], o[db][4 * g + 1] * rstd * sg[1]); a.y = pk2(o[db][4 * g + 2] * rstd * sg[2], o[db][4 * g + 3] * rstd * sg[3]);
                b.x = pk2(o[db][4 * g + 4] * rstd * sh[0], o[db][4 * g + 5] * rstd * sh[1]); b.y = pk2(o[db][4 * g + 6] * rstd * sh[2], o[db][4 * g + 7] * rstd * sh[3]);
                store_pair16(dst + 32 * db + 8 * g, a, b, hi); }
    }
    __syncthreads();
}

__device__ __forceinline__ unsigned f2key(float v) { unsigned b = __float_as_uint(v); if ((b << 1) == 0u) b = 0u; return (b & 0x80000000u) ? ~b : (b | 0x80000000u); }
__device__ __forceinline__ float key2f(unsigned k) { return (k & 0x80000000u) ? __uint_as_float(k & 0x7fffffffu) : __uint_as_float(~k); }
#define ROR_(v, n) ((unsigned)__builtin_amdgcn_update_dpp(0, (int)(v), 0x120 + (n), 0xf, 0xf, false))
__device__ __forceinline__ unsigned wave_max_u32(unsigned v) {
    v = max(v, ROR_(v, 1)); v = max(v, ROR_(v, 2)); v = max(v, ROR_(v, 4)); v = max(v, ROR_(v, 8));
    { auto r = __builtin_amdgcn_permlane16_swap(v, v, false, false); v = max((unsigned)r[0], (unsigned)r[1]); }
    { auto r = __builtin_amdgcn_permlane32_swap(v, v, false, false); v = max((unsigned)r[0], (unsigned)r[1]); }
    return v;
}
__device__ __forceinline__ unsigned wave_min_u32(unsigned v) { return ~wave_max_u32(~v); }
__device__ __forceinline__ unsigned wave_add_u32(unsigned v) {
    v += ROR_(v, 1); v += ROR_(v, 2); v += ROR_(v, 4); v += ROR_(v, 8);
    { auto r = __builtin_amdgcn_permlane16_swap(v, v, false, false); v = (unsigned)r[0] + (unsigned)r[1]; }
    { auto r = __builtin_amdgcn_permlane32_swap(v, v, false, false); v = (unsigned)r[0] + (unsigned)r[1]; }
    return v;
}
__device__ __forceinline__ int count_ge(const unsigned (&u)[32], unsigned thr, int ng) {
    int c = 0;
#pragma unroll
    for (int g = 0; g < 4; ++g) if (g < ng) {
        unsigned long long m0, m1, m2, m3, m4, m5, m6, m7;
        asm("v_cmp_ge_u32_e64 %0, %8, %16\n\tv_cmp_ge_u32_e64 %1, %9, %16\n\tv_cmp_ge_u32_e64 %2, %10, %16\n\tv_cmp_ge_u32_e64 %3, %11, %16\n\t"
            "v_cmp_ge_u32_e64 %4, %12, %16\n\tv_cmp_ge_u32_e64 %5, %13, %16\n\tv_cmp_ge_u32_e64 %6, %14, %16\n\tv_cmp_ge_u32_e64 %7, %15, %16"
            : "=&s"(m0), "=&s"(m1), "=&s"(m2), "=&s"(m3), "=&s"(m4), "=&s"(m5), "=&s"(m6), "=&s"(m7)
            : "v"(u[8 * g]), "v"(u[8 * g + 1]), "v"(u[8 * g + 2]), "v"(u[8 * g + 3]), "v"(u[8 * g + 4]), "v"(u[8 * g + 5]), "v"(u[8 * g + 6]), "v"(u[8 * g + 7]), "v"(thr));
        c += (__popcll(m0) + __popcll(m1)) + (__popcll(m2) + __popcll(m3)) + (__popcll(m4) + __popcll(m5)) + (__popcll(m6) + __popcll(m7));
    }
    return c;
}
__device__ __forceinline__ unsigned pick_mid(unsigned lo, unsigned hi, int clo, int chi, int it) {
    const unsigned span = hi - lo;
    const float flo = key2f(lo), fhi = key2f(hi - 1u);
    const float fr = (it & 1) ? 0.5f : ((float)(clo - 256) - 0.5f) * fast_rcp((float)(clo - chi));
    unsigned mid = f2key(flo + fr * (fhi - flo));
    if ((it & 1) && it >= 16) mid = lo + (span >> 1);
    if (mid <= lo || mid >= hi) mid = lo + (span >> 1);
    return mid;
}
#define WRITELANE2(lo_, hi_, bal_, i_) asm("s_nop 1\n\tv_writelane_b32 %0, %2, %4\n\tv_writelane_b32 %1, %3, %4" : "+v"(lo_), "+v"(hi_) : "s"((unsigned)(bal_)), "s"((unsigned)((bal_) >> 32)), "n"(i_))
__device__ __forceinline__ void write_mask_row(const unsigned (&u)[32], unsigned thr, int clo, int ng, LAS unsigned* bm, int lane) {
    int wlo = 0, whi = 0;
    if (clo == 256) {
#pragma unroll
        for (int i = 0; i < 32; ++i) { const unsigned long long bal = __ballot(u[i] >= thr); WRITELANE2(wlo, whi, bal, i); }
    } else {
        const int need = 256 - count_ge(u, thr + 1u, ng);
        int run = 0; const unsigned long long below = (1ull << lane) - 1ull;
#pragma unroll
        for (int i = 0; i < 32; ++i) {
            const unsigned long long eq = __ballot(u[i] == thr); const int rank = run + __popcll(eq & below);
            const unsigned long long bal = __ballot(u[i] > thr || (u[i] == thr && rank < need)); run += __popcll(eq);
            WRITELANE2(wlo, whi, bal, i);
        }
    }
    if (lane < 32) { u32x2 w; w.x = (unsigned)wlo; w.y = (unsigned)whi; *(LAS u32x2*)(bm + 2 * lane) = w; }
}
__device__ __forceinline__ void compact_row(const unsigned (&u)[32], unsigned lo, unsigned hi, int ng, LAS unsigned* scr, int lane, unsigned& c0, unsigned& c1) {
    int base = 0;
#pragma unroll
    for (int g = 0; g < 4; ++g) if (g < ng) {
#pragma unroll
        for (int i = 8 * g; i < 8 * g + 8; ++i) {
            const bool inb = u[i] >= lo && u[i] < hi;
            const unsigned long long bal = __ballot(inb);
            const int pos = base + (int)__builtin_amdgcn_mbcnt_hi((unsigned)(bal >> 32), __builtin_amdgcn_mbcnt_lo((unsigned)bal, 0u));
            if (inb) scr[pos] = u[i];
            base += __popcll(bal);
        }
    }
    asm volatile("s_waitcnt lgkmcnt(0)" ::: "memory");
    c0 = lane < base ? scr[lane] : 0u; c1 = 64 + lane < base ? scr[64 + lane] : 0u;
}
__device__ __forceinline__ void select_rows2(const unsigned (&va)[32], const unsigned (&vb)[32], int ta, int tb, LAS unsigned* bma, LAS unsigned* bmb, LAS unsigned* scr, int lane) {
    const int na = ta + 1, nb = tb + 1;
    if (nb <= 256) {
        const int ca = na - 32 * lane, cb = nb - 32 * lane;
        bma[lane] = ca >= 32 ? 0xffffffffu : (ca <= 0 ? 0u : ((1u << ca) - 1u)); bmb[lane] = cb >= 32 ? 0xffffffffu : (cb <= 0 ? 0u : ((1u << cb) - 1u)); return; }
    const int ng = (nb + 511) >> 9;
    unsigned ua[32], ub[32];
    unsigned mxa = 0u, mna = 0xffffffffu, mxb = 0u, mnb = 0xffffffffu;
#pragma unroll
    for (int i = 0; i < 32; ++i) { const bool oka = 64 * i + lane <= ta, okb = 64 * i + lane <= tb; ua[i] = oka ? va[i] : 0u; ub[i] = okb ? vb[i] : 0u;
        mxa = max(mxa, ua[i]); mna = min(mna, oka ? va[i] : 0xffffffffu); mxb = max(mxb, ub[i]); mnb = min(mnb, okb ? vb[i] : 0xffffffffu); }
    mxa = (unsigned)__builtin_amdgcn_readfirstlane((int)wave_max_u32(mxa)); mna = (unsigned)__builtin_amdgcn_readfirstlane((int)wave_min_u32(mna));
    mxb = (unsigned)__builtin_amdgcn_readfirstlane((int)wave_max_u32(mxb)); mnb = (unsigned)__builtin_amdgcn_readfirstlane((int)wave_min_u32(mnb));
    unsigned loa = mna, hia = mxa + 1u, lob = mnb, hib = mxb + 1u;
    int cloa = na, chia = 0, clob = nb, chib = 0;
    bool acta = na > 256, actb = true;
    int it = 0;
    for (; it < 96 && ((acta && cloa - chia > 128) || (actb && clob - chib > 128)); ++it) {
        const unsigned mida = acta ? pick_mid(loa, hia, cloa, chia, it) : loa, midb = actb ? pick_mid(lob, hib, clob, chib, it) : lob;
        int ca = 0, cb = 0;
#pragma unroll
        for (int g = 0; g < 4; ++g) if (g < ng) {
            unsigned long long m0, m1, m2, m3, m4, m5, m6, m7, q0, q1, q2, q3, q4, q5, q6, q7;
            asm("v_cmp_ge_u32_e64 %0, %8, %16\n\tv_cmp_ge_u32_e64 %1, %9, %16\n\tv_cmp_ge_u32_e64 %2, %10, %16\n\tv_cmp_ge_u32_e64 %3, %11, %16\n\t"
                "v_cmp_ge_u32_e64 %4, %12, %16\n\tv_cmp_ge_u32_e64 %5, %13, %16\n\tv_cmp_ge_u32_e64 %6, %14, %16\n\tv_cmp_ge_u32_e64 %7, %15, %16"
                : "=&s"(m0), "=&s"(m1), "=&s"(m2), "=&s"(m3), "=&s"(m4), "=&s"(m5), "=&s"(m6), "=&s"(m7)
                : "v"(ua[8 * g]), "v"(ua[8 * g + 1]), "v"(ua[8 * g + 2]), "v"(ua[8 * g + 3]), "v"(ua[8 * g + 4]), "v"(ua[8 * g + 5]), "v"(ua[8 * g + 6]), "v"(ua[8 * g + 7]), "v"(mida));
            asm("v_cmp_ge_u32_e64 %0, %8, %16\n\tv_cmp_ge_u32_e64 %1, %9, %16\n\tv_cmp_ge_u32_e64 %2, %10, %16\n\tv_cmp_ge_u32_e64 %3, %11, %16\n\t"
                "v_cmp_ge_u32_e64 %4, %12, %16\n\tv_cmp_ge_u32_e64 %5, %13, %16\n\tv_cmp_ge_u32_e64 %6, %14, %16\n\tv_cmp_ge_u32_e64 %7, %15, %16"
                : "=&s"(q0), "=&s"(q1), "=&s"(q2), "=&s"(q3), "=&s"(q4), "=&s"(q5), "=&s"(q6), "=&s"(q7)
                : "v"(ub[8 * g]), "v"(ub[8 * g + 1]), "v"(ub[8 * g + 2]), "v"(ub[8 * g + 3]), "v"(ub[8 * g + 4]), "v"(ub[8 * g + 5]), "v"(ub[8 * g + 6]), "v"(ub[8 * g + 7]), "v"(midb));
            ca += (__popcll(m0) + __popcll(m1)) + (__popcll(m2) + __popcll(m3)) + (__popcll(m4) + __popcll(m5)) + (__popcll(m6) + __popcll(m7));
            cb += (__popcll(q0) + __popcll(q1)) + (__popcll(q2) + __popcll(q3)) + (__popcll(q4) + __popcll(q5)) + (__popcll(q6) + __popcll(q7));
        }
        if (acta) { if (ca >= 256) { loa = mida; cloa = ca; } else { hia = mida; chia = ca; } acta = ca != 256 && hia - loa > 1u; }
        if (actb) { if (cb >= 256) { lob = midb; clob = cb; } else { hib = midb; chib = cb; } actb = cb != 256 && hib - lob > 1u; }
    }
    if (acta || actb) {
        unsigned a0 = 0u, a1 = 0u, b0 = 0u, b1 = 0u;
        const int basea = chia, baseb = chib;
        if (acta) compact_row(ua, loa, hia, ng, scr, lane, a0, a1);
        if (actb) compact_row(ub, lob, hib, ng, scr + 128, lane, b0, b1);
        for (; it < 200 && (acta || actb); ++it) {
            const unsigned mida = acta ? pick_mid(loa, hia, cloa, chia, it) : loa, midb = actb ? pick_mid(lob, hib, clob, chib, it) : lob;
            const int ca = basea + __popcll(__ballot(a0 >= mida)) + __popcll(__ballot(a1 >= mida));
            const int cb = baseb + __popcll(__ballot(b0 >= midb)) + __popcll(__ballot(b1 >= midb));
            if (acta) { if (ca >= 256) { loa = mida; cloa = ca; } else { hia = mida; chia = ca; } acta = ca != 256 && hia - loa > 1u; }
            if (actb) { if (cb >= 256) { lob = midb; clob = cb; } else { hib = midb; chib = cb; } actb = cb != 256 && hib - lob > 1u; }
        }
    }
    if (na <= 256) { const int c = na - 32 * lane; bma[lane] = c >= 32 ? 0xffffffffu : (c <= 0 ? 0u : ((1u << c) - 1u)); }
    else write_mask_row(ua, loa, cloa, ng, bma, lane);
    write_mask_row(ub, lob, clob, ng, bmb, lane);
}

__device__ __forceinline__ void dsa_unit(const bf16_t* QA, const bf16_t* KA, const bf16_t* VAT, const bf16_t* QI, const bf16_t* KI, const float* WI, float* strip, bf16_t* OA,
                                         LAS unsigned char* lds, int b, int qblk) {
    const int tid = fresh_tid(), lane = tid & 63, r32 = lane & 31, hi = lane >> 5, wid = __builtin_amdgcn_readfirstlane(tid >> 6);
    const size_t tok0 = (size_t)b * SEQ;
    constexpr int BM_OFF = 4 * KT_BYTES;
    constexpr int QI_OFF = BM_OFF + 64 * 256, QI_PITCH = 1040, WI_OFF = QI_OFF + 32 * QI_PITCH, SCR_OFF = WI_OFF + 1024;
    LAS unsigned* bm = (LAS unsigned*)(lds + BM_OFF);
    for (int s = 0; s < 2; ++s) {
        const int qt = 2 * qblk + s;
        {
            { const int row = tid >> 4, ch = tid & 15;
              const u32x4* src = (const u32x4*)(QI + (tok0 + 32 * qt + row) * 512 + ch * 32);
              LAS u32x4* dq = (LAS u32x4*)(lds + QI_OFF + row * QI_PITCH + ch * 64);
              const u32x4 a0 = src[0], a1 = src[1], a2 = src[2], a3 = src[3]; dq[0] = a0; dq[1] = a1; dq[2] = a2; dq[3] = a3; }
            if (tid < 256) { const int row = tid >> 3, hh = tid & 7; ((LAS float*)(lds + WI_OFF))[row * 8 + hh] = WI[(tok0 + 32 * qt + row) * 8 + hh]; }
            __syncthreads();
            const LAS unsigned char* qb = lds + QI_OFF + r32 * QI_PITCH + hi * 16;
            const LAS float* wl = (const LAS float*)(lds + WI_OFF) + r32 * 8;
            for (int rep1 = 0; rep1 < 1 + (DSA_REP & 1); ++rep1) {
            bf16x8 kfn[4];
            if (wid <= qt) {
#pragma unroll
                for (int d0 = 0; d0 < 4; ++d0) kfn[d0] = *(const bf16x8*)(KI + (tok0 + 32 * wid + r32) * 64 + d0 * 16 + hi * 8); }
            for (int kt = wid; kt <= qt; kt += NWAVES) {
                bf16x8 kf[4];
#pragma unroll
                for (int d0 = 0; d0 < 4; ++d0) kf[d0] = kfn[d0];
                if (kt + NWAVES <= qt) {
#pragma unroll
                    for (int d0 = 0; d0 < 4; ++d0) kfn[d0] = *(const bf16x8*)(KI + (tok0 + 32 * (kt + NWAVES) + r32) * 64 + d0 * 16 + hi * 8); }
                f32x16 isc;
#pragma unroll
                for (int r = 0; r < 16; ++r) isc[r] = 0.0f;
#pragma unroll 1
                for (int hh = 0; hh < 8; ++hh) {
                    f32x16 lg;
#pragma unroll
                    for (int r = 0; r < 16; ++r) lg[r] = 0.0f;
#pragma unroll
                    for (int d0 = 0; d0 < 4; ++d0) { const bf16x8 qf = *(const LAS bf16x8*)(qb + hh * 128 + d0 * 32); lg = mfma32(kf[d0], qf, lg); }
                    const float w = wl[hh];
#pragma unroll
                    for (int r = 0; r < 16; ++r) isc[r] += fmaxf(lg[r], 0.0f) * w;
                }
                float* sp = strip + (size_t)r32 * SEQ + 32 * kt + 4 * hi;
#pragma unroll
                for (int g = 0; g < 4; ++g) *(u32x4*)(sp + 8 * g) = (u32x4){f2key(isc[4 * g]), f2key(isc[4 * g + 1]), f2key(isc[4 * g + 2]), f2key(isc[4 * g + 3])};
            }
            }
        }
        asm volatile("s_waitcnt vmcnt(0)" ::: "memory");
        __syncthreads();
        for (int rep2 = 0; rep2 < 1 + ((DSA_REP >> 1) & 1); ++rep2) {
#pragma unroll 1
            for (int rp = 0; rp < 2; ++rp) {
                unsigned v2[2][32];
#pragma unroll
                for (int rr = 0; rr < 2; ++rr)
#pragma unroll
                    for (int i = 0; i < 32; ++i) v2[rr][i] = ((const unsigned*)strip)[(size_t)(wid + 8 * (2 * rp + rr)) * SEQ + 64 * i + lane];
                { const int ra = wid + 16 * rp, rb = ra + 8; select_rows2(v2[0], v2[1], 32 * qt + ra, 32 * qt + rb, bm + (32 * s + ra) * 64, bm + (32 * s + rb) * 64, (LAS unsigned*)(lds + SCR_OFF) + wid * 256, lane); }
            }
        }
        __syncthreads();
    }
    const int head = wid & 3, sub = wid >> 2;
    const int q = 64 * qblk + 32 * sub + r32;
    bf16x8 qr[4];
    { const bf16_t* qp = QA + (tok0 + q) * 256 + head * 64 + hi * 8;
#pragma unroll
      for (int d0 = 0; d0 < 4; ++d0) qr[d0] = *(const bf16x8*)(qp + d0 * 16); }
    const int NT = qblk + 1;
    const int srow = tid >> 3, sch = tid & 7;
    const bf16_t* const ksrc[1] = {KA + (tok0 + srow) * 64 + sch * 8};
    const bf16_t* const vsrc[1] = {VAT + ((size_t)b * 64 + srow) * SEQ + sch * 8};
    for (int rep3 = 0; rep3 < 1 + ((DSA_REP >> 2) & 1); ++rep3) {
    f32x16 o[2]; float l = 0.0f;
#pragma unroll
    for (int db = 0; db < 2; ++db)
#pragma unroll
        for (int r = 0; r < 16; ++r) o[db][r] = 0.0f;
    const LAS unsigned* bmq = bm + (32 * sub + r32) * 64;
    struct MaskBits { const LAS unsigned* bmq; int hi;
        __device__ __forceinline__ void pre(f32x16&, f32x16&, int) const {}
        __device__ __forceinline__ void pbits(int t, unsigned& w0, unsigned& w1) const { w0 = bmq[2 * t] >> (8 * hi); w1 = bmq[2 * t + 1] >> (8 * hi); } };
    const MaskBits maskf{bmq, hi};
    flash_run<1, 1, 1>(lds, ksrc, (size_t)64 * 64, vsrc, NT, NT, 0, qr, maskf, o, l, tid, r32, hi);
    l += __shfl_xor(l, 32);
    store_o<2>(o, 1.0f / l, OA + (tok0 + q) * 256 + head * 64, hi);
    }
}
}

__device__ __forceinline__ void phase_attention(const Ctx& c, LAS unsigned char* lds, int layer) {
    unsigned char* A = c.ws + WS_A;
    const bf16_t *QA = (const bf16_t*)(A + A_QA), *KA = (const bf16_t*)(A + A_KA), *VAT = (const bf16_t*)(A + A_VAT), *QI = (const bf16_t*)(A + A_QI), *KI = (const bf16_t*)(A + A_KI);
    const float* WI = (const float*)(A + A_WI);
    const bf16_t *QB = (const bf16_t*)(A + A_QB), *KB = (const bf16_t*)(A + A_KB), *VBT = (const bf16_t*)(A + A_VBT), *QC = (const bf16_t*)(A + A_QC), *KC = (const bf16_t*)(A + A_KC), *VCT = (const bf16_t*)(A + A_VCT);
    bf16_t *OA = (bf16_t*)((unsigned char*)c.out + DO_O), *OB = OA + (size_t)T * 256, *OC = OB + (size_t)T * 256;
    const float* kmean = (const float*)(c.ws + WS_CTL + CTL_KMEAN) + (size_t)layer * (16 * 4 * 8 * 2 * 64);
    float* strip = (float*)(c.ws + WS_G) + (size_t)blockIdx.x * 32 * SEQ;
    const int tid = fresh_tid();
    const int grp = (int)blockIdx.x & 7;
    constexpr int QUEUE_LDS_OFF = 131072 + 1024;
    LAS unsigned short* order = (LAS unsigned short*)(lds + QUEUE_LDS_OFF);
    LAS unsigned* tick = (LAS unsigned*)(lds + QUEUE_LDS_OFF + 512);
    unsigned* qctr = (unsigned*)(c.ws + WS_CTL + 32768) + (size_t)(layer * 8 + grp) * 64;
    auto cost_of = [](int e) -> int { return e < 64 ? 79 * ((e & 31) + 1) : e < 128 ? 92 * ((e & 7) + 1) : 51 * ((e & 15) + 1); };
    if (tid < 256) { const int ce = cost_of(tid); int rank = 0;
        for (int o = 0; o < 256; ++o) { const int co = cost_of(o); rank += (co > ce || (co == ce && o < tid)) ? 1 : 0; }
        order[rank] = (unsigned short)tid; }
    if (tid == 0) tick[0] = __hip_atomic_fetch_add(qctr, 1u, __ATOMIC_RELAXED, __HIP_MEMORY_SCOPE_AGENT);
    const float* lp = c.lam_p + (size_t)layer * 4 * 64; const int lane = tid & 63;
    const float s1 = wave_sum(lp[lane] * lp[64 + lane]), s2 = wave_sum(lp[128 + lane] * lp[192 + lane]);
    const float lam_init = 0.8f - 0.6f * expf(-0.3f * (float)layer);
    const float lam = __int_as_float(__builtin_amdgcn_readfirstlane(__float_as_int(expf(s1) - expf(s2) + lam_init)));
    const float outscale = __int_as_float(__builtin_amdgcn_readfirstlane(__float_as_int(1.0f - lam_init)));
    const float* subg = c.subln_g + (size_t)layer * 128;
    __syncthreads();
    for (;;) {
        const unsigned cur = tick[0];
        __syncthreads();
        if (cur >= 256u) break;
        unsigned nxt = 0u;
        if (tid == 0) nxt = __hip_atomic_fetch_add(qctr, 1u, __ATOMIC_RELAXED, __HIP_MEMORY_SCOPE_AGENT);
        const int e = order[cur];
        if (e < 64) att::dsa_unit(QA, KA, VAT, QI, KI, WI, strip, OA, lds, 2 * grp + (e >> 5), e & 31);
        else if (e < 128) att::moba_unit(QB, KB, VBT, kmean, OB, lds, 2 * grp + ((e >> 5) & 1), (e >> 3) & 3, e & 7);
        else att::diff_unit(QC, KC, VCT, OC, lds, grp + 8 * ((e >> 6) & 1), (e >> 4) & 3, e & 15, lam, outscale, subg);
        __syncthreads();
        if (tid == 0) tick[0] = nxt;
        __syncthreads();
    }
}

constexpr int RING_BYTES = 131072, MISC_OFF = RING_BYTES, GAIN_LDS_OFF = MISC_OFF + 1024, LDS_BYTES = 147456;
struct Args { const void* in[12]; float* out; unsigned char* ws; int ph_lo, ph_hi; };
static_assert(sizeof(Args) == 12 * 8 + 8 + 8 + 8, "Args has no padding");

__global__ void __launch_bounds__(NTHREADS, 2) hybrid_fwd(Args args) {
    extern __shared__ __attribute__((aligned(16))) unsigned char lds_raw[];
    LAS unsigned char* lds = (LAS unsigned char*)lds_raw;
    volatile LAS unsigned* MISC = (volatile LAS unsigned*)(lds + MISC_OFF);
    const int tid = threadIdx.x;
    if (tid < 64) MISC[tid] = 0u;
    __syncthreads();
    Ctx c;
    c.x_in = (const float*)args.in[0]; c.pos = (const int*)args.in[1]; c.norm_g = (const float*)args.in[2]; c.w_in = (const float*)args.in[3]; c.qk_g = (const float*)args.in[4];
    c.lam_p = (const float*)args.in[5]; c.subln_g = (const float*)args.in[6]; c.w_branch = (const float*)args.in[7]; c.w_out = (const float*)args.in[8];
    c.w_gate = (const float*)args.in[9]; c.w_up = (const float*)args.in[10]; c.w_down = (const float*)args.in[11];
    c.out = args.out; c.ws = args.ws;
    const int lo = args.ph_lo, hi = args.ph_hi;
    unsigned* ctl = (unsigned*)(c.ws + WS_CTL);
    XcdBarrier bar; bar.bar = ctl + CW_BAR; bar.x = 0u; bar.st = MISC + 8;
    if (hi - lo > 1) bar = xcd_barrier_post(ctl + CW_BAR, MISC + 8);
#ifndef PH_MASK
#define PH_MASK 0xffu
#endif
#define PHE(id) ((PH_MASK >> (id)) & 1u)
#ifndef REP_MASK
#define REP_MASK 0u
#endif
#define REPN(id) (1 + (int)((REP_MASK >> (id)) & 1u))
#define IN(k) (lo <= (k) && (k) < hi)
#define SEAM(k) do { if (lo <= (k) && (k) + 1 < hi) xcd_barrier(bar); } while (0)
    const int G = gridDim.x, cb = blockIdx.x;
#define LYR() ({ int l_ = layer; asm volatile("" : "+s"(l_)); l_; })
#define WSL() ({ __attribute__((address_space(1))) unsigned char* p_ = (__attribute__((address_space(1))) unsigned char*)c.ws; asm volatile("" : "+s"(p_)); (unsigned char*)p_; })
#define OUTL() ({ __attribute__((address_space(1))) unsigned char* p_ = (__attribute__((address_space(1))) unsigned char*)c.out; asm volatile("" : "+s"(p_)); (unsigned char*)p_; })
#define H8 ((signed char*)(WSL() + WS_H8))
#define SA ((float*)(WSL() + WS_CTL + CTL_SA))
#define XB ((bf16_t*)(WSL() + WS_XB))
#define ACT ((bf16_t*)(WSL() + WS_A))
#define MRG ((bf16_t*)(WSL() + WS_A))
#define GB (WSL() + WS_G)
#define OA ((bf16_t*)(OUTL() + DO_O))
#define H ((bf16_t*)(OUTL() + DO_H))

    if (IN(0) && PHE(0)) for (int rep = 0; rep < REPN(0); ++rep) { phase_prologue(c, lds); prologue_i8<0>(c, lds); }
    SEAM(0);
    for (int layer = 0; layer < 2; ++layer) {
        const int base = 1 + 11 * layer;
        bf16_t* WL = wlayer(c, layer);
        if (IN(base + 0) && PHE(1)) for (int rep = 0; rep < REPN(1); ++rep) { if (LYR() == 0) { prologue_i8<1>(c, lds); phase_norm<false, false, true>(c.x_in, H, H8, SA); } else phase_norm<true, false, true>(XB, H, H8, SA); }
        SEAM(base + 0);
        if (IN(base + 1) && PHE(2)) for (int rep = 0; rep < REPN(2); ++rep) { pg8::Gemm g{(const bf16_t*)H8, WL + WL_GU, T, 5632, D / 2}; pg8::StaticOrder S; S.init(T, 5632, G, cb);
            EpiSwigluI8 E{ACT, SA, (const float*)(c.ws + WS_CTL + CTL_CMAX) + (size_t)layer * CMAX_PER_LAYER};
            pg8::gemm_phase<EpiSwigluI8, pg8::StaticOrder, true, true, true>(lds, g, S, E); }
        SEAM(base + 1);
        if (IN(base + 2) && PHE(3)) { pg8::Gemm g{ACT, WL + WL_DN, T, D, DFF}; RevOrder S; S.init(T, D, G, cb);
            if (LYR() == 0) { EpiResid<false, true> E{c.x_in, XB, 0.5f}; pg8::gemm_phase<EpiResid<false, true>, RevOrder, true, true>(lds, g, S, E); }
            else { EpiResid<true, true> E{XB, XB, 0.5f}; pg8::gemm_phase<EpiResid<true, true>, RevOrder, true, true>(lds, g, S, E); } }
        SEAM(base + 2);
        if (IN(base + 3) && PHE(1)) for (int rep = 0; rep < REPN(1); ++rep) phase_norm<true, false, true>(XB, H, H8, SA);
        SEAM(base + 3);
        if (IN(base + 4) && PHE(4)) for (int rep = 0; rep < REPN(4); ++rep) { pg8::Gemm g{(const bf16_t*)H8, WL + WL_IN, T, NINP, D / 2}; pg8::StaticOrder S; S.init(T, NINP, G, cb);
            { const int t_ = fresh_tid(); if (t_ < 384) ((LAS float*)(lds + GAIN_LDS_OFF))[t_] = c.qk_g[(size_t)layer * 6 * 64 + t_];
              const float* cm_ = (const float*)(WSL() + WS_CTL + CTL_CMAX) + (size_t)layer * CMAX_PER_LAYER + 2 * 5632 + 3072;
              for (int i_ = t_; i_ < NINP; i_ += NTHREADS) ((LAS float*)(lds + GAIN_LDS_OFF + 1536))[i_] = cm_[i_] * (1.0f / 127.0f);
              __syncthreads(); }
            EpiInProjT<true> E{c.ws, lds + GAIN_LDS_OFF, layer};
            pg8::gemm_phase<EpiInProjT<true>, pg8::StaticOrder, true, true, true>(lds, g, S, E); }
        SEAM(base + 4);
        if (IN(base + 5) && PHE(5)) phase_attention(c, lds, layer);
        SEAM(base + 5);
        if (IN(base + 6) && PHE(6)) for (int rep = 0; rep < REPN(6); ++rep) {
            for (int rg = 0; rg < REPN(8); ++rg) { pg8::Gemm g{(const bf16_t*)H8, WL + WL_GT, T, 3 * D, D / 2}; GateOrder S; S.base.init(T, D, G, cb);
              EpiGateI8 E{GB, SA, (const float*)(c.ws + WS_CTL + CTL_CMAX) + (size_t)layer * CMAX_PER_LAYER + 2 * 5632};
              pg8::gemm_phase<EpiGateI8, GateOrder, true, true, true>(lds, g, S, E); }
            for (int rs = 0; rs < REPN(9); ++rs) { pg8::Gemm g{OA, WL + WL_BR, T, D, 256, (size_t)T * 256 * 2, (size_t)1024 * 256 * 2}; SegOrder S; S.base.init(T, D, G, cb); EpiMergeSeg E{GB, MRG};
              pg8::gemm_phase<EpiMergeSeg, SegOrder, true, true>(lds, g, S, E); }
        }
        SEAM(base + 6);
        if (IN(base + 7) && PHE(7)) { pg8::Gemm g{MRG, WL + WL_OUT, T, D, D}; pg8::StaticOrder S; S.init(T, D, G, cb); EpiResid<true, true> E{XB, XB, 1.0f};
            pg8::gemm_phase<EpiResid<true, true>, pg8::StaticOrder, true, true>(lds, g, S, E); }
        SEAM(base + 7);
        if (IN(base + 8) && PHE(1)) for (int rep = 0; rep < REPN(1); ++rep) phase_norm<true, false, true>(XB, H, H8, SA);
        SEAM(base + 8);
        if (IN(base + 9) && PHE(2)) for (int rep = 0; rep < REPN(2); ++rep) { pg8::Gemm g{(const bf16_t*)H8, WL + WL_GU + (size_t)5632 * 1024, T, 5632, D / 2}; pg8::StaticOrder S; S.init(T, 5632, G, cb);
            EpiSwigluI8 E{ACT, SA, (const float*)(c.ws + WS_CTL + CTL_CMAX) + (size_t)layer * CMAX_PER_LAYER + 5632};
            pg8::gemm_phase<EpiSwigluI8, pg8::StaticOrder, true, true, true>(lds, g, S, E); }
        SEAM(base + 9);
        if (IN(base + 10) && PHE(3)) { pg8::Gemm g{ACT, WL + WL_DN + (size_t)1024 * 2816, T, D, DFF}; RevOrder S; S.init(T, D, G, cb);
            if (LYR() == 1) { EpiResid<true, false> E{XB, c.out, 0.5f}; pg8::gemm_phase<EpiResid<true, false>, RevOrder, true, true>(lds, g, S, E); }
            else { EpiResid<true, true> E{XB, XB, 0.5f}; pg8::gemm_phase<EpiResid<true, true>, RevOrder, true, true>(lds, g, S, E); } }
        SEAM(base + 10);
    }
#undef IN
#undef SEAM
#undef WSL
#undef LYR
#undef OUTL
#undef H8
#undef SA
#undef XB
#undef ACT
#undef MRG
#undef GB
#undef OA
#undef H
}
#define MK_AFTER_PHASE(p) do {} while (0)

extern "C" void kernel_launch(void* const* d_in, const int* in_sizes, int n_in, void* d_out, int out_size, void* d_ws, size_t ws_size, hipStream_t stream) {
    static int grid = 0;
    if (grid == 0) {
        if (n_in != 12 || in_sizes[0] != T * D || out_size != T * D || ws_size < WS_END) {
            fprintf(stderr, "kernel_launch: unexpected shapes (n_in %d, in0 %d, out %d, ws %zu < %zu); nothing launched\n", n_in, n_in > 0 ? in_sizes[0] : -1, out_size, ws_size, (size_t)WS_END); grid = -1; return; }
        int dev = 0, cus = 0, per_cu = 0;
        if (hipGetDevice(&dev) != hipSuccess || hipDeviceGetAttribute(&cus, hipDeviceAttributeMultiprocessorCount, dev) != hipSuccess) { grid = -1; return; }
        if (hipFuncSetAttribute((const void*)hybrid_fwd, hipFuncAttributeMaxDynamicSharedMemorySize, LDS_BYTES) != hipSuccess) { fprintf(stderr, "kernel_launch: hipFuncSetAttribute failed\n"); grid = -1; return; }
        if (hipOccupancyMaxActiveBlocksPerMultiprocessor(&per_cu, (const void*)hybrid_fwd, NTHREADS, LDS_BYTES) != hipSuccess || per_cu < 1)
            fprintf(stderr, "kernel_launch: occupancy query reports %d workgroups per CU\n", per_cu);
        (void)hipGetLastError();
        grid = cus > 0 ? cus : 256;
        if (grid > 256) grid = 256;
    }
    if (grid < 0) return;
    (void)hipMemsetAsync((char*)d_ws + WS_CTL, 0, CTL_BYTES, stream);
    Args a{};
    for (int i = 0; i < 12; ++i) a.in[i] = d_in[i];
    a.out = (float*)d_out; a.ws = (unsigned char*)d_ws;
#if MK_N_LAUNCHES == 1
    a.ph_lo = 0; a.ph_hi = NPHASE;
    hipLaunchKernelGGL(hybrid_fwd, dim3(grid), dim3(NTHREADS), LDS_BYTES, stream, a);
#else
    for (int p = 0; p < NPHASE; ++p) {
        a.ph_lo = p; a.ph_hi = p + 1;
        hipLaunchKernelGGL(hybrid_fwd, dim3(grid), dim3(NTHREADS), LDS_BYTES, stream, a);
        MK_AFTER_PHASE(p);
    }
#endif
}
```

```cpp
#include <hip/hip_runtime.h>
#include <cstdio>
#include <cstdint>
#ifndef MK_N_LAUNCHES
#define MK_N_LAUNCHES 1
#endif
#ifndef MK_CHECKS
#define MK_CHECKS 0
#endif
__device__ __forceinline__ int fresh_tid() { int t = threadIdx.x; asm volatile("" : "+v"(t)); return t; }
#ifndef ATT_MASK
#define ATT_MASK 7
#endif
#ifndef ATT_REP
#define ATT_REP 0
#endif
#ifndef DSA_REP
#define DSA_REP 0
#endif
#ifndef DIFF_REP
#define DIFF_REP 0
#endif
namespace pg8 {
#define PG8_LAS __attribute__((address_space(3)))
typedef unsigned short bf16_t;
typedef short bf16x8 __attribute__((ext_vector_type(8)));
typedef float f32x4 __attribute__((ext_vector_type(4)));
typedef unsigned u32x4 __attribute__((ext_vector_type(4)));
constexpr int BM = 256, BK = 64, HALF = 128, HTB = HALF * BK * 2  , STAGE_BYTES = 8 * HTB, NXCD = 8, WGM = 8;

__host__ __device__ __forceinline__ int lds_byte(int r, int c) { const int st = (r >> 4) * 2 + (c >> 5), rr = r & 15, cc = c & 31, ob = rr * 64 + cc * 2; return st * 1024 + (ob ^ (((ob >> 9) & 1) << 5)); }
__host__ __device__ __forceinline__ void stage_rc(int b, int& R, int& C) { const int st = b / 1024, sb = b % 1024, swz = sb ^ (((sb >> 9) & 1) << 5); R = (st >> 1) * 16 + swz / 64; C = (st & 1) * 32 + (swz % 64) / 2; }
__host__ __device__ __forceinline__ int perm32(int rho) { const int n = rho >> 4, i = rho & 15; return 8 * (i >> 2) + 4 * n + (i & 3); }

struct Unit { int pm, pn, seg; };
struct Gemm { const bf16_t* A; const bf16_t* Bt; int M, N, K; size_t segA = 0, segB = 0; };

struct StaticOrder {
    int nM, nN, nwg, G, c;
    __host__ __device__ void init(int M, int N, int G_, int c_) { nM = M / BM; nN = N / BM; nwg = nM * nN; G = G_; c = c_; }
    __host__ __device__ bool next(int i, Unit& u) const {
        const long L = (long)i * G + c; if (L >= nwg) return false;
        int wgid = (int)L; { const int q = nwg / NXCD, r = nwg % NXCD, xcd = wgid % NXCD, off = wgid / NXCD; wgid = (xcd < r ? xcd * (q + 1) : r * (q + 1) + (xcd - r) * q) + off; }
        const int nig = WGM * nN, gid = wgid / nig, fm = gid * WGM, gsz = (nM - fm) < WGM ? (nM - fm) : WGM;
        u.pm = fm + ((wgid % nig) % gsz); u.pn = (wgid % nig) / gsz; u.seg = 0; return true;
    }
    __device__ __forceinline__ void a_ready(const Unit&) const {}
    __device__ __forceinline__ void done(const Unit&) const {}
};

__device__ __forceinline__ unsigned cvt_pk_bf16(float lo, float hi) { unsigned r; asm volatile("v_cvt_pk_bf16_f32 %0, %1, %2" : "=v"(r) : "v"(lo), "v"(hi)); return r; }
typedef float f32x2 __attribute__((ext_vector_type(2)));
typedef int i32x4 __attribute__((ext_vector_type(4)));
template <bool I8> struct MmaOp;
template <> struct MmaOp<false> { typedef f32x4 acc_t; static __device__ __forceinline__ f32x4 mma(bf16x8 b, bf16x8 a, f32x4 c) { return __builtin_amdgcn_mfma_f32_16x16x32_bf16(b, a, c, 0, 0, 0); } };
template <> struct MmaOp<true>  { typedef i32x4 acc_t; static __device__ __forceinline__ i32x4 mma(bf16x8 b, bf16x8 a, i32x4 c) { return __builtin_amdgcn_mfma_i32_16x16x64_i8(__builtin_bit_cast(i32x4, b), __builtin_bit_cast(i32x4, a), c, 0, 0, 0); } };
template <class Epi, class Sched, bool ALIGN_EPI = false, bool SP2 = false, bool I8 = false>
__device__ __forceinline__ void gemm_phase(PG8_LAS unsigned char* lds, const Gemm g, const Sched& S, const Epi& E) {
    const int tid = fresh_tid(), wid = __builtin_amdgcn_readfirstlane(tid >> 6), lane = tid & 63, wr = wid >> 2, wc = wid & 3, fr = lane & 15, fq = lane >> 4;
    const int K = g.K, nt = K / BK;
    unsigned voffA[2], voffB[2];
#pragma unroll
    for (int i = 0; i < 2; ++i) { int R, C; stage_rc(tid * 16 + i * 8192, R, C); const int Rb = Epi::PERM ? ((R & ~31) + perm32(R & 31)) : R;
        voffA[i] = (unsigned)(R * K + C) * 2u; voffB[i] = (unsigned)(Rb * K + C) * 2u; }
    const size_t kstep = (size_t)(BK * 2);
    const size_t hstep = (size_t)HALF * K * 2;
    const size_t tstep = 2 * hstep;
    const unsigned ldsw = (unsigned)wid * 1024u;
    const int aoff = lds_byte(wr * 64 + fr, fq * 8), boff = lds_byte(wc * 32 + fr, fq * 8);
#define PG8_SA(b, h) (((b) * 2 + (h)) * HTB)
#define PG8_SB(b, h) ((4 + (b) * 2 + (h)) * HTB)
#define PG8_STAGE(bufoff, gbase, voff) do { _Pragma("unroll") for (int _i = 0; _i < 2; ++_i) \
        __builtin_amdgcn_global_load_lds((const unsigned*)((const char*)(gbase) + (voff)[_i]), (PG8_LAS unsigned*)(lds + (bufoff) + ldsw + _i * 8192), 16, 0, 0); } while (0)
#define PG8_LDA(dst, b, h) do { _Pragma("unroll") for (int m = 0; m < 4; ++m) _Pragma("unroll") for (int k = 0; k < 2; ++k) dst[m][k] = *(const PG8_LAS bf16x8*)(lds + PG8_SA(b, h) + aoff + m * 2048 + k * 1024); } while (0)
#define PG8_LDB(dst, b, h) do { _Pragma("unroll") for (int n = 0; n < 2; ++n) _Pragma("unroll") for (int k = 0; k < 2; ++k) dst[n][k] = *(const PG8_LAS bf16x8*)(lds + PG8_SB(b, h) + boff + n * 2048 + k * 1024); } while (0)
#define PG8_MMA(ai, bj, At, Bt) do { __builtin_amdgcn_s_setprio(1); _Pragma("unroll") for (int m = 0; m < 4; ++m) _Pragma("unroll") for (int n = 0; n < 2; ++n) _Pragma("unroll") for (int k = 0; k < 2; ++k) \
        acc[ai][bj][m][n] = MmaOp<I8>::mma(Bt[n][k], At[m][k], acc[ai][bj][m][n]); __builtin_amdgcn_s_setprio(0); } while (0)
#define PG8_WAIT_V(n) asm volatile("s_waitcnt vmcnt(" #n ")" ::: "memory")
#define PG8_WAIT_L(n) asm volatile("s_waitcnt lgkmcnt(" #n ")" ::: "memory")
#define PG8_BAR __builtin_amdgcn_s_barrier()
#define PG8_SCHED __builtin_amdgcn_sched_barrier(0)
    Unit cur, nxt; int ui = 0;
    if (!S.next(0, cur)) return;
    typedef typename MmaOp<I8>::acc_t acc_t;
    acc_t acc[2][2][4][2];
#pragma unroll
    for (int a = 0; a < 2; ++a)
#pragma unroll
        for (int b = 0; b < 2; ++b)
#pragma unroll
            for (int m = 0; m < 4; ++m)
#pragma unroll
                for (int n = 0; n < 2; ++n) acc[a][b][m][n] = acc_t{};
    bf16x8 At[4][2], B0[2][2], B1[2][2];
    const char* cA = (const char*)g.A + (size_t)cur.pm * tstep + (size_t)cur.seg * g.segA; const char* cB = (const char*)g.Bt + (size_t)cur.pn * tstep + (size_t)cur.seg * g.segB;
    S.a_ready(cur);
    if constexpr (SP2) {
        PG8_STAGE(PG8_SB(0, 0), cB, voffB); PG8_STAGE(PG8_SB(0, 1), cB + hstep, voffB); PG8_STAGE(PG8_SA(0, 0), cA, voffA); PG8_STAGE(PG8_SA(0, 1), cA + hstep, voffA);
        if (wr == 1) PG8_BAR;
        PG8_WAIT_V(2); PG8_BAR;
        PG8_STAGE(PG8_SB(1, 0), cB + kstep, voffB); PG8_STAGE(PG8_SA(1, 0), cA + kstep, voffA); PG8_STAGE(PG8_SB(1, 1), cB + hstep + kstep, voffB);
        PG8_WAIT_V(6); PG8_BAR;
    } else {
        PG8_STAGE(PG8_SB(0, 0), cB, voffB); PG8_STAGE(PG8_SA(0, 0), cA, voffA); PG8_STAGE(PG8_SB(0, 1), cB + hstep, voffB); PG8_STAGE(PG8_SA(0, 1), cA + hstep, voffA);
        if (wr == 1) PG8_BAR;
        PG8_WAIT_V(4); PG8_BAR;
        PG8_STAGE(PG8_SB(1, 0), cB + kstep, voffB); PG8_STAGE(PG8_SA(1, 0), cA + kstep, voffA); PG8_STAGE(PG8_SB(1, 1), cB + hstep + kstep, voffB);
        PG8_WAIT_V(6); PG8_BAR;
    }
    for (;;) {
        const bool has_next = S.next(ui + 1, nxt);
        const char* nA = has_next ? (const char*)g.A + (size_t)nxt.pm * tstep + (size_t)nxt.seg * g.segA : cA; const char* nB = has_next ? (const char*)g.Bt + (size_t)nxt.pn * tstep + (size_t)nxt.seg * g.segB : cB;
        for (int t = 0; t < nt; t += 2) {
            const bool last = (t == nt - 2);
            const char* a1 = cA + (size_t)(t + 1) * kstep;
            const char* a2 = last ? nA : cA + (size_t)(t + 2) * kstep; const char* b2 = last ? nB : cB + (size_t)(t + 2) * kstep;
            const char* a3 = a2 + kstep; const char* b3 = b2 + kstep;
            if (last && has_next) S.a_ready(nxt);
            if constexpr (SP2) {
            PG8_LDB(B0, 0, 0); PG8_LDB(B1, 0, 1); PG8_SCHED; PG8_LDA(At, 0, 0); PG8_STAGE(PG8_SA(1, 1), a1 + hstep, voffA);
            PG8_WAIT_V(8); PG8_WAIT_L(0); PG8_BAR; PG8_MMA(0, 0, At, B0); PG8_MMA(0, 1, At, B1); PG8_BAR; PG8_SCHED;
            PG8_LDA(At, 0, 1); PG8_STAGE(PG8_SB(0, 0), b2, voffB); PG8_STAGE(PG8_SB(0, 1), b2 + hstep, voffB); PG8_STAGE(PG8_SA(0, 0), a2, voffA);
            PG8_WAIT_V(8); PG8_WAIT_L(0); PG8_BAR; PG8_MMA(1, 0, At, B0); PG8_MMA(1, 1, At, B1); PG8_BAR; PG8_SCHED;
            PG8_LDB(B0, 1, 0); PG8_LDB(B1, 1, 1); PG8_SCHED; PG8_LDA(At, 1, 0); PG8_STAGE(PG8_SA(0, 1), a2 + hstep, voffA);
            PG8_WAIT_V(8); PG8_WAIT_L(0); PG8_BAR; PG8_MMA(0, 0, At, B0); PG8_MMA(0, 1, At, B1); PG8_BAR; PG8_SCHED;
            PG8_LDA(At, 1, 1); PG8_STAGE(PG8_SB(1, 0), b3, voffB); PG8_STAGE(PG8_SB(1, 1), b3 + hstep, voffB); PG8_STAGE(PG8_SA(1, 0), a3, voffA);
            PG8_WAIT_V(8); PG8_WAIT_L(0); PG8_BAR; PG8_MMA(1, 0, At, B0); PG8_MMA(1, 1, At, B1); PG8_BAR; PG8_SCHED;
            } else {
            PG8_LDB(B0, 0, 0); PG8_SCHED; PG8_LDA(At, 0, 0); PG8_STAGE(PG8_SA(1, 1), a1 + hstep, voffA);
            PG8_WAIT_L(8); PG8_BAR; PG8_WAIT_L(0); PG8_MMA(0, 0, At, B0); PG8_BAR; PG8_SCHED;
            PG8_LDB(B1, 0, 1); PG8_STAGE(PG8_SB(0, 0), b2, voffB);
            PG8_BAR; PG8_WAIT_L(0); PG8_MMA(0, 1, At, B1); PG8_BAR;
            PG8_LDA(At, 0, 1); PG8_STAGE(PG8_SA(0, 0), a2, voffA);
            PG8_BAR; PG8_WAIT_L(0); PG8_MMA(1, 0, At, B0); PG8_BAR; PG8_SCHED;
            PG8_STAGE(PG8_SB(0, 1), b2 + hstep, voffB);
            PG8_WAIT_V(6); PG8_BAR; PG8_MMA(1, 1, At, B1); PG8_BAR;
            PG8_LDB(B0, 1, 0); PG8_SCHED; PG8_LDA(At, 1, 0); PG8_STAGE(PG8_SA(0, 1), a2 + hstep, voffA);
            PG8_WAIT_L(8); PG8_BAR; PG8_WAIT_L(0); PG8_MMA(0, 0, At, B0); PG8_BAR; PG8_SCHED;
            PG8_LDB(B1, 1, 1); PG8_STAGE(PG8_SB(1, 0), b3, voffB);
            PG8_BAR; PG8_WAIT_L(0); PG8_MMA(0, 1, At, B1); PG8_BAR;
            PG8_LDA(At, 1, 1); PG8_STAGE(PG8_SA(1, 0), a3, voffA);
            PG8_BAR; PG8_WAIT_L(0); PG8_MMA(1, 0, At, B0); PG8_BAR; PG8_SCHED;
            PG8_STAGE(PG8_SB(1, 1), b3 + hstep, voffB);
            PG8_WAIT_V(6); PG8_BAR; PG8_MMA(1, 1, At, B1); PG8_BAR;
            }
        }
        if constexpr (ALIGN_EPI) { if (wr == 0) PG8_BAR; }
        if constexpr (!Epi::AFTER_DRAIN) { E(acc, cur, wr, wc, fr, fq); S.done(cur); }
        if (!has_next) break;
        if (!E.keep(cur)) {
#pragma unroll
        for (int a = 0; a < 2; ++a)
#pragma unroll
            for (int b = 0; b < 2; ++b)
#pragma unroll
                for (int m = 0; m < 4; ++m)
#pragma unroll
                    for (int n = 0; n < 2; ++n) acc[a][b][m][n] = acc_t{};
        }
        cur = nxt; cA = nA; cB = nB; ++ui;
        if constexpr (ALIGN_EPI) { if (wr == 1) PG8_BAR; }
    }
    PG8_WAIT_V(0);
    if constexpr (!ALIGN_EPI) { if (wr == 0) PG8_BAR; }
    PG8_BAR;
    if constexpr (Epi::AFTER_DRAIN) { E.fused(acc, cur, wr, wc, fr, fq, lds, wid, lane); S.done(cur); }
#undef PG8_SA
#undef PG8_SB
#undef PG8_STAGE
#undef PG8_LDA
#undef PG8_LDB
#undef PG8_MMA
#undef PG8_WAIT_V
#undef PG8_WAIT_L
#undef PG8_BAR
#undef PG8_SCHED
}
}

#define LAS __attribute__((address_space(3)))
typedef unsigned short bf16_t;
typedef short bf16x8 __attribute__((ext_vector_type(8)));
typedef float f32x4 __attribute__((ext_vector_type(4)));
typedef float f32x16 __attribute__((ext_vector_type(16)));
typedef unsigned u32x4 __attribute__((ext_vector_type(4)));
typedef unsigned u32x2 __attribute__((ext_vector_type(2)));

constexpr int NB = 16, SEQ = 2048, T = NB * SEQ, D = 1024, DFF = 2816, NIN = 6344, NINP = 3328;
constexpr float EPS = 1e-6f;
constexpr float C2 = 0.125f * 1.4426950408889634f;
constexpr int NWAVES = 8, NTHREADS = 512;
constexpr int NPHASE = 23;

constexpr int CI_QA = 0, CI_KA = 256, CI_VA = 320, CI_QI = 384, CI_KI = 896, CI_WI = 960, CI_QB = 968, CI_KB = 1224, CI_VB = 1480, CI_QC = 1736, CI_KC = 2248, CI_VC = 2760, CI_G = 3272;

constexpr size_t MiB = 1u << 20;
constexpr size_t WS_CTL = 0, CTL_BYTES = 1 * MiB;
constexpr int CW_BAR = 4096;
constexpr size_t CTL_KMEAN = 65536;
constexpr size_t CTL_DIAG = 655360;
constexpr size_t CTL_CMAX = 720896;
constexpr int CMAX_PER_LAYER = 2 * 5632 + 3072 + 3328;
constexpr size_t CTL_SA = 901120;
constexpr size_t WS_ROPE = 1 * MiB;
constexpr size_t WS_W = 3 * MiB;
constexpr size_t WL_GU = 0, WL_DN = 2 * (size_t)5632 * 1024, WL_IN = WL_DN + 2 * (size_t)1024 * 2816, WL_GT = WL_IN + (size_t)NINP * 1024,
                 WL_BR = WL_GT + 3 * (size_t)1024 * 1024, WL_OUT = WL_BR + (size_t)1024 * 1024, WL_END = WL_OUT + (size_t)1024 * 1024;
static_assert(WL_END * 2 * 2 <= 99 * MiB, "weights");
constexpr size_t WS_XB = 102 * MiB;
constexpr size_t DO_H = 0, DO_O = 64 * MiB;
constexpr size_t WS_G = 166 * MiB;
constexpr size_t WS_A = 262 * MiB;
constexpr size_t A_QA = 0, A_KA = 16 * MiB, A_VAT = 20 * MiB, A_QI = 24 * MiB, A_KI = 56 * MiB, A_WI = 60 * MiB, A_QB = 61 * MiB, A_KB = 77 * MiB, A_VBT = 93 * MiB,
                 A_QC = 109 * MiB, A_KC = 141 * MiB, A_VCT = 173 * MiB, A_END = 205 * MiB;
constexpr size_t WS_H8 = WS_A + A_END;
constexpr size_t WS_END = WS_H8 + 32 * MiB;
static_assert(WS_END <= 512 * MiB && CTL_CMAX + 2 * CMAX_PER_LAYER * 4 <= CTL_SA && CTL_SA + (size_t)T * 4 <= CTL_BYTES, "workspace");

#define XB_TMO      128
#define XB_XCNT(j)  (256  + 64 * (j))
#define XB_XSUB(j)  (1280 + 64 * (j))
#define XB_XGEN(j)  (2304 + 64 * (j))
#define XB_TOP      3328
#define XB_TOPGEN   3392
#define XCD_BAR_WORDS 3456
#define XB_SPIN_CAP (1u << 18)
__device__ __forceinline__ unsigned xb_ld(unsigned* p)              { return __hip_atomic_load(p, __ATOMIC_RELAXED, __HIP_MEMORY_SCOPE_AGENT); }
__device__ __forceinline__ unsigned xb_add(unsigned* p, unsigned v) { return __hip_atomic_fetch_add(p, v, __ATOMIC_RELAXED, __HIP_MEMORY_SCOPE_AGENT); }
__device__ __forceinline__ unsigned xb_xcc_id() { return (unsigned)__builtin_amdgcn_s_getreg((3 << 11) | 20) & 0xFu; }
#define XB_SPIN(cond, bar) do { unsigned _sp = 0; while (cond) { __builtin_amdgcn_s_sleep(1); \
    if ((++_sp & 255u) == 0u) { if (xb_ld(&(bar)[XB_TMO])) break; if (_sp > XB_SPIN_CAP) { atomicAdd(&(bar)[XB_TMO], 1u); break; } } } } while (0)
struct XcdBarrier { unsigned* bar; unsigned x; volatile LAS unsigned* st; };
__device__ __forceinline__ XcdBarrier xcd_barrier_post(unsigned* bar, volatile LAS unsigned* st) {
    XcdBarrier b; b.bar = bar; b.x = xb_xcc_id(); b.st = st;
    if (threadIdx.x == 0) (void)xb_add(&bar[XB_XCNT(b.x)], 1u);
    return b;
}
__device__ __forceinline__ void xcd_barrier_complete(unsigned* bar, unsigned x, unsigned& nloc, unsigned& nx) {
    const unsigned G = gridDim.x * gridDim.y * gridDim.z;
    unsigned sum, cnt, mine, sp = 0u;
    for (;;) {
        sum = 0u; cnt = 0u; mine = 0u;
#pragma unroll
        for (unsigned j = 0; j < 16; ++j) { const unsigned c = xb_ld(&bar[XB_XCNT(j)]); sum += c; cnt += (c > 0u) ? 1u : 0u; mine = (j == x) ? c : mine; }
        if (sum == G) break;
        __builtin_amdgcn_s_sleep(1);
        if ((++sp & 255u) == 0u) { if (xb_ld(&bar[XB_TMO])) break; if (sp > XB_SPIN_CAP) { atomicAdd(&bar[XB_TMO], 1u); break; } }
    }
    nloc = mine > 0u ? mine : 1u; nx = cnt > 0u ? cnt : 1u;
}
__device__ __forceinline__ void xcd_barrier(const XcdBarrier& b) {
    asm volatile("s_waitcnt vmcnt(0)" ::: "memory");
    __syncthreads();
    if (threadIdx.x == 0) {
        unsigned* bar = b.bar;
        __builtin_amdgcn_s_waitcnt(0);
        unsigned nloc = b.st[0], nx = b.st[1];
        if (nloc == 0u) { xcd_barrier_complete(bar, b.x, nloc, nx); b.st[0] = nloc; b.st[1] = nx; }
        const unsigned old = xb_add(&bar[XB_XSUB(b.x)], 1u);
        const unsigned gen = old / nloc;
        if (old + 1u == (gen + 1u) * nloc) {
            __builtin_amdgcn_fence(__ATOMIC_RELEASE, "agent");
            asm volatile("s_waitcnt vmcnt(0)" ::: "memory");
            const unsigned og = xb_add(&bar[XB_TOP], 1u);
            const unsigned tg = og / nx;
            if (og + 1u == (tg + 1u) * nx) xb_add(&bar[XB_TOPGEN], 1u);
            else XB_SPIN(xb_ld(&bar[XB_TOPGEN]) == tg, bar);
            __builtin_amdgcn_fence(__ATOMIC_ACQUIRE, "agent");
            xb_add(&bar[XB_XGEN(b.x)], 1u);
            asm volatile("s_waitcnt vmcnt(0)" ::: "memory");
        } else {
            XB_SPIN(xb_ld(&bar[XB_XGEN(b.x)]) == gen, bar);
            __builtin_amdgcn_fence(__ATOMIC_ACQUIRE, "agent");
            asm volatile("s_waitcnt vmcnt(0)" ::: "memory");
        }
    }
    __syncthreads();
}

typedef float f32x2_t __attribute__((ext_vector_type(2))); typedef __bf16 bf16x2_t __attribute__((ext_vector_type(2)));
__device__ __forceinline__ unsigned pk2(float lo, float hi) { f32x2_t v = {lo, hi}; bf16x2_t b = __builtin_convertvector(v, bf16x2_t); return __builtin_bit_cast(unsigned, b); }
__device__ __forceinline__ float bf2f(unsigned short h) { return __uint_as_float((unsigned)h << 16); }
#define RORF_(v, n) __uint_as_float((unsigned)__builtin_amdgcn_update_dpp(0, (int)__float_as_uint(v), 0x120 + (n), 0xf, 0xf, false))
__device__ __forceinline__ float wave_sum(float v) {
    v += RORF_(v, 1); v += RORF_(v, 2); v += RORF_(v, 4); v += RORF_(v, 8);
    { auto r = __builtin_amdgcn_permlane16_swap(__float_as_uint(v), __float_as_uint(v), false, false); v = __uint_as_float(r[0]) + __uint_as_float(r[1]); }
    { auto r = __builtin_amdgcn_permlane32_swap(__float_as_uint(v), __float_as_uint(v), false, false); v = __uint_as_float(r[0]) + __uint_as_float(r[1]); }
    return v;
}
__device__ __forceinline__ float wave_max_f(float v) {
    v = fmaxf(v, RORF_(v, 1)); v = fmaxf(v, RORF_(v, 2)); v = fmaxf(v, RORF_(v, 4)); v = fmaxf(v, RORF_(v, 8));
    { auto r = __builtin_amdgcn_permlane16_swap(__float_as_uint(v), __float_as_uint(v), false, false); v = fmaxf(__uint_as_float(r[0]), __uint_as_float(r[1])); }
    { auto r = __builtin_amdgcn_permlane32_swap(__float_as_uint(v), __float_as_uint(v), false, false); v = fmaxf(__uint_as_float(r[0]), __uint_as_float(r[1])); }
    return v;
}
__device__ __forceinline__ float fast_exp2(float x) { return __builtin_amdgcn_exp2f(x); }
__device__ __forceinline__ float fast_rcp(float x) { return __builtin_amdgcn_rcpf(x); }
__device__ __forceinline__ float sigmoidf_(float x) { return fast_rcp(1.0f + fast_exp2(-1.4426950408889634f * x)); }

struct Ctx {
    const float* x_in; const int* pos; const float* norm_g; const float* w_in; const float* qk_g; const float* lam_p; const float* subln_g;
    const float* w_branch; const float* w_out; const float* w_gate; const float* w_up; const float* w_down;
    float* out; unsigned char* ws;
};
__device__ __forceinline__ bf16_t* wsb(const Ctx& c, size_t off) { return (bf16_t*)(c.ws + off); }
__device__ __forceinline__ bf16_t* wlayer(const Ctx& c, int layer) { return (bf16_t*)(c.ws + WS_W) + (size_t)layer * WL_END; }

struct EpiSwiglu {
    static constexpr bool PERM = true, AFTER_DRAIN = false;
    __device__ __forceinline__ bool keep(const pg8::Unit&) const { return false; }
    bf16_t* O;
    __device__ __forceinline__ void operator()(const f32x4 (&acc)[2][2][4][2], const pg8::Unit& u, int wr, int wc, int fr_in, int fq_in) const {
        int fr = fr_in, fq = fq_in; asm volatile("" : "+v"(fr), "+v"(fq));
        const int row0 = u.pm * 256 + wr * 64 + fr, col = u.pn * 128 + wc * 32 + 8 * fq;
#pragma unroll
        for (int ai = 0; ai < 2; ++ai)
#pragma unroll
            for (int m = 0; m < 4; ++m) {
                float a[8];
#pragma unroll
                for (int n = 0; n < 2; ++n)
#pragma unroll
                    for (int e = 0; e < 4; ++e) { const float g = acc[ai][0][m][n][e], up = acc[ai][1][m][n][e]; a[4 * n + e] = g * sigmoidf_(g) * up; }
                u32x4 w; w.x = pk2(a[0], a[1]); w.y = pk2(a[2], a[3]); w.z = pk2(a[4], a[5]); w.w = pk2(a[6], a[7]);
                *(u32x4*)(O + (size_t)(row0 + ai * 128 + m * 16) * DFF + col) = w;
            }
    }
};
typedef int i32x4 __attribute__((ext_vector_type(4)));
struct EpiSwigluI8 {
    static constexpr bool PERM = true, AFTER_DRAIN = false;
    __device__ __forceinline__ bool keep(const pg8::Unit&) const { return false; }
    bf16_t* O; const float* sa; const float* cmax;
    __device__ __forceinline__ void operator()(const i32x4 (&acc)[2][2][4][2], const pg8::Unit& u, int wr, int wc, int fr_in, int fq_in) const {
        int fr = fr_in, fq = fq_in; asm volatile("" : "+v"(fr), "+v"(fq));
        const int row0 = u.pm * 256 + wr * 64 + fr, col = u.pn * 128 + wc * 32 + 8 * fq, bcol = u.pn * 256 + wc * 32 + 8 * fq;
        float sg[8], su[8];
        { const f32x4 g0 = *(const f32x4*)(cmax + bcol), g1 = *(const f32x4*)(cmax + bcol + 4), u0 = *(const f32x4*)(cmax + bcol + 128), u1 = *(const f32x4*)(cmax + bcol + 132);
#pragma unroll
          for (int k = 0; k < 4; ++k) { sg[k] = g0[k] * (1.0f / 127.0f); sg[4 + k] = g1[k] * (1.0f / 127.0f); su[k] = u0[k] * (1.0f / 127.0f); su[4 + k] = u1[k] * (1.0f / 127.0f); } }
        float sr[8];
#pragma unroll
        for (int s_ = 0; s_ < 8; ++s_) sr[s_] = sa[row0 + (s_ >> 2) * 128 + (s_ & 3) * 16];
#pragma unroll
        for (int ai = 0; ai < 2; ++ai)
#pragma unroll
            for (int m = 0; m < 4; ++m) {
                const float s = sr[ai * 4 + m];
                float a[8];
#pragma unroll
                for (int n = 0; n < 2; ++n)
#pragma unroll
                    for (int e = 0; e < 4; ++e) { const float g = (float)acc[ai][0][m][n][e] * (s * sg[4 * n + e]), up = (float)acc[ai][1][m][n][e] * (s * su[4 * n + e]); a[4 * n + e] = g * sigmoidf_(g) * up; }
                u32x4 w; w.x = pk2(a[0], a[1]); w.y = pk2(a[2], a[3]); w.z = pk2(a[4], a[5]); w.w = pk2(a[6], a[7]);
                *(u32x4*)(O + (size_t)(row0 + ai * 128 + m * 16) * DFF + col) = w;
            }
    }
};
struct EpiGateI8 {
    static constexpr bool PERM = true, AFTER_DRAIN = false;
    __device__ __forceinline__ bool keep(const pg8::Unit&) const { return false; }
    unsigned char* G; const float* sa; const float* cmax;
    __device__ __forceinline__ void operator()(const i32x4 (&acc)[2][2][4][2], const pg8::Unit& u, int wr, int wc, int fr_in, int fq_in) const {
        int fr = fr_in, fq = fq_in; asm volatile("" : "+v"(fr), "+v"(fq));
        const int row0 = u.pm * 256 + wr * 64 + fr, col0 = u.pn * 256 + wc * 32 + 8 * fq;
        float sc[2][8];
#pragma unroll
        for (int bj = 0; bj < 2; ++bj) { const f32x4 c0 = *(const f32x4*)(cmax + col0 + bj * 128), c1 = *(const f32x4*)(cmax + col0 + bj * 128 + 4);
#pragma unroll
            for (int k = 0; k < 4; ++k) { sc[bj][k] = c0[k] * (1.0f / 127.0f); sc[bj][4 + k] = c1[k] * (1.0f / 127.0f); } }
        float sr[8];
#pragma unroll
        for (int s_ = 0; s_ < 8; ++s_) sr[s_] = sa[row0 + (s_ >> 2) * 128 + (s_ & 3) * 16];
#pragma unroll
        for (int ai = 0; ai < 2; ++ai)
#pragma unroll
            for (int m = 0; m < 4; ++m)
#pragma unroll
                for (int bj = 0; bj < 2; ++bj) {
                    const float s = sr[ai * 4 + m];
                    unsigned q[8];
#pragma unroll
                    for (int k = 0; k < 8; ++k) q[k] = (unsigned)__builtin_fmaxf(__builtin_rintf(255.0f * sigmoidf_((float)acc[ai][bj][m][k >> 2][k & 3] * (s * sc[bj][k]))), 1.0f);
                    u32x2 w; w.x = q[0] | (q[1] << 8) | (q[2] << 16) | (q[3] << 24); w.y = q[4] | (q[5] << 8) | (q[6] << 16) | (q[7] << 24);
                    *(u32x2*)(G + (size_t)(row0 + ai * 128 + m * 16) * 3072 + col0 + bj * 128) = w;
                }
    }
};

template <bool IN_BF16, bool OUT_BF16> struct EpiResid {
    static constexpr bool PERM = true, AFTER_DRAIN = false;
    __device__ __forceinline__ bool keep(const pg8::Unit&) const { return false; }
    const void* in; void* out; float alpha;
    __device__ __forceinline__ void operator()(const f32x4 (&acc)[2][2][4][2], const pg8::Unit& u, int wr, int wc, int fr_in, int fq_in) const {
        int fr = fr_in, fq = fq_in; asm volatile("" : "+v"(fr), "+v"(fq));
        const int row0 = u.pm * 256 + wr * 64 + fr, col0 = u.pn * 256 + wc * 32 + 8 * fq;
        constexpr int DEPTH = 4;
#define RS_OFF(s_, bj_) ((size_t)(row0 + ((s_) >> 2) * 128 + ((s_) & 3) * 16) * D + col0 + (bj_) * 128)
        f32x4 bufa[DEPTH][2], bufb[DEPTH][2];
#define RS_LOAD(s_, d_) do { _Pragma("unroll") for (int bj = 0; bj < 2; ++bj) { \
            if (IN_BF16) { bufa[d_][bj] = __builtin_bit_cast(f32x4, *(const u32x4*)((const bf16_t*)in + RS_OFF(s_, bj))); } \
            else { bufa[d_][bj] = *(const f32x4*)((const float*)in + RS_OFF(s_, bj)); bufb[d_][bj] = *(const f32x4*)((const float*)in + RS_OFF(s_, bj) + 4); } } } while (0)
#pragma unroll
        for (int s_ = 0; s_ < DEPTH; ++s_) RS_LOAD(s_, s_);
        asm volatile("" ::: "memory");
#pragma unroll
        for (int s_ = 0; s_ < 8; ++s_) {
            const int ai = s_ >> 2, m = s_ & 3;
#pragma unroll
            for (int bj = 0; bj < 2; ++bj) {
                f32x4 x0, x1;
                if (IN_BF16) { const u32x4 w = __builtin_bit_cast(u32x4, bufa[s_ % DEPTH][bj]);
                    x0 = (f32x4){__uint_as_float(w.x << 16), __uint_as_float(w.x & 0xffff0000u), __uint_as_float(w.y << 16), __uint_as_float(w.y & 0xffff0000u)};
                    x1 = (f32x4){__uint_as_float(w.z << 16), __uint_as_float(w.z & 0xffff0000u), __uint_as_float(w.w << 16), __uint_as_float(w.w & 0xffff0000u)}; }
                else { x0 = bufa[s_ % DEPTH][bj]; x1 = bufb[s_ % DEPTH][bj]; }
                x0 = x0 + alpha * acc[ai][bj][m][0]; x1 = x1 + alpha * acc[ai][bj][m][1];
                if (OUT_BF16) { u32x4 w; w.x = pk2(x0[0], x0[1]); w.y = pk2(x0[2], x0[3]); w.z = pk2(x1[0], x1[1]); w.w = pk2(x1[2], x1[3]); *(u32x4*)((bf16_t*)out + RS_OFF(s_, bj)) = w; }
                else { *(f32x4*)((float*)out + RS_OFF(s_, bj)) = x0; *(f32x4*)((float*)out + RS_OFF(s_, bj) + 4) = x1; }
            }
            asm volatile("" ::: "memory");
            if (s_ + DEPTH < 8) { RS_LOAD(s_ + DEPTH, s_ % DEPTH); asm volatile("" ::: "memory"); }
        }
#undef RS_LOAD
#undef RS_OFF
    }
};
struct EpiGate {
    static constexpr bool PERM = true, AFTER_DRAIN = false;
    __device__ __forceinline__ bool keep(const pg8::Unit&) const { return false; }
    unsigned char* G;
    __device__ __forceinline__ void operator()(const f32x4 (&acc)[2][2][4][2], const pg8::Unit& u, int wr, int wc, int fr_in, int fq_in) const {
        int fr = fr_in, fq = fq_in; asm volatile("" : "+v"(fr), "+v"(fq));
        const int row0 = u.pm * 256 + wr * 64 + fr, col0 = u.pn * 256 + wc * 32 + 8 * fq;
#pragma unroll
        for (int ai = 0; ai < 2; ++ai)
#pragma unroll
            for (int m = 0; m < 4; ++m)
#pragma unroll
                for (int bj = 0; bj < 2; ++bj) {
                    unsigned q[8];
#pragma unroll
                    for (int k = 0; k < 8; ++k) q[k] = (unsigned)__builtin_fmaxf(__builtin_rintf(255.0f * sigmoidf_(acc[ai][bj][m][k >> 2][k & 3])), 1.0f);
                    u32x2 w; w.x = q[0] | (q[1] << 8) | (q[2] << 16) | (q[3] << 24); w.y = q[4] | (q[5] << 8) | (q[6] << 16) | (q[7] << 24);
                    *(u32x2*)(G + (size_t)(row0 + ai * 128 + m * 16) * 3072 + col0 + bj * 128) = w;
                }
    }
};
struct EpiMerge {
    static constexpr bool PERM = true, AFTER_DRAIN = false;
    __device__ __forceinline__ bool keep(const pg8::Unit&) const { return false; }
    const unsigned char* G; bf16_t* Mg; int first;
    __device__ __forceinline__ void operator()(const f32x4 (&acc)[2][2][4][2], const pg8::Unit& u, int wr, int wc, int fr_in, int fq_in) const {
        int fr = fr_in, fq = fq_in; asm volatile("" : "+v"(fr), "+v"(fq));
        const int row0 = u.pm * 256 + wr * 64 + fr, col0 = u.pn * 256 + wc * 32 + 8 * fq;
        constexpr int DEPTH = 4;
        u32x2 gb[DEPTH][2]; u32x4 mb[DEPTH][2];
#define MS_OFF(s_, bj_) ((size_t)(row0 + ((s_) >> 2) * 128 + ((s_) & 3) * 16) * D + col0 + (bj_) * 128)
#define GS_OFF(s_, bj_) ((size_t)(row0 + ((s_) >> 2) * 128 + ((s_) & 3) * 16) * 3072 + col0 + (bj_) * 128)
#pragma unroll
        for (int s_ = 0; s_ < DEPTH; ++s_)
#pragma unroll
            for (int bj = 0; bj < 2; ++bj) { gb[s_][bj] = *(const u32x2*)(G + GS_OFF(s_, bj)); mb[s_][bj] = (u32x4){0u, 0u, 0u, 0u}; if (!first) mb[s_][bj] = *(const u32x4*)(Mg + MS_OFF(s_, bj)); }
        asm volatile("" ::: "memory");
#pragma unroll
        for (int s_ = 0; s_ < 8; ++s_) {
            const int ai = s_ >> 2, m = s_ & 3;
#pragma unroll
            for (int bj = 0; bj < 2; ++bj) {
                const u32x2 g = gb[s_ % DEPTH][bj]; const u32x4 pm_ = mb[s_ % DEPTH][bj];
                float r[8];
#pragma unroll
                for (int k = 0; k < 4; ++k) {
                    const unsigned mw = pm_[k], gw = g[k >> 1] >> (16 * (k & 1));
                    const float a0 = acc[ai][bj][m][k >> 1][(k & 1) * 2], a1 = acc[ai][bj][m][k >> 1][(k & 1) * 2 + 1];
                    r[2 * k] = __uint_as_float(mw << 16) + (float)(gw & 0xffu) * (1.0f / 255.0f) * a0;
                    r[2 * k + 1] = __uint_as_float(mw & 0xffff0000u) + (float)((gw >> 8) & 0xffu) * (1.0f / 255.0f) * a1;
                }
                u32x4 w; w.x = pk2(r[0], r[1]); w.y = pk2(r[2], r[3]); w.z = pk2(r[4], r[5]); w.w = pk2(r[6], r[7]);
                *(u32x4*)(Mg + MS_OFF(s_, bj)) = w;
            }
            asm volatile("" ::: "memory");
            if (s_ + DEPTH < 8) {
#pragma unroll
                for (int bj = 0; bj < 2; ++bj) { gb[s_ % DEPTH][bj] = *(const u32x2*)(G + GS_OFF(s_ + DEPTH, bj)); if (!first) mb[s_ % DEPTH][bj] = *(const u32x4*)(Mg + MS_OFF(s_ + DEPTH, bj)); }
                asm volatile("" ::: "memory");
            }
        }
#undef MS_OFF
#undef GS_OFF
    }
};

struct EpiMergeSeg {
    static constexpr bool PERM = true, AFTER_DRAIN = false;
    const unsigned char* G3; bf16_t* Mg;
    __device__ __forceinline__ bool keep(const pg8::Unit& u) const { return u.seg != 3; }
    __device__ __forceinline__ void operator()(f32x4 (&acc)[2][2][4][2], const pg8::Unit& u, int wr, int wc, int fr_in, int fq_in) const {
        if (u.seg == 2) return;
        int fr = fr_in, fq = fq_in; asm volatile("" : "+v"(fr), "+v"(fq));
        const int row0 = u.pm * 256 + wr * 64 + fr, col0 = u.pn * 256 + wc * 32 + 8 * fq;
        const bool last = u.seg == 3;
        const unsigned char* Gn = G3 + (last ? 2 : u.seg) * 1024;
        const unsigned char* Gd = G3 + (u.seg + 1) * 1024;
        constexpr int DEPTH = 4;
        u32x2 nb[DEPTH][2], db[DEPTH][2];
#define GS_OFF(s_, bj_) ((size_t)(row0 + ((s_) >> 2) * 128 + ((s_) & 3) * 16) * 3072 + col0 + (bj_) * 128)
#define MS_OFF(s_, bj_) ((size_t)(row0 + ((s_) >> 2) * 128 + ((s_) & 3) * 16) * D + col0 + (bj_) * 128)
#pragma unroll
        for (int s_ = 0; s_ < DEPTH; ++s_)
#pragma unroll
            for (int bj = 0; bj < 2; ++bj) { nb[s_][bj] = *(const u32x2*)(Gn + GS_OFF(s_, bj)); db[s_][bj] = (u32x2){0x01010101u, 0x01010101u}; if (!last) db[s_][bj] = *(const u32x2*)(Gd + GS_OFF(s_, bj)); }
        asm volatile("" ::: "memory");
#pragma unroll
        for (int s_ = 0; s_ < 8; ++s_) {
            const int ai = s_ >> 2, m = s_ & 3;
#pragma unroll
            for (int bj = 0; bj < 2; ++bj) {
                const u32x2 gn = nb[s_ % DEPTH][bj], gd = db[s_ % DEPTH][bj];
                float r[8];
#pragma unroll
                for (int k = 0; k < 8; ++k) {
                    const float fn = (float)((gn[k >> 2] >> (8 * (k & 3))) & 0xffu), fd = last ? 255.0f : (float)((gd[k >> 2] >> (8 * (k & 3))) & 0xffu);
                    r[k] = acc[ai][bj][m][k >> 2][k & 3] * (fn * fast_rcp(fd));
                    acc[ai][bj][m][k >> 2][k & 3] = r[k];
                }
                if (last) { u32x4 w; w.x = pk2(r[0], r[1]); w.y = pk2(r[2], r[3]); w.z = pk2(r[4], r[5]); w.w = pk2(r[6], r[7]); *(u32x4*)(Mg + MS_OFF(s_, bj)) = w; }
            }
            asm volatile("" ::: "memory");
            if (s_ + DEPTH < 8) {
#pragma unroll
                for (int bj = 0; bj < 2; ++bj) { nb[s_ % DEPTH][bj] = *(const u32x2*)(Gn + GS_OFF(s_ + DEPTH, bj)); if (!last) db[s_ % DEPTH][bj] = *(const u32x2*)(Gd + GS_OFF(s_ + DEPTH, bj)); }
                asm volatile("" ::: "memory");
            }
        }
#undef GS_OFF
#undef MS_OFF
    }
};
struct SegOrder {
    pg8::StaticOrder base;
    __device__ __forceinline__ bool next(int i, pg8::Unit& u) const { if (!base.next(i >> 2, u)) return false; u.seg = i & 3; return true; }
    __device__ __forceinline__ void a_ready(const pg8::Unit&) const {}
    __device__ __forceinline__ void done(const pg8::Unit&) const {}
};

struct RevOrder {
    pg8::StaticOrder base; int rounds;
    __device__ __forceinline__ void init(int M, int N, int G_, int c_) { base.init(M, N, G_, c_); rounds = (base.nwg - c_ + G_ - 1) / G_; }
    __device__ __forceinline__ bool next(int i, pg8::Unit& u) const { return i < rounds && base.next(rounds - 1 - i, u); }
    __device__ __forceinline__ void a_ready(const pg8::Unit&) const {}
    __device__ __forceinline__ void done(const pg8::Unit&) const {}
};

struct GateOrder {
    pg8::StaticOrder base;
    __device__ __forceinline__ bool next(int i, pg8::Unit& u) const { if (!base.next(i / 3, u)) return false; u.pn += 4 * (i % 3); return true; }
    __device__ __forceinline__ void a_ready(const pg8::Unit&) const {}
    __device__ __forceinline__ void done(const pg8::Unit&) const {}
};

template <bool I8> struct EpiInProjT {
    typedef typename pg8::MmaOp<I8>::acc_t acc_t;
    static constexpr bool PERM = true, AFTER_DRAIN = false;
    __device__ __forceinline__ bool keep(const pg8::Unit&) const { return false; }
    unsigned char* ws;
    const LAS unsigned char* gains_lds;
    int layer;
    __device__ __forceinline__ void operator()(const acc_t (&acc)[2][2][4][2], const pg8::Unit& u, int wr, int wc, int fr_in, int fq_in) const {
        int fr = fr_in, fq = fq_in; asm volatile("" : "+v"(fr), "+v"(fq));
        const int pn = u.pn;
        unsigned char* A = ws + WS_A; const float* rope = (const float*)(ws + WS_ROPE);
        float* kmean = (float*)(ws + WS_CTL + CTL_KMEAN) + (size_t)layer * (16 * 4 * 8 * 2 * 64);
        int kind = 0;
        int ng = -1;
        bool do_rope = false; float scale = 1.0f; bool do_kmean = false;
        bf16_t* dst = nullptr; int pitch = 0, coloff = 0; int vdims = 0, vdimoff = 0;
        if (pn == 0)      { dst = (bf16_t*)(A + A_QA); pitch = 256; coloff = 64 * wc; ng = 0; do_rope = true; scale = C2; }
        else if (pn == 1) {
            if (wc == 0)      { dst = (bf16_t*)(A + A_KA); pitch = 64; coloff = 0; ng = 1; do_rope = true; }
            else if (wc == 1) { kind = 1; dst = (bf16_t*)(A + A_VAT); vdims = 64; vdimoff = 0; }
            else if (wc == 2) { dst = (bf16_t*)(A + A_KI); pitch = 64; coloff = 0; do_rope = true; }
            else              { kind = 2; }
        }
        else if (pn <= 3) { dst = (bf16_t*)(A + A_QI); pitch = 512; coloff = 64 * (4 * (pn - 2) + wc); do_rope = true; }
        else if (pn == 4) { dst = (bf16_t*)(A + A_QB); pitch = 256; coloff = 64 * wc; ng = 2; do_rope = true; scale = C2; }
        else if (pn == 5) { dst = (bf16_t*)(A + A_KB); pitch = 256; coloff = 64 * wc; ng = 3; do_rope = true; do_kmean = true; }
        else if (pn == 6) { kind = 1; dst = (bf16_t*)(A + A_VBT); vdims = 256; vdimoff = 64 * wc; }
        else if (pn <= 8) { dst = (bf16_t*)(A + A_QC); pitch = 512; coloff = 64 * (4 * (pn - 7) + wc); ng = 4; do_rope = true; scale = C2; }
        else if (pn <= 10){ dst = (bf16_t*)(A + A_KC); pitch = 512; coloff = 64 * (4 * (pn - 9) + wc); ng = 5; do_rope = true; }
        else              { kind = 1; dst = (bf16_t*)(A + A_VCT); vdims = 512; vdimoff = 64 * (4 * (pn - 11) + wc); }
        const int row0 = u.pm * 256 + wr * 64 + fr;
        const float* sa = (const float*)(ws + WS_CTL + CTL_SA);
        const LAS float* scp = (const LAS float*)(gains_lds + 1536) + u.pn * 256 + wc * 32 + 8 * fq;
#define IPS(ai_, m_) (sa[row0 + (ai_) * 128 + (m_) * 16])
#define IPSC() float sc_[16]; if (I8) { const LAS float* q_ = scp; asm volatile("" : "+v"(q_)); const f32x4 a_ = *(const LAS f32x4*)q_, b_ = *(const LAS f32x4*)(q_ + 4), c_ = *(const LAS f32x4*)(q_ + 128), d_ = *(const LAS f32x4*)(q_ + 132); \
        _Pragma("unroll") for (int k_ = 0; k_ < 4; ++k_) { sc_[k_] = a_[k_]; sc_[4 + k_] = b_[k_]; sc_[8 + k_] = c_[k_]; sc_[12 + k_] = d_[k_]; } }
#define IPV(ai_, bj_, m_, n_, e_) (I8 ? (float)acc[ai_][bj_][m_][n_][e_] * (rs_ * sc_[8 * (bj_) + 4 * (n_) + (e_)]) : (float)acc[ai_][bj_][m_][n_][e_])
        if (kind == 2) {
            if (fq == 0) {
                float* WI = (float*)(A + A_WI);
#pragma unroll
                for (int ai = 0; ai < 2; ++ai)
#pragma unroll
                    for (int m = 0; m < 4; ++m) { const size_t tok = (size_t)(row0 + ai * 128 + m * 16); const float rs_ = I8 ? IPS(ai, m) : 1.0f; IPSC();
                        *(f32x4*)(WI + tok * 8) = (f32x4){IPV(ai, 0, m, 0, 0), IPV(ai, 0, m, 0, 1), IPV(ai, 0, m, 0, 2), IPV(ai, 0, m, 0, 3)} * 0.04419417382415922f;
                        *(f32x4*)(WI + tok * 8 + 4) = (f32x4){IPV(ai, 0, m, 1, 0), IPV(ai, 0, m, 1, 1), IPV(ai, 0, m, 1, 2), IPV(ai, 0, m, 1, 3)} * 0.04419417382415922f; }
            }
            return;
        }
        if (kind == 1) {
            const int b = u.pm >> 3;
#pragma unroll
            for (int ai = 0; ai < 2; ++ai)
#pragma unroll
                for (int m = 0; m < 4; ++m) {
                    const float rs_ = I8 ? IPS(ai, m) : 1.0f; IPSC();
                    const int s = (row0 + ai * 128 + m * 16) & (SEQ - 1);
                    bf16_t* base = dst + ((size_t)b * vdims + vdimoff + 16 * fq) * SEQ + s;
#pragma unroll
                    for (int bj = 0; bj < 2; ++bj)
#pragma unroll
                        for (int n = 0; n < 2; ++n)
#pragma unroll
                            for (int e = 0; e < 4; e += 2) { const unsigned w = pk2(IPV(ai, bj, m, n, e), IPV(ai, bj, m, n, e + 1));
                                base[(size_t)(8 * bj + 4 * n + e) * SEQ] = (bf16_t)(w & 0xffffu); base[(size_t)(8 * bj + 4 * n + e + 1) * SEQ] = (bf16_t)(w >> 16); }
                }
            return;
        }
        const LAS float* gp = (const LAS float*)gains_lds + (ng >= 0 ? ng : 0) * 64 + 16 * fq;
        float ksum[16];
#pragma unroll
        for (int k = 0; k < 16; ++k) ksum[k] = 0.0f;
        const bool roper = do_rope && fq == 0;
        const unsigned* ropeu = (const unsigned*)rope;
        float rs_n = I8 ? IPS(0, 0) : 1.0f;
        u32x4 rt_n[2];
        if (roper) { const unsigned* rp = ropeu + (size_t)row0 * 8; rt_n[0] = *(const u32x4*)rp; rt_n[1] = *(const u32x4*)(rp + 4); }
#pragma unroll
        for (int sl = 0; sl < 8; ++sl) {
                const int ai = sl >> 2, m = sl & 3;
                const size_t tok = (size_t)(row0 + ai * 128 + m * 16);
                const float rs_ = rs_n;
                const u32x4 t0 = rt_n[0], t1 = rt_n[1];
                if (sl < 7) {
                    const int ai1 = (sl + 1) >> 2, m1 = (sl + 1) & 3;
                    if (I8) rs_n = IPS(ai1, m1);
                    if (roper) { const unsigned* rp = ropeu + (size_t)(row0 + ai1 * 128 + m1 * 16) * 8; rt_n[0] = *(const u32x4*)rp; rt_n[1] = *(const u32x4*)(rp + 4); }
                }
                float v[16];
                { IPSC();
#pragma unroll
                for (int bj = 0; bj < 2; ++bj)
#pragma unroll
                    for (int n = 0; n < 2; ++n)
#pragma unroll
                        for (int e = 0; e < 4; ++e) v[8 * bj + 4 * n + e] = IPV(ai, bj, m, n, e); }
                if (ng >= 0) {
                    float ss = 0.0f;
#pragma unroll
                    for (int k = 0; k < 16; ++k) ss += v[k] * v[k];
                    ss += __shfl_xor(ss, 16); ss += __shfl_xor(ss, 32);
                    const float rstd = rsqrtf(ss * (1.0f / 64.0f) + EPS);
                    const f32x4 g0 = *(const LAS f32x4*)gp, g1 = *(const LAS f32x4*)(gp + 4), g2 = *(const LAS f32x4*)(gp + 8), g3 = *(const LAS f32x4*)(gp + 12);
#pragma unroll
                    for (int k = 0; k < 4; ++k) { v[k] = v[k] * rstd * g0[k]; v[4 + k] = v[4 + k] * rstd * g1[k]; v[8 + k] = v[8 + k] * rstd * g2[k]; v[12 + k] = v[12 + k] * rstd * g3[k]; }
                }
                if (roper) {
#pragma unroll
                    for (int i = 0; i < 8; ++i) { const unsigned cs_ = i < 4 ? t0[i & 3] : t1[i & 3]; const float c = __uint_as_float(cs_ << 16), s = __uint_as_float(cs_ & 0xffff0000u);
                        const float x1 = v[i], x2 = v[8 + i]; v[i] = x1 * c - x2 * s; v[8 + i] = x2 * c + x1 * s; }
                }
                if (do_kmean) {
#pragma unroll
                    for (int k = 0; k < 16; ++k) ksum[k] += v[k];
                }
#pragma unroll
                for (int k = 0; k < 16; ++k) v[k] *= scale;
                bf16_t* p = dst + tok * pitch + coloff + 16 * fq;
                u32x4 w0, w1; w0.x = pk2(v[0], v[1]); w0.y = pk2(v[2], v[3]); w0.z = pk2(v[4], v[5]); w0.w = pk2(v[6], v[7]);
                w1.x = pk2(v[8], v[9]); w1.y = pk2(v[10], v[11]); w1.z = pk2(v[12], v[13]); w1.w = pk2(v[14], v[15]);
                *(u32x4*)p = w0; *(u32x4*)(p + 8) = w1;
            }
        if (do_kmean) {
#pragma unroll
            for (int k = 0; k < 16; ++k) { float s = ksum[k]; s += __shfl_xor(s, 1); s += __shfl_xor(s, 2); s += __shfl_xor(s, 4); s += __shfl_xor(s, 8); ksum[k] = s; }
            if (fr == 0) {
                float* km = kmean + (((size_t)((u.pm >> 3) * 4 + wc) * 8 + (u.pm & 7)) * 2 + wr) * 64 + 16 * fq;
#pragma unroll
                for (int k = 0; k < 16; k += 4) *(f32x4*)(km + k) = (f32x4){ksum[k], ksum[k + 1], ksum[k + 2], ksum[k + 3]};
            }
        }
    }
};
#undef IPV
#undef IPS
#undef IPSC

template <class Map> __device__ __forceinline__ void conv_item(const Map& map, int ld, int K, bf16_t* WT, const float* gk, LAS float* scr, int item, int nblk, int lane) {
    const int kb = item / nblk, nb = item % nblk, k0 = 64 * kb, n0 = 32 * nb;
    typedef const __attribute__((address_space(1))) float* gptr;
    const float* src0 = map(n0 + (lane & 31)); const bool valid = src0 != nullptr; const gptr src = (gptr)(uintptr_t)(valid ? src0 : map(0));
    float tv[32];
#pragma unroll
    for (int i = 0; i < 32; ++i) { const int kk = 2 * i + (lane >> 5); tv[i] = src[(size_t)(k0 + kk) * ld]; }
#pragma unroll
    for (int i = 0; i < 32; ++i) { const int kk = 2 * i + (lane >> 5); float v = valid ? tv[i] : 0.0f; if (gk) v *= gk[k0 + kk]; scr[kk * 33 + (lane & 31)] = v; }
    asm volatile("s_waitcnt lgkmcnt(0)" ::: "memory");
    const int c = lane & 7;
#pragma unroll
    for (int j = 0; j < 4; ++j) { const int n = (lane >> 3) + 8 * j; const LAS float* s = scr + (8 * c) * 33 + n;
        u32x4 o; o.x = pk2(s[0 * 33], s[1 * 33]); o.y = pk2(s[2 * 33], s[3 * 33]); o.z = pk2(s[4 * 33], s[5 * 33]); o.w = pk2(s[6 * 33], s[7 * 33]);
        *(u32x4*)(WT + (size_t)(n0 + n) * K + k0 + 8 * c) = o; }
    asm volatile("s_waitcnt lgkmcnt(0)" ::: "memory");
}
struct MapPlain { const float* W; __device__ __forceinline__ const float* operator()(int n) const { return W + n; } };
struct MapGU { const float* Wg; const float* Wu; __device__ __forceinline__ const float* operator()(int n) const { const int t = n >> 8, w = n & 255;
    const uintptr_t a = (uintptr_t)Wg, d = (uintptr_t)Wu - (uintptr_t)Wg; return (const float*)(a + d * (uintptr_t)(w >> 7)) + t * 128 + (w & 127); } };
struct MapIn { const float* W;
    __device__ __forceinline__ const float* operator()(int n) const {
        const int pn = n >> 8, w = n & 255, bj = w >> 7, wc = (w >> 5) & 3, fq = (w >> 3) & 3, j = w & 7, dim = 16 * fq + 8 * bj + j;
        int base;
        if (pn == 0) base = CI_QA + 64 * wc;
        else if (pn == 1) { if (wc == 0) base = CI_KA; else if (wc == 1) base = CI_VA; else if (wc == 2) base = CI_KI; else { if (dim >= 8) return nullptr; base = CI_WI; } }
        else if (pn <= 3) base = CI_QI + 64 * (4 * (pn - 2) + wc);
        else if (pn == 4) base = CI_QB + 64 * wc;
        else if (pn == 5) base = CI_KB + 64 * wc;
        else if (pn == 6) base = CI_VB + 64 * wc;
        else if (pn <= 8) base = CI_QC + 64 * (4 * (pn - 7) + wc);
        else if (pn <= 10) base = CI_KC + 64 * (4 * (pn - 9) + wc);
        else base = CI_VC + 64 * (4 * (pn - 11) + wc);
        return W + base + dim;
    } };

template <bool G64, class Map> __device__ __forceinline__ void colmax_item(const Map& map, int ld, const float* gk, unsigned* cmax, int item, int nblk, int lane) {
    const int kb = item / nblk, nb = item % nblk, k0 = 64 * kb, n0 = 32 * nb;
    typedef const __attribute__((address_space(1))) float* gptr;
    const float* src0 = map(n0 + (lane & 31)); const bool valid = src0 != nullptr; const gptr src = (gptr)(uintptr_t)(valid ? src0 : map(0));
    float tv[32];
#pragma unroll
    for (int i = 0; i < 32; ++i) { const int kk = 2 * i + (lane >> 5); tv[i] = src[(size_t)(k0 + kk) * ld]; }
    float mx = 0.0f;
#pragma unroll
    for (int i = 0; i < 32; ++i) { const int kk = 2 * i + (lane >> 5); mx = fmaxf(mx, valid ? fabsf(tv[i] * gk[k0 + kk]) : 0.0f); }
    mx = fmaxf(mx, __shfl_xor(mx, 32));
    if (G64) { mx = wave_max_f(mx); if (lane == 0) atomicMax(cmax + (n0 >> 8) * 4 + ((n0 >> 5) & 3), __float_as_uint(mx)); }
    else if (lane < 32) atomicMax(cmax + n0 + lane, __float_as_uint(mx));
}
template <bool G64, class Map> __device__ __forceinline__ void conv_item_i8(const Map& map, int ld, int K, signed char* WT, const float* gk, const float* cmax, LAS float* scr, int item, int nblk, int lane) {
    const int kb = item / nblk, nb = item % nblk, k0 = 64 * kb, n0 = 32 * nb;
    typedef const __attribute__((address_space(1))) float* gptr;
    const float* src0 = map(n0 + (lane & 31)); const bool valid = src0 != nullptr; const gptr src = (gptr)(uintptr_t)(valid ? src0 : map(0));
    const float am = G64 ? cmax[(n0 >> 8) * 4 + ((n0 >> 5) & 3)] : cmax[n0 + (lane & 31)], qs = (valid && am > 0.0f) ? 127.0f / am : 0.0f;
    float tv[32];
#pragma unroll
    for (int i = 0; i < 32; ++i) { const int kk = 2 * i + (lane >> 5); tv[i] = src[(size_t)(k0 + kk) * ld]; }
#pragma unroll
    for (int i = 0; i < 32; ++i) { const int kk = 2 * i + (lane >> 5); scr[kk * 33 + (lane & 31)] = __builtin_rintf(tv[i] * gk[k0 + kk] * qs); }
    asm volatile("s_waitcnt lgkmcnt(0)" ::: "memory");
    const int c = lane & 7;
#pragma unroll
    for (int j = 0; j < 4; ++j) { const int n = (lane >> 3) + 8 * j; const LAS float* s = scr + (8 * c) * 33 + n;
        unsigned b[8];
#pragma unroll
        for (int k = 0; k < 8; ++k) b[k] = (unsigned)(int)s[k * 33] & 0xffu;
        u32x2 o; o.x = b[0] | (b[1] << 8) | (b[2] << 16) | (b[3] << 24); o.y = b[4] | (b[5] << 8) | (b[6] << 16) | (b[7] << 24);
        *(u32x2*)(WT + (size_t)(n0 + n) * K + k0 + 8 * c) = o; }
    asm volatile("s_waitcnt lgkmcnt(0)" ::: "memory");
}
template <int PASS> __device__ __forceinline__ void prologue_i8(const Ctx& c, LAS unsigned char* lds) {
    const int tid = fresh_tid(), lane = tid & 63, wave = __builtin_amdgcn_readfirstlane(tid >> 6);
    LAS float* scr = (LAS float*)(lds + wave * 16384);
    const int gw = blockIdx.x * NWAVES + wave, NGW = gridDim.x * NWAVES;
    constexpr int I_GU = 16 * 176, I_GT3 = 16 * 96, I_IN8 = 16 * 104, PER_LAYER = 2 * I_GU + I_GT3 + I_IN8;
    for (int it = gw; it < 2 * PER_LAYER; it += NGW) {
        const int layer = it / PER_LAYER; int r = it % PER_LAYER;
        bf16_t* WL = wlayer(c, layer);
        const float* ng = c.norm_g + (size_t)layer * 3 * D;
        float* cm = (float*)(c.ws + WS_CTL + CTL_CMAX) + (size_t)layer * CMAX_PER_LAYER;
        if (r < 2 * I_GU) { const int f = r / I_GU; r %= I_GU; const size_t wo = ((size_t)layer * 2 + f) * D * DFF; const MapGU map{c.w_gate + wo, c.w_up + wo};
            if (PASS == 0) colmax_item<false>(map, DFF, ng + (f ? 2 : 0) * D, (unsigned*)cm + f * 5632, r, 176, lane);
            else conv_item_i8<false>(map, DFF, D, (signed char*)(WL + WL_GU + (size_t)f * 5632 * 1024), ng + (f ? 2 : 0) * D, cm + f * 5632, scr, r, 176, lane);
            continue; }
        r -= 2 * I_GU;
        if (r < I_GT3) { const MapPlain map{c.w_in + (size_t)layer * D * NIN + CI_G};
          if (PASS == 0) colmax_item<false>(map, NIN, ng + D, (unsigned*)cm + 2 * 5632, r, 96, lane);
          else conv_item_i8<false>(map, NIN, D, (signed char*)(WL + WL_GT), ng + D, cm + 2 * 5632, scr, r, 96, lane);
          continue; }
        r -= I_GT3;
        { const MapIn map{c.w_in + (size_t)layer * D * NIN};
          if (PASS == 0) colmax_item<false>(map, NIN, ng + D, (unsigned*)cm + 2 * 5632 + 3072, r, 104, lane);
          else conv_item_i8<false>(map, NIN, D, (signed char*)(WL + WL_IN), ng + D, cm + 2 * 5632 + 3072, scr, r, 104, lane); }
    }
}

__device__ __forceinline__ void phase_prologue(const Ctx& c, LAS unsigned char* lds) {
    const int tid = fresh_tid(), lane = tid & 63, wave = __builtin_amdgcn_readfirstlane(tid >> 6);
    LAS float* scr = (LAS float*)(lds + wave * 16384);
    const int gw = blockIdx.x * NWAVES + wave, NGW = gridDim.x * NWAVES;
    constexpr int I_GU = 16 * 176, I_DN = 44 * 32, I_IN = 16 * 104, I_GT = 16 * 32, I_BA = 4 * 32, I_BC = 8 * 32, I_OUT = 16 * 32;
    constexpr int PER_LAYER = 2 * I_DN + 4 * I_BA + I_OUT;
    for (int it = gw; it < 2 * PER_LAYER; it += NGW) {
        const int layer = it / PER_LAYER; int r = it % PER_LAYER;
        bf16_t* WL = wlayer(c, layer);
        const float* ng = c.norm_g + (size_t)layer * 3 * D;
        if (r < 2 * I_DN) { const int f = r / I_DN; r %= I_DN; const size_t wo = ((size_t)layer * 2 + f) * D * DFF;
            conv_item(MapPlain{c.w_down + wo}, D, DFF, WL + WL_DN + (size_t)f * 1024 * 2816, nullptr, scr, r, 32, lane); continue; } r -= 2 * I_DN;
        if (r < 4 * I_BA) { const int i = r / I_BA; r %= I_BA; conv_item(MapPlain{c.w_branch + (size_t)layer * D * D + (size_t)i * 256 * D}, D, 256, WL + WL_BR + (size_t)i * 1024 * 256, nullptr, scr, r, 32, lane); continue; } r -= 4 * I_BA;
        conv_item(MapPlain{c.w_out + (size_t)layer * D * D}, D, D, WL + WL_OUT, nullptr, scr, r, 32, lane);
    }
    unsigned* rope = (unsigned*)(c.ws + WS_ROPE);
    for (int idx = blockIdx.x * NTHREADS + tid; idx < T * 8; idx += gridDim.x * NTHREADS) {
        const int tok = idx >> 3, i = idx & 7;
        const float inv = i == 0 ? 1.0f : i == 1 ? 0x1.8d275ep-3f : i == 2 ? 0x1.341190p-5f : i == 3 ? 0x1.ddee9cp-8f : i == 4 ? 0x1.72ba44p-10f : i == 5 ? 0x1.1f91f0p-12f : i == 6 ? 0x1.be2188p-15f : 0x1.5a0f4ep-17f;
        const float ang = (float)c.pos[tok] * inv;
        const double rev = (double)ang * 0.15915494309189535;
        const float fr_ = (float)(rev - __builtin_rint(rev));
        rope[(size_t)tok * 8 + i] = pk2(__builtin_amdgcn_cosf(fr_), __builtin_amdgcn_sinf(fr_));
    }
}

template <bool IN_BF16, bool OUT_BF, bool OUT_I8> __device__ __forceinline__ void phase_norm(const void* xin, bf16_t* h, signed char* h8, float* sa) {
    const int tid = fresh_tid(), lane = tid & 63, wave = tid >> 6;
    const int gw = blockIdx.x * NWAVES + wave, NGW = gridDim.x * NWAVES;
    constexpr int NR = 4;
    for (int row0 = gw; row0 < T; row0 += NR * NGW) {
        float v[NR][16];
#pragma unroll
        for (int k = 0; k < NR; ++k) {
            const int row = min(row0 + k * NGW, T - 1);
            if (IN_BF16) {
                const u32x4* xr = (const u32x4*)((const bf16_t*)xin + (size_t)row * D) + 2 * lane;
                const u32x4 a = xr[0], b = xr[1]; const unsigned w[8] = {a.x, a.y, a.z, a.w, b.x, b.y, b.z, b.w};
#pragma unroll
                for (int j = 0; j < 8; ++j) { v[k][2 * j] = __uint_as_float(w[j] << 16); v[k][2 * j + 1] = __uint_as_float(w[j] & 0xffff0000u); }
            } else {
                const f32x4* xr = (const f32x4*)((const float*)xin + (size_t)row * D) + lane;
#pragma unroll
                for (int j = 0; j < 4; ++j) { const f32x4 t = xr[64 * j]; v[k][4 * j] = t.x; v[k][4 * j + 1] = t.y; v[k][4 * j + 2] = t.z; v[k][4 * j + 3] = t.w; }
            }
        }
#pragma unroll
        for (int k = 0; k < NR; ++k) {
            const int row = row0 + k * NGW;
            if (row >= T) break;
            float s = 0.0f, am = 0.0f;
#pragma unroll
            for (int j = 0; j < 16; ++j) { s += v[k][j] * v[k][j]; am = fmaxf(am, fabsf(v[k][j])); }
            const float rstd = rsqrtf(wave_sum(s) * (1.0f / D) + EPS);
            if (OUT_BF) {
                if (IN_BF16) {
                    u32x4* o = (u32x4*)(h + (size_t)row * D) + 2 * lane;
                    u32x4 a, b; a.x = pk2(v[k][0] * rstd, v[k][1] * rstd); a.y = pk2(v[k][2] * rstd, v[k][3] * rstd); a.z = pk2(v[k][4] * rstd, v[k][5] * rstd); a.w = pk2(v[k][6] * rstd, v[k][7] * rstd);
                    b.x = pk2(v[k][8] * rstd, v[k][9] * rstd); b.y = pk2(v[k][10] * rstd, v[k][11] * rstd); b.z = pk2(v[k][12] * rstd, v[k][13] * rstd); b.w = pk2(v[k][14] * rstd, v[k][15] * rstd);
                    o[0] = a; o[1] = b;
                } else {
                    u32x2* o = (u32x2*)(h + (size_t)row * D) + lane;
#pragma unroll
                    for (int j = 0; j < 4; ++j) { u32x2 w; w.x = pk2(v[k][4 * j] * rstd, v[k][4 * j + 1] * rstd); w.y = pk2(v[k][4 * j + 2] * rstd, v[k][4 * j + 3] * rstd); o[64 * j] = w; }
                }
            }
            if (OUT_I8) {
                am = wave_max_f(am);
                const float qs = am > 0.0f ? 127.0f / am : 0.0f;
                unsigned b[16];
#pragma unroll
                for (int j = 0; j < 16; ++j) b[j] = (unsigned)(int)__builtin_rintf(v[k][j] * qs) & 0xffu;
                if (IN_BF16) { u32x4 w; w.x = b[0] | (b[1] << 8) | (b[2] << 16) | (b[3] << 24); w.y = b[4] | (b[5] << 8) | (b[6] << 16) | (b[7] << 24);
                               w.z = b[8] | (b[9] << 8) | (b[10] << 16) | (b[11] << 24); w.w = b[12] | (b[13] << 8) | (b[14] << 16) | (b[15] << 24);
                               *((u32x4*)(h8 + (size_t)row * D) + lane) = w; }
                else {
#pragma unroll
                    for (int j = 0; j < 4; ++j) *((unsigned*)(h8 + (size_t)row * D) + lane + 64 * j) = b[4 * j] | (b[4 * j + 1] << 8) | (b[4 * j + 2] << 16) | (b[4 * j + 3] << 24); }
                if (lane == 0) sa[row] = rstd * am * (1.0f / 127.0f);
            }
        }
    }
}

namespace att {
constexpr int KP = 144;
constexpr int KT_BYTES = 64 * KP;
constexpr float NEG = -INFINITY;
__device__ __forceinline__ int pi32(int m) { return (m & ~12) | ((m & 8) >> 1) | ((m & 4) << 1); }
__device__ __forceinline__ f32x16 mfma32(bf16x8 a, bf16x8 b, f32x16 c) { return __builtin_amdgcn_mfma_f32_32x32x16_bf16(a, b, c, 0, 0, 0); }

__device__ __forceinline__ void qk_tile(f32x16& p0, f32x16& p1, const LAS unsigned char* Kt, const bf16x8 (&qr)[4], int koff) {
    bf16x8 kf[2][2];
    kf[0][0] = *(const LAS bf16x8*)(Kt + koff); kf[0][1] = *(const LAS bf16x8*)(Kt + koff + 32 * KP);
    const f32x16 z = {0.f, 0.f, 0.f, 0.f, 0.f, 0.f, 0.f, 0.f, 0.f, 0.f, 0.f, 0.f, 0.f, 0.f, 0.f, 0.f};
#pragma unroll
    for (int d0 = 0; d0 < 4; ++d0) {
        if (d0 < 3) { kf[(d0 + 1) & 1][0] = *(const LAS bf16x8*)(Kt + koff + (d0 + 1) * 32); kf[(d0 + 1) & 1][1] = *(const LAS bf16x8*)(Kt + koff + 32 * KP + (d0 + 1) * 32); }
        if (d0 == 0) { p0 = mfma32(kf[0][0], qr[0], z); p1 = mfma32(kf[0][1], qr[0], z); }
        else { p0 = mfma32(kf[d0 & 1][0], qr[d0], p0); p1 = mfma32(kf[d0 & 1][1], qr[d0], p1); }
    }
}
struct SoftState { float mref, l; bool valid; };
constexpr float SM_THR = 6.0f;
template <int NDB, int PMASK> __device__ __forceinline__ void softmax_tile(const f32x16& p0, const f32x16& p1, SoftState& st, f32x16 (&o)[NDB], bf16x8 (&pb)[4], unsigned w0, unsigned w1) {
    float a = __builtin_fmaxf(__builtin_fmaxf(p0[0], p0[1]), p1[0]), b = __builtin_fmaxf(__builtin_fmaxf(p0[2], p0[3]), p1[1]);
    a = __builtin_fmaxf(__builtin_fmaxf(a, p1[2]), p1[3]);
#pragma unroll
    for (int r = 4; r < 16; r += 4) { a = __builtin_fmaxf(__builtin_fmaxf(a, p0[r]), p0[r + 1]); b = __builtin_fmaxf(__builtin_fmaxf(b, p0[r + 2]), p0[r + 3]);
                                      a = __builtin_fmaxf(__builtin_fmaxf(a, p1[r]), p1[r + 1]); b = __builtin_fmaxf(__builtin_fmaxf(b, p1[r + 2]), p1[r + 3]); }
    float rm = __builtin_fmaxf(a, b);
    { auto rr = __builtin_amdgcn_permlane32_swap(__float_as_uint(rm), __float_as_uint(rm), false, false); rm = __builtin_fmaxf(__uint_as_float(rr[0]), __uint_as_float(rr[1])); }
    const bool seen = rm > -1e30f;
    const bool need = (rm - st.mref > SM_THR) || (!st.valid && seen);
    st.valid = st.valid || seen;
    if (__ballot(need) != 0ull) {
        const float mnew = need ? rm : st.mref;
        const float f = fast_exp2(st.mref - mnew);
        st.mref = mnew;
        st.l *= f;
#pragma unroll
        for (int db = 0; db < NDB; ++db)
#pragma unroll
            for (int r = 0; r < 16; ++r) o[db][r] *= f;
    }
    float sum = 0.0f;
    const float mr = (PMASK == 2 && w0 == 0u) ? INFINITY : st.mref;
#pragma unroll
    for (int ks = 0; ks < 4; ++ks) {
        float e[8];
#pragma unroll
        for (int k = 0; k < 8; ++k) {
            const int r = 8 * (ks & 1) + k; const int bit = 16 * (r >> 3) + (r & 7);
            float v = fast_exp2((ks < 2 ? p0[r] : p1[r]) - mr);
            if (PMASK == 1) v = __uint_as_float(__float_as_uint(v) & (unsigned)__builtin_amdgcn_sbfe((int)(ks < 2 ? w0 : w1), bit, 1));
            e[k] = v; sum += v;
        }
        u32x4 w; w.x = pk2(e[0], e[1]); w.y = pk2(e[2], e[3]); w.z = pk2(e[4], e[5]); w.w = pk2(e[6], e[7]);
        pb[ks] = __builtin_bit_cast(bf16x8, w);
    }
    st.l += sum;
}
template <int NDB> __device__ __forceinline__ void pv_tile(f32x16 (&o)[NDB], const bf16x8 (&pb)[4], const LAS unsigned char* Vt, int voff) {
    constexpr int NS = 4 * NDB;
    bf16x8 vf[2][2];
#define VF_LD(s_) (*(const LAS bf16x8*)(Vt + voff + ((s_) % NDB) * 32 * KP + ((s_) / NDB) * 32))
    vf[0][0] = VF_LD(0); vf[0][1] = VF_LD(1);
#pragma unroll
    for (int s_ = 0; s_ < NS; s_ += 2) {
        const int cur = (s_ >> 1) & 1;
        if (s_ + 2 < NS) { vf[cur ^ 1][0] = VF_LD(s_ + 2); vf[cur ^ 1][1] = VF_LD(s_ + 3); }
        o[s_ % NDB] = mfma32(vf[cur][0], pb[s_ / NDB], o[s_ % NDB]);
        o[(s_ + 1) % NDB] = mfma32(vf[cur][1], pb[(s_ + 1) / NDB], o[(s_ + 1) % NDB]);
    }
#undef VF_LD
}
#define LDS_BAR() asm volatile("s_waitcnt lgkmcnt(0)\n\ts_barrier" ::: "memory")
template <int NK, int NV, int PMASK, class MaskF>
__device__ __forceinline__ void flash_run(LAS unsigned char* lds, const bf16_t* const (&ksrc)[NK], size_t ktile, const bf16_t* const (&vsrc)[NV], int NT, int nact, int ksel,
                                          const bf16x8 (&qr)[4], const MaskF& maskf, f32x16 (&o)[2 * NV], float& l_out, int tid, int r32, int hi) {
    constexpr int KB = NK * KT_BYTES, VB = NV * KT_BYTES, VBASE = 2 * KB;
    const int srow = tid >> 3, sch = tid & 7, sdst = srow * KP + sch * 16;
    const int koff = pi32(r32) * KP + hi * 16 + ksel * KT_BYTES, voff = r32 * KP + hi * 16;
    u32x4 kreg[2][NK], vreg[2][NV];
#pragma unroll
    for (int i = 0; i < NK; ++i) { kreg[0][i] = *(const u32x4*)ksrc[i]; *(LAS u32x4*)(lds + i * KT_BYTES + sdst) = kreg[0][i]; }
    if (NT > 1) {
#pragma unroll
        for (int i = 0; i < NK; ++i) { kreg[0][i] = *(const u32x4*)(ksrc[i] + ktile); *(LAS u32x4*)(lds + KB + i * KT_BYTES + sdst) = kreg[0][i]; } }
#pragma unroll
    for (int i = 0; i < NV; ++i) { vreg[0][i] = *(const u32x4*)vsrc[i]; *(LAS u32x4*)(lds + VBASE + i * KT_BYTES + sdst) = vreg[0][i]; }
    if (NT > 2) {
#pragma unroll
        for (int i = 0; i < NK; ++i) kreg[1][i] = *(const u32x4*)(ksrc[i] + 2 * ktile); }
    if (NT > 1) {
#pragma unroll
        for (int i = 0; i < NV; ++i) vreg[1][i] = *(const u32x4*)(vsrc[i] + 64); }
    LDS_BAR();
    SoftState st; st.mref = 0.0f; st.l = 0.0f; st.valid = false;
    f32x16 s0, s1, u0, u1;
    if (nact > 0) { qk_tile(s0, s1, lds, qr, koff); maskf.pre(s0, s1, 0); }
#define FLASH_STEP(t, LD, ST, C0, C1, N0, N1) do { \
        if ((t) + 3 < NT) { _Pragma("unroll") for (int i = 0; i < NK; ++i) kreg[LD][i] = *(const u32x4*)(ksrc[i] + (size_t)((t) + 3) * ktile); } \
        if ((t) + 2 < NT) { _Pragma("unroll") for (int i = 0; i < NV; ++i) vreg[LD][i] = *(const u32x4*)(vsrc[i] + ((t) + 2) * 64); } \
        if ((t) < nact) { \
            bf16x8 pb[4]; unsigned w0 = 0u, w1 = 0u; \
            if (PMASK) maskf.pbits((t), w0, w1); \
            softmax_tile<2 * NV, PMASK>(C0, C1, st, o, pb, w0, w1); \
            if ((t) + 1 < nact) { qk_tile(N0, N1, lds + (((t) + 1) & 1) * KB, qr, koff); maskf.pre(N0, N1, (t) + 1); } \
            pv_tile<2 * NV>(o, pb, lds + VBASE + ((t) & 1) * VB, voff); \
        } \
        if ((t) + 2 < NT) { _Pragma("unroll") for (int i = 0; i < NK; ++i) *(LAS u32x4*)(lds + ((t) & 1) * KB + i * KT_BYTES + sdst) = kreg[ST][i]; } \
        if ((t) + 1 < NT) { _Pragma("unroll") for (int i = 0; i < NV; ++i) *(LAS u32x4*)(lds + VBASE + (((t) + 1) & 1) * VB + i * KT_BYTES + sdst) = vreg[ST][i]; } \
        LDS_BAR(); \
    } while (0)
    int t = 0;
    for (; t + 1 < NT; t += 2) { FLASH_STEP(t, 0, 1, s0, s1, u0, u1); FLASH_STEP(t + 1, 1, 0, u0, u1, s0, s1); }
    if (t < NT) FLASH_STEP(t, 0, 1, s0, s1, u0, u1);
#undef FLASH_STEP
    asm volatile("s_waitcnt vmcnt(0)" ::: "memory");
    l_out = st.l;
}
__device__ __forceinline__ void causal_mask(f32x16& p0, f32x16& p1, int kb, int q, int hi) {
#pragma unroll
    for (int r = 0; r < 16; ++r) { const int key = kb + 16 * (r >> 3) + 8 * hi + (r & 7); if (key > q) p0[r] = NEG; if (key + 32 > q) p1[r] = NEG; }
}
__device__ __forceinline__ void store_pair16(bf16_t* dst, u32x2 a, u32x2 b, int hi) {
    { auto r = __builtin_amdgcn_permlane32_swap(a.x, b.x, false, false); a.x = r[0]; b.x = r[1]; }
    { auto r = __builtin_amdgcn_permlane32_swap(a.y, b.y, false, false); a.y = r[0]; b.y = r[1]; }
    u32x4 w; w.x = a.x; w.y = a.y; w.z = b.x; w.w = b.y;
    *(u32x4*)(dst + 8 * hi) = w;
}
template <int NDB> __device__ __forceinline__ void store_o(const f32x16 (&o)[NDB], float inv, bf16_t* dst, int hi) {
#pragma unroll
    for (int db = 0; db < NDB; ++db)
#pragma unroll
        for (int g = 0; g < 4; g += 2) {
            u32x2 a, b;
            a.x = pk2(o[db][4 * g] * inv, o[db][4 * g + 1] * inv); a.y = pk2(o[db][4 * g + 2] * inv, o[db][4 * g + 3] * inv);
            b.x = pk2(o[db][4 * g + 4] * inv, o[db][4 * g + 5] * inv); b.y = pk2(o[db][4 * g + 6] * inv, o[db][4 * g + 7] * inv);
            store_pair16(dst + 32 * db + 8 * g, a, b, hi);
        }
}

__device__ __forceinline__ void moba_unit(const bf16_t* QB, const bf16_t* KB, const bf16_t* VBT, const float* kmean, bf16_t* OB, LAS unsigned char* lds, int b, int h, int j) {
    const int tid = fresh_tid(), lane = tid & 63, r32 = lane & 31, hi = lane >> 5, wid = __builtin_amdgcn_readfirstlane(tid >> 6);
    const size_t tok0 = (size_t)b * SEQ;
    const int q = 256 * j + 32 * wid + r32;
    bf16x8 qr[4];
    { const bf16_t* qp = QB + (tok0 + q) * 256 + h * 64 + hi * 8;
#pragma unroll
      for (int d0 = 0; d0 < 4; ++d0) qr[d0] = *(const bf16x8*)(qp + d0 * 16); }
    unsigned sel = 0u;
    if (j > 0) {
        if (j <= 3) sel = (1u << j) - 1u;
        else {
            float gate[7];
#pragma unroll
            for (int n = 0; n < 7; ++n) {
                gate[n] = NEG;
                if (n < j) {
                    const float* km = kmean + ((size_t)(b * 4 + h) * 8 + n) * 128 + hi * 8; float s = 0.0f;
#pragma unroll
                    for (int d0 = 0; d0 < 4; ++d0) { const f32x4 a = *(const f32x4*)(km + d0 * 16) + *(const f32x4*)(km + 64 + d0 * 16), c = *(const f32x4*)(km + d0 * 16 + 4) + *(const f32x4*)(km + 64 + d0 * 16 + 4);
#pragma unroll
                        for (int e = 0; e < 4; ++e) { s += bf2f((unsigned short)qr[d0][e]) * a[e]; s += bf2f((unsigned short)qr[d0][4 + e]) * c[e]; } }
                    s += __shfl_xor(s, 32); gate[n] = s;
                }
            }
#pragma unroll
            for (int it = 0; it < 3; ++it) { float best = 0.0f; int bi = -1;
#pragma unroll
                for (int n = 0; n < 7; ++n) { if (n < j && !((sel >> n) & 1u) && (bi < 0 || gate[n] > best)) { best = gate[n]; bi = n; } }
                sel |= 1u << bi; }
        }
    }
    const int NT = 4 * (j + 1);
    const int srow = tid >> 3, sch = tid & 7;
    const bf16_t* const ksrc[1] = {KB + (tok0 + srow) * 256 + h * 64 + sch * 8};
    const bf16_t* const vsrc[1] = {VBT + ((size_t)(b * 4 + h) * 64 + srow) * SEQ + sch * 8};
    f32x16 o[2]; float l = 0.0f;
#pragma unroll
    for (int db = 0; db < 2; ++db)
#pragma unroll
        for (int r = 0; r < 16; ++r) o[db][r] = 0.0f;
    const int qmin = 256 * j + 32 * wid;
    struct MaskMoba { unsigned sel; int j, qmin, q, hi;
        __device__ __forceinline__ void pre(f32x16& p0, f32x16& p1, int t) const { const int kb = 64 * t; if ((t >> 2) >= j && kb + 63 > qmin) causal_mask(p0, p1, kb, q, hi); }
        __device__ __forceinline__ void pbits(int t, unsigned& w0, unsigned& w1) const { const int blk = t >> 2; const unsigned m_ = (blk >= j || ((sel >> blk) & 1u)) ? 0xffffffffu : 0u; w0 = m_; w1 = m_; } };
    const MaskMoba maskf{sel, j, qmin, q, hi};
    flash_run<1, 1, 2>(lds, ksrc, (size_t)64 * 256, vsrc, NT, (qmin + 31) / 64 + 1, 0, qr, maskf, o, l, tid, r32, hi);
    l += __shfl_xor(l, 32);
    store_o<2>(o, 1.0f / l, OB + (tok0 + q) * 256 + h * 64, hi);
}

__device__ __forceinline__ void diff_unit(const bf16_t* QC, const bf16_t* KC, const bf16_t* VCT, bf16_t* OC, LAS unsigned char* lds, int b, int h, int qblk, float lam, float outscale, const float* subg) {
    const int tid = fresh_tid(), lane = tid & 63, r32 = lane & 31, hi = lane >> 5, wid = __builtin_amdgcn_readfirstlane(tid >> 6);
    const int cmp = wid & 1, sub = wid >> 1;
    const size_t tok0 = (size_t)b * SEQ;
    const int q = 128 * qblk + 32 * sub + r32;
    bf16x8 qr[4];
    { const bf16_t* qp = QC + (tok0 + q) * 512 + (2 * h + cmp) * 64 + hi * 8;
#pragma unroll
      for (int d0 = 0; d0 < 4; ++d0) qr[d0] = *(const bf16x8*)(qp + d0 * 16); }
    const int NT = 2 * (qblk + 1);
    const int srow = tid >> 3, sch = tid & 7;
    const bf16_t* const k0p = KC + (tok0 + srow) * 512 + (2 * h) * 64 + sch * 8;
    const bf16_t* const v0p = VCT + ((size_t)(b * 4 + h) * 128 + srow) * SEQ + sch * 8;
    const bf16_t* const ksrc[2] = {k0p, k0p + 64};
    const bf16_t* const vsrc[2] = {v0p, v0p + (size_t)64 * SEQ};
    f32x16 o[4]; float l = 0.0f;
#pragma unroll
    for (int db = 0; db < 4; ++db)
#pragma unroll
        for (int r = 0; r < 16; ++r) o[db][r] = 0.0f;
    const int qmin = 128 * qblk + 32 * sub;
    struct MaskCausal { int qmin, q, hi;
        __device__ __forceinline__ void pre(f32x16& p0, f32x16& p1, int t) const { const int kb = 64 * t; if (kb + 63 > qmin) causal_mask(p0, p1, kb, q, hi); }
        __device__ __forceinline__ void pbits(int, unsigned&, unsigned&) const {} };
    const MaskCausal maskf{qmin, q, hi};
    for (int repd = 0; repd < 1 + (DIFF_REP & 1); ++repd) {
        if (repd) {
#pragma unroll
            for (int db = 0; db < 4; ++db)
#pragma unroll
                for (int r = 0; r < 16; ++r) o[db][r] = 0.0f; }
        flash_run<2, 2, 0>(lds, ksrc, (size_t)64 * 512, vsrc, NT, (qmin + 31) / 64 + 1, cmp, qr, maskf, o, l, tid, r32, hi);
    }
    l += __shfl_xor(l, 32);
    const float inv = 1.0f / l;
    LAS float* xch = (LAS float*)lds + (size_t)sub * 64 * 64 + lane;
    if (cmp == 1) {
#pragma unroll
        for (int db = 0; db < 4; ++db)
#pragma unroll
            for (int r = 0; r < 16; ++r) xch[(db * 16 + r) * 64] = o[db][r] * inv;
    }
    __syncthreads();
    if (cmp == 0) {
        float ss = 0.0f;
#pragma unroll
        for (int db = 0; db < 4; ++db)
#pragma unroll
            for (int r = 0; r < 16; ++r) { const float v = o[db][r] * inv - lam * xch[(db * 16 + r) * 64]; o[db][r] = v; ss += v * v; }
        ss += __shfl_xor(ss, 32);
        const float rstd = rsqrtf(ss * (1.0f / 128.0f) + EPS) * outscale;
        bf16_t* dst = OC + (size_t)(h >> 1) * T * 256 + (tok0 + q) * 256 + (h & 1) * 128;
#pragma unroll
        for (int db = 0; db < 4; ++db)
#pragma unroll
            for (int g = 0; g < 4; g += 2) { const int d = 32 * db + 8 * g + 4 * hi; const f32x4 sg = *(const f32x4*)(subg + d), sh = *(const f32x4*)(subg + d + 8);
                u32x2 a, b; a.x = pk2(o[db][4 * g] * rstd * sg[0], o[db][4 * g + 1] * rstd * sg[1]); a.y = pk2(o[db][4 * g + 2] * rstd * sg[2], o[db][4 * g + 3] * rstd * sg[3]);
                b.x = pk2(o[db][4 * g + 4] * rstd * sh[0], o[db][4 * g + 5] * rstd * sh[1]); b.y = pk2(o[db][4 * g + 6] * rstd * sh[2], o[db][4 * g + 7] * rstd * sh[3]);
                store_pair16(dst + 32 * db + 8 * g, a, b, hi); }
    }
    __syncthreads();
}

__device__ __forceinline__ unsigned f2key(float v) { unsigned b = __float_as_uint(v); if ((b << 1) == 0u) b = 0u; return (b & 0x80000000u) ? ~b : (b | 0x80000000u); }
__device__ __forceinline__ float key2f(unsigned k) { return (k & 0x80000000u) ? __uint_as_float(k & 0x7fffffffu) : __uint_as_float(~k); }
#define ROR_(v, n) ((unsigned)__builtin_amdgcn_update_dpp(0, (int)(v), 0x120 + (n), 0xf, 0xf, false))
__device__ __forceinline__ unsigned wave_max_u32(unsigned v) {
    v = max(v, ROR_(v, 1)); v = max(v, ROR_(v, 2)); v = max(v, ROR_(v, 4)); v = max(v, ROR_(v, 8));
    { auto r = __builtin_amdgcn_permlane16_swap(v, v, false, false); v = max((unsigned)r[0], (unsigned)r[1]); }
    { auto r = __builtin_amdgcn_permlane32_swap(v, v, false, false); v = max((unsigned)r[0], (unsigned)r[1]); }
    return v;
}
__device__ __forceinline__ unsigned wave_min_u32(unsigned v) { return ~wave_max_u32(~v); }
__device__ __forceinline__ unsigned wave_add_u32(unsigned v) {
    v += ROR_(v, 1); v += ROR_(v, 2); v += ROR_(v, 4); v += ROR_(v, 8);
    { auto r = __builtin_amdgcn_permlane16_swap(v, v, false, false); v = (unsigned)r[0] + (unsigned)r[1]; }
    { auto r = __builtin_amdgcn_permlane32_swap(v, v, false, false); v = (unsigned)r[0] + (unsigned)r[1]; }
    return v;
}
__device__ __forceinline__ int count_ge(const unsigned (&u)[32], unsigned thr, int ng) {
    int c = 0;
#pragma unroll
    for (int g = 0; g < 4; ++g) if (g < ng) {
        unsigned long long m0, m1, m2, m3, m4, m5, m6, m7;
        asm("v_cmp_ge_u32_e64 %0, %8, %16\n\tv_cmp_ge_u32_e64 %1, %9, %16\n\tv_cmp_ge_u32_e64 %2, %10, %16\n\tv_cmp_ge_u32_e64 %3, %11, %16\n\t"
            "v_cmp_ge_u32_e64 %4, %12, %16\n\tv_cmp_ge_u32_e64 %5, %13, %16\n\tv_cmp_ge_u32_e64 %6, %14, %16\n\tv_cmp_ge_u32_e64 %7, %15, %16"
            : "=&s"(m0), "=&s"(m1), "=&s"(m2), "=&s"(m3), "=&s"(m4), "=&s"(m5), "=&s"(m6), "=&s"(m7)
            : "v"(u[8 * g]), "v"(u[8 * g + 1]), "v"(u[8 * g + 2]), "v"(u[8 * g + 3]), "v"(u[8 * g + 4]), "v"(u[8 * g + 5]), "v"(u[8 * g + 6]), "v"(u[8 * g + 7]), "v"(thr));
        c += (__popcll(m0) + __popcll(m1)) + (__popcll(m2) + __popcll(m3)) + (__popcll(m4) + __popcll(m5)) + (__popcll(m6) + __popcll(m7));
    }
    return c;
}
__device__ __forceinline__ unsigned pick_mid(unsigned lo, unsigned hi, int clo, int chi, int it) {
    const unsigned span = hi - lo;
    const float flo = key2f(lo << 16), fhi = key2f(((hi - 1u) << 16) | 0xffffu);
    const float fr = (it & 1) ? 0.5f : ((float)(clo - 256) - 0.5f) * fast_rcp((float)(clo - chi));
    unsigned mid = f2key(flo + fr * (fhi - flo)) >> 16;
    if ((it & 1) && it >= 8) mid = lo + (span >> 1);
    if (mid <= lo || mid >= hi) mid = lo + (span >> 1);
    return mid;
}
#define WRITELANE2(lo_, hi_, bal_, i_) asm("s_nop 1\n\tv_writelane_b32 %0, %2, %4\n\tv_writelane_b32 %1, %3, %4" : "+v"(lo_), "+v"(hi_) : "s"((unsigned)(bal_)), "s"((unsigned)((bal_) >> 32)), "n"(i_))
__device__ __forceinline__ void write_mask_row(const unsigned (&u)[32], unsigned thr, int clo, int ng, LAS unsigned* bm, int lane) {
    int wlo = 0, whi = 0;
    if (clo == 256) {
#pragma unroll
        for (int i = 0; i < 32; ++i) { const unsigned long long bal = __ballot(u[i] >= thr); WRITELANE2(wlo, whi, bal, i); }
    } else {
        const int need = 256 - count_ge(u, thr + 1u, ng);
        int run = 0; const unsigned long long below = (1ull << lane) - 1ull;
#pragma unroll
        for (int i = 0; i < 32; ++i) {
            const unsigned long long eq = __ballot(u[i] == thr); const int rank = run + __popcll(eq & below);
            const unsigned long long bal = __ballot(u[i] > thr || (u[i] == thr && rank < need)); run += __popcll(eq);
            WRITELANE2(wlo, whi, bal, i);
        }
    }
    if (lane < 32) { u32x2 w; w.x = (unsigned)wlo; w.y = (unsigned)whi; *(LAS u32x2*)(bm + 2 * lane) = w; }
}
__device__ __forceinline__ void compact_row(const unsigned (&u)[32], unsigned lo, unsigned hi, int ng, LAS unsigned* scr, int lane, unsigned& c0, unsigned& c1) {
    int base = 0;
#pragma unroll
    for (int g = 0; g < 4; ++g) if (g < ng) {
#pragma unroll
        for (int i = 8 * g; i < 8 * g + 8; ++i) {
            const bool inb = u[i] >= lo && u[i] < hi;
            const unsigned long long bal = __ballot(inb);
            const int pos = base + (int)__builtin_amdgcn_mbcnt_hi((unsigned)(bal >> 32), __builtin_amdgcn_mbcnt_lo((unsigned)bal, 0u));
            if (inb) scr[pos] = u[i];
            base += __popcll(bal);
        }
    }
    asm volatile("s_waitcnt lgkmcnt(0)" ::: "memory");
    c0 = lane < base ? scr[lane] : 0u; c1 = 64 + lane < base ? scr[64 + lane] : 0u;
}
__device__ __forceinline__ void select_rows2(const unsigned (&va)[32], const unsigned (&vb)[32], int ta, int tb, LAS unsigned* bma, LAS unsigned* bmb, LAS unsigned* scr, int lane) {
    const int na = ta + 1, nb = tb + 1;
    if (nb <= 256) {
        const int ca = na - 32 * lane, cb = nb - 32 * lane;
        bma[lane] = ca >= 32 ? 0xffffffffu : (ca <= 0 ? 0u : ((1u << ca) - 1u)); bmb[lane] = cb >= 32 ? 0xffffffffu : (cb <= 0 ? 0u : ((1u << cb) - 1u)); return; }
    const int ng = (nb + 511) >> 9;
    unsigned ua[32], ub[32];
    unsigned mxa = 0u, mna = 0xffffffffu, mxb = 0u, mnb = 0xffffffffu;
#pragma unroll
    for (int i = 0; i < 32; ++i) { const bool oka = 64 * i + lane <= ta, okb = 64 * i + lane <= tb; ua[i] = oka ? va[i] : 0u; ub[i] = okb ? vb[i] : 0u;
        mxa = max(mxa, ua[i]); mna = min(mna, oka ? va[i] : 0xffffffffu); mxb = max(mxb, ub[i]); mnb = min(mnb, okb ? vb[i] : 0xffffffffu); }
    mxa = (unsigned)__builtin_amdgcn_readfirstlane((int)wave_max_u32(mxa)); mna = (unsigned)__builtin_amdgcn_readfirstlane((int)wave_min_u32(mna));
    mxb = (unsigned)__builtin_amdgcn_readfirstlane((int)wave_max_u32(mxb)); mnb = (unsigned)__builtin_amdgcn_readfirstlane((int)wave_min_u32(mnb));
    unsigned loa = mna, hia = mxa + 1u, lob = mnb, hib = mxb + 1u;
    int cloa = na, chia = 0, clob = nb, chib = 0;
    bool acta = na > 256, actb = true;
    int it = 0;
    for (; it < 96 && ((acta && cloa - chia > 128) || (actb && clob - chib > 128)); ++it) {
        const unsigned mida = acta ? pick_mid(loa, hia, cloa, chia, it) : loa, midb = actb ? pick_mid(lob, hib, clob, chib, it) : lob;
        int ca = 0, cb = 0;
#pragma unroll
        for (int g = 0; g < 4; ++g) if (g < ng) {
            unsigned long long m0, m1, m2, m3, m4, m5, m6, m7, q0, q1, q2, q3, q4, q5, q6, q7;
            asm("v_cmp_ge_u32_e64 %0, %8, %16\n\tv_cmp_ge_u32_e64 %1, %9, %16\n\tv_cmp_ge_u32_e64 %2, %10, %16\n\tv_cmp_ge_u32_e64 %3, %11, %16\n\t"
                "v_cmp_ge_u32_e64 %4, %12, %16\n\tv_cmp_ge_u32_e64 %5, %13, %16\n\tv_cmp_ge_u32_e64 %6, %14, %16\n\tv_cmp_ge_u32_e64 %7, %15, %16"
                : "=&s"(m0), "=&s"(m1), "=&s"(m2), "=&s"(m3), "=&s"(m4), "=&s"(m5), "=&s"(m6), "=&s"(m7)
                : "v"(ua[8 * g]), "v"(ua[8 * g + 1]), "v"(ua[8 * g + 2]), "v"(ua[8 * g + 3]), "v"(ua[8 * g + 4]), "v"(ua[8 * g + 5]), "v"(ua[8 * g + 6]), "v"(ua[8 * g + 7]), "v"(mida));
            asm("v_cmp_ge_u32_e64 %0, %8, %16\n\tv_cmp_ge_u32_e64 %1, %9, %16\n\tv_cmp_ge_u32_e64 %2, %10, %16\n\tv_cmp_ge_u32_e64 %3, %11, %16\n\t"
                "v_cmp_ge_u32_e64 %4, %12, %16\n\tv_cmp_ge_u32_e64 %5, %13, %16\n\tv_cmp_ge_u32_e64 %6, %14, %16\n\tv_cmp_ge_u32_e64 %7, %15, %16"
                : "=&s"(q0), "=&s"(q1), "=&s"(q2), "=&s"(q3), "=&s"(q4), "=&s"(q5), "=&s"(q6), "=&s"(q7)
                : "v"(ub[8 * g]), "v"(ub[8 * g + 1]), "v"(ub[8 * g + 2]), "v"(ub[8 * g + 3]), "v"(ub[8 * g + 4]), "v"(ub[8 * g + 5]), "v"(ub[8 * g + 6]), "v"(ub[8 * g + 7]), "v"(midb));
            ca += (__popcll(m0) + __popcll(m1)) + (__popcll(m2) + __popcll(m3)) + (__popcll(m4) + __popcll(m5)) + (__popcll(m6) + __popcll(m7));
            cb += (__popcll(q0) + __popcll(q1)) + (__popcll(q2) + __popcll(q3)) + (__popcll(q4) + __popcll(q5)) + (__popcll(q6) + __popcll(q7));
        }
        if (acta) { if (ca >= 256) { loa = mida; cloa = ca; } else { hia = mida; chia = ca; } acta = ca != 256 && hia - loa > 1u; }
        if (actb) { if (cb >= 256) { lob = midb; clob = cb; } else { hib = midb; chib = cb; } actb = cb != 256 && hib - lob > 1u; }
    }
    if (acta || actb) {
        unsigned a0 = 0u, a1 = 0u, b0 = 0u, b1 = 0u;
        const int basea = chia, baseb = chib;
        if (acta) compact_row(ua, loa, hia, ng, scr, lane, a0, a1);
        if (actb) compact_row(ub, lob, hib, ng, scr + 128, lane, b0, b1);
        for (; it < 200 && (acta || actb); ++it) {
            const unsigned mida = acta ? pick_mid(loa, hia, cloa, chia, it) : loa, midb = actb ? pick_mid(lob, hib, clob, chib, it) : lob;
            const int ca = basea + __popcll(__ballot(a0 >= mida)) + __popcll(__ballot(a1 >= mida));
            const int cb = baseb + __popcll(__ballot(b0 >= midb)) + __popcll(__ballot(b1 >= midb));
            if (acta) { if (ca >= 256) { loa = mida; cloa = ca; } else { hia = mida; chia = ca; } acta = ca != 256 && hia - loa > 1u; }
            if (actb) { if (cb >= 256) { lob = midb; clob = cb; } else { hib = midb; chib = cb; } actb = cb != 256 && hib - lob > 1u; }
        }
    }
    if (na <= 256) { const int c = na - 32 * lane; bma[lane] = c >= 32 ? 0xffffffffu : (c <= 0 ? 0u : ((1u << c) - 1u)); }
    else write_mask_row(ua, loa, cloa, ng, bma, lane);
    write_mask_row(ub, lob, clob, ng, bmb, lane);
}

__device__ __forceinline__ void dsa_unit(const bf16_t* QA, const bf16_t* KA, const bf16_t* VAT, const bf16_t* QI, const bf16_t* KI, const float* WI, float* strip, bf16_t* OA,
                                         LAS unsigned char* lds, int b, int qblk) {
    const int tid = fresh_tid(), lane = tid & 63, r32 = lane & 31, hi = lane >> 5, wid = __builtin_amdgcn_readfirstlane(tid >> 6);
    const size_t tok0 = (size_t)b * SEQ;
    constexpr int BM_OFF = 4 * KT_BYTES;
    constexpr int QI_OFF = BM_OFF + 64 * 256, QI_PITCH = 1040, WI_OFF = QI_OFF + 32 * QI_PITCH, SCR_OFF = WI_OFF + 1024;
    LAS unsigned* bm = (LAS unsigned*)(lds + BM_OFF);
    for (int s = 0; s < 2; ++s) {
        const int qt = 2 * qblk + s;
        {
            { const int row = tid >> 4, ch = tid & 15;
              const u32x4* src = (const u32x4*)(QI + (tok0 + 32 * qt + row) * 512 + ch * 32);
              LAS u32x4* dq = (LAS u32x4*)(lds + QI_OFF + row * QI_PITCH + ch * 64);
              const u32x4 a0 = src[0], a1 = src[1], a2 = src[2], a3 = src[3]; dq[0] = a0; dq[1] = a1; dq[2] = a2; dq[3] = a3; }
            if (tid < 256) { const int row = tid >> 3, hh = tid & 7; ((LAS float*)(lds + WI_OFF))[row * 8 + hh] = WI[(tok0 + 32 * qt + row) * 8 + hh]; }
            __syncthreads();
            const LAS unsigned char* qb = lds + QI_OFF + r32 * QI_PITCH + hi * 16;
            const LAS float* wl = (const LAS float*)(lds + WI_OFF) + r32 * 8;
            for (int rep1 = 0; rep1 < 1 + (DSA_REP & 1); ++rep1) {
            bf16x8 kfn[4];
            if (wid <= qt) {
#pragma unroll
                for (int d0 = 0; d0 < 4; ++d0) kfn[d0] = *(const bf16x8*)(KI + (tok0 + 32 * wid + r32) * 64 + d0 * 16 + hi * 8); }
            for (int kt = wid; kt <= qt; kt += NWAVES) {
                bf16x8 kf[4];
#pragma unroll
                for (int d0 = 0; d0 < 4; ++d0) kf[d0] = kfn[d0];
                if (kt + NWAVES <= qt) {
#pragma unroll
                    for (int d0 = 0; d0 < 4; ++d0) kfn[d0] = *(const bf16x8*)(KI + (tok0 + 32 * (kt + NWAVES) + r32) * 64 + d0 * 16 + hi * 8); }
                f32x16 isc;
#pragma unroll
                for (int r = 0; r < 16; ++r) isc[r] = 0.0f;
#pragma unroll 1
                for (int hh = 0; hh < 8; ++hh) {
                    f32x16 lg;
#pragma unroll
                    for (int r = 0; r < 16; ++r) lg[r] = 0.0f;
#pragma unroll
                    for (int d0 = 0; d0 < 4; ++d0) { const bf16x8 qf = *(const LAS bf16x8*)(qb + hh * 128 + d0 * 32); lg = mfma32(kf[d0], qf, lg); }
                    const float w = wl[hh];
#pragma unroll
                    for (int r = 0; r < 16; ++r) isc[r] += __int_as_float(max(__float_as_int(lg[r]), 0)) * w;
                }
                unsigned short* sp = (unsigned short*)strip + (size_t)r32 * SEQ + 32 * kt + 4 * hi;
#pragma unroll
                for (int g = 0; g < 4; ++g) { u32x2 w;
                    w.x = (f2key(isc[4 * g]) >> 16) | (f2key(isc[4 * g + 1]) & 0xffff0000u); w.y = (f2key(isc[4 * g + 2]) >> 16) | (f2key(isc[4 * g + 3]) & 0xffff0000u);
                    __builtin_nontemporal_store(w, (u32x2*)(sp + 8 * g)); }
            }
            }
        }
        asm volatile("s_waitcnt vmcnt(0)" ::: "memory");
        __syncthreads();
        for (int rep2 = 0; rep2 < 1 + ((DSA_REP >> 1) & 1); ++rep2) {
#pragma unroll 1
            for (int rp = 0; rp < 2; ++rp) {
                unsigned v2[2][32];
#pragma unroll
                for (int rr = 0; rr < 2; ++rr)
#pragma unroll
                    for (int i = 0; i < 32; ++i) v2[rr][i] = __builtin_nontemporal_load((const unsigned short*)strip + (size_t)(wid + 8 * (2 * rp + rr)) * SEQ + 64 * i + lane);
                { const int ra = wid + 16 * rp, rb = ra + 8; select_rows2(v2[0], v2[1], 32 * qt + ra, 32 * qt + rb, bm + (32 * s + ra) * 64, bm + (32 * s + rb) * 64, (LAS unsigned*)(lds + SCR_OFF) + wid * 256, lane); }
            }
        }
        __syncthreads();
    }
    const int head = wid & 3, sub = wid >> 2;
    const int q = 64 * qblk + 32 * sub + r32;
    bf16x8 qr[4];
    { const bf16_t* qp = QA + (tok0 + q) * 256 + head * 64 + hi * 8;
#pragma unroll
      for (int d0 = 0; d0 < 4; ++d0) qr[d0] = *(const bf16x8*)(qp + d0 * 16); }
    const int NT = qblk + 1;
    const int srow = tid >> 3, sch = tid & 7;
    const bf16_t* const ksrc[1] = {KA + (tok0 + srow) * 64 + sch * 8};
    const bf16_t* const vsrc[1] = {VAT + ((size_t)b * 64 + srow) * SEQ + sch * 8};
    for (int rep3 = 0; rep3 < 1 + ((DSA_REP >> 2) & 1); ++rep3) {
    f32x16 o[2]; float l = 0.0f;
#pragma unroll
    for (int db = 0; db < 2; ++db)
#pragma unroll
        for (int r = 0; r < 16; ++r) o[db][r] = 0.0f;
    const LAS unsigned* bmq = bm + (32 * sub + r32) * 64;
    struct MaskBits { const LAS unsigned* bmq; int hi;
        __device__ __forceinline__ void pre(f32x16&, f32x16&, int) const {}
        __device__ __forceinline__ void pbits(int t, unsigned& w0, unsigned& w1) const { w0 = bmq[2 * t] >> (8 * hi); w1 = bmq[2 * t + 1] >> (8 * hi); } };
    const MaskBits maskf{bmq, hi};
    flash_run<1, 1, 1>(lds, ksrc, (size_t)64 * 64, vsrc, NT, NT, 0, qr, maskf, o, l, tid, r32, hi);
    l += __shfl_xor(l, 32);
    store_o<2>(o, 1.0f / l, OA + (tok0 + q) * 256 + head * 64, hi);
    }
}
}

__device__ __forceinline__ void phase_attention(const Ctx& c, LAS unsigned char* lds, int layer) {
    unsigned char* A = c.ws + WS_A;
    const bf16_t *QA = (const bf16_t*)(A + A_QA), *KA = (const bf16_t*)(A + A_KA), *VAT = (const bf16_t*)(A + A_VAT), *QI = (const bf16_t*)(A + A_QI), *KI = (const bf16_t*)(A + A_KI);
    const float* WI = (const float*)(A + A_WI);
    const bf16_t *QB = (const bf16_t*)(A + A_QB), *KB = (const bf16_t*)(A + A_KB), *VBT = (const bf16_t*)(A + A_VBT), *QC = (const bf16_t*)(A + A_QC), *KC = (const bf16_t*)(A + A_KC), *VCT = (const bf16_t*)(A + A_VCT);
    bf16_t *OA = (bf16_t*)((unsigned char*)c.out + DO_O), *OB = OA + (size_t)T * 256, *OC = OB + (size_t)T * 256;
    const float* kmean = (const float*)(c.ws + WS_CTL + CTL_KMEAN) + (size_t)layer * (16 * 4 * 8 * 2 * 64);
    float* strip = (float*)(c.ws + WS_G) + (size_t)blockIdx.x * 32 * SEQ;
    const int GW = gridDim.x, vcu = (GW % 8 == 0) ? ((int)blockIdx.x % 8) * (GW / 8) + (int)blockIdx.x / 8 : (int)blockIdx.x;

    if (ATT_MASK & 1) for (int rep = 0; rep < 1 + (ATT_REP & 1); ++rep) for (int w = vcu; w < 256; w += GW) {
        const int b = w >> 4, p = w & 15;
        for (int k = 0; k < 2; ++k) att::dsa_unit(QA, KA, VAT, QI, KI, WI, strip, OA, lds, b, k ? 31 - p : p);
    }
    if (ATT_MASK & 2) for (int rep = 0; rep < 1 + ((ATT_REP >> 1) & 1); ++rep) for (int w = vcu; w < 256; w += GW) {
        const int b = w >> 4, h = (w >> 2) & 3, jp = w & 3;
        for (int k = 0; k < 2; ++k) att::moba_unit(QB, KB, VBT, kmean, OB, lds, b, h, k ? 7 - jp : jp);
    }
    if (ATT_MASK & 4) {
        const float* lp = c.lam_p + (size_t)layer * 4 * 64; const int lane = fresh_tid() & 63;
        const float s1 = wave_sum(lp[lane] * lp[64 + lane]), s2 = wave_sum(lp[128 + lane] * lp[192 + lane]);
        const float lam_init = 0.8f - 0.6f * expf(-0.3f * (float)layer);
        const float lam = expf(s1) - expf(s2) + lam_init;
        const float* subg = c.subln_g + (size_t)layer * 128;
        for (int rep = 0; rep < 1 + ((ATT_REP >> 2) & 1); ++rep) for (int w = vcu; w < 512; w += GW) {
            const int b = w >> 5, h = (w >> 3) & 3, qp = w & 7;
            for (int k = 0; k < 2; ++k) att::diff_unit(QC, KC, VCT, OC, lds, b, h, k ? 15 - qp : qp, lam, 1.0f - lam_init, subg);
        }
    }
}

constexpr int RING_BYTES = 131072, MISC_OFF = RING_BYTES, GAIN_LDS_OFF = MISC_OFF + 1024, LDS_BYTES = 147456;
struct Args { const void* in[12]; float* out; unsigned char* ws; int ph_lo, ph_hi; };
static_assert(sizeof(Args) == 12 * 8 + 8 + 8 + 8, "Args has no padding");

__global__ void __launch_bounds__(NTHREADS, 2) hybrid_fwd(Args args) {
    extern __shared__ __attribute__((aligned(16))) unsigned char lds_raw[];
    LAS unsigned char* lds = (LAS unsigned char*)lds_raw;
    volatile LAS unsigned* MISC = (volatile LAS unsigned*)(lds + MISC_OFF);
    const int tid = threadIdx.x;
    if (tid < 64) MISC[tid] = 0u;
    __syncthreads();
    Ctx c;
    c.x_in = (const float*)args.in[0]; c.pos = (const int*)args.in[1]; c.norm_g = (const float*)args.in[2]; c.w_in = (const float*)args.in[3]; c.qk_g = (const float*)args.in[4];
    c.lam_p = (const float*)args.in[5]; c.subln_g = (const float*)args.in[6]; c.w_branch = (const float*)args.in[7]; c.w_out = (const float*)args.in[8];
    c.w_gate = (const float*)args.in[9]; c.w_up = (const float*)args.in[10]; c.w_down = (const float*)args.in[11];
    c.out = args.out; c.ws = args.ws;
    const int lo = args.ph_lo, hi = args.ph_hi;
    unsigned* ctl = (unsigned*)(c.ws + WS_CTL);
    XcdBarrier bar; bar.bar = ctl + CW_BAR; bar.x = 0u; bar.st = MISC + 8;
    if (hi - lo > 1) bar = xcd_barrier_post(ctl + CW_BAR, MISC + 8);
#ifndef PH_MASK
#define PH_MASK 0xffu
#endif
#define PHE(id) ((PH_MASK >> (id)) & 1u)
#ifndef REP_MASK
#define REP_MASK 0u
#endif
#define REPN(id) (1 + (int)((REP_MASK >> (id)) & 1u))
#define IN(k) (lo <= (k) && (k) < hi)
#define SEAM(k) do { if (lo <= (k) && (k) + 1 < hi) xcd_barrier(bar); } while (0)
    const int G = gridDim.x, cb = blockIdx.x;
#define LYR() ({ int l_ = layer; asm volatile("" : "+s"(l_)); l_; })
#define WSL() ({ __attribute__((address_space(1))) unsigned char* p_ = (__attribute__((address_space(1))) unsigned char*)c.ws; asm volatile("" : "+s"(p_)); (unsigned char*)p_; })
#define OUTL() ({ __attribute__((address_space(1))) unsigned char* p_ = (__attribute__((address_space(1))) unsigned char*)c.out; asm volatile("" : "+s"(p_)); (unsigned char*)p_; })
#define H8 ((signed char*)(WSL() + WS_H8))
#define SA ((float*)(WSL() + WS_CTL + CTL_SA))
#define XB ((bf16_t*)(WSL() + WS_XB))
#define ACT ((bf16_t*)(WSL() + WS_A))
#define MRG ((bf16_t*)(WSL() + WS_A))
#define GB (WSL() + WS_G)
#define OA ((bf16_t*)(OUTL() + DO_O))
#define H ((bf16_t*)(OUTL() + DO_H))

    if (IN(0) && PHE(0)) for (int rep = 0; rep < REPN(0); ++rep) { phase_prologue(c, lds); prologue_i8<0>(c, lds); }
    SEAM(0);
    for (int layer = 0; layer < 2; ++layer) {
        const int base = 1 + 11 * layer;
        bf16_t* WL = wlayer(c, layer);
        if (IN(base + 0) && PHE(1)) for (int rep = 0; rep < REPN(1); ++rep) { if (LYR() == 0) { prologue_i8<1>(c, lds); phase_norm<false, false, true>(c.x_in, H, H8, SA); } else phase_norm<true, false, true>(XB, H, H8, SA); }
        SEAM(base + 0);
        if (IN(base + 1) && PHE(2)) for (int rep = 0; rep < REPN(2); ++rep) { pg8::Gemm g{(const bf16_t*)H8, WL + WL_GU, T, 5632, D / 2}; pg8::StaticOrder S; S.init(T, 5632, G, cb);
            EpiSwigluI8 E{ACT, SA, (const float*)(c.ws + WS_CTL + CTL_CMAX) + (size_t)layer * CMAX_PER_LAYER};
            pg8::gemm_phase<EpiSwigluI8, pg8::StaticOrder, true, true, true>(lds, g, S, E); }
        SEAM(base + 1);
        if (IN(base + 2) && PHE(3)) { pg8::Gemm g{ACT, WL + WL_DN, T, D, DFF}; RevOrder S; S.init(T, D, G, cb);
            if (LYR() == 0) { EpiResid<false, true> E{c.x_in, XB, 0.5f}; pg8::gemm_phase<EpiResid<false, true>, RevOrder, true, true>(lds, g, S, E); }
            else { EpiResid<true, true> E{XB, XB, 0.5f}; pg8::gemm_phase<EpiResid<true, true>, RevOrder, true, true>(lds, g, S, E); } }
        SEAM(base + 2);
        if (IN(base + 3) && PHE(1)) for (int rep = 0; rep < REPN(1); ++rep) phase_norm<true, false, true>(XB, H, H8, SA);
        SEAM(base + 3);
        if (IN(base + 4) && PHE(4)) for (int rep = 0; rep < REPN(4); ++rep) { pg8::Gemm g{(const bf16_t*)H8, WL + WL_IN, T, NINP, D / 2}; pg8::StaticOrder S; S.init(T, NINP, G, cb);
            { const int t_ = fresh_tid(); if (t_ < 384) ((LAS float*)(lds + GAIN_LDS_OFF))[t_] = c.qk_g[(size_t)layer * 6 * 64 + t_];
              const float* cm_ = (const float*)(WSL() + WS_CTL + CTL_CMAX) + (size_t)layer * CMAX_PER_LAYER + 2 * 5632 + 3072;
              for (int i_ = t_; i_ < NINP; i_ += NTHREADS) ((LAS float*)(lds + GAIN_LDS_OFF + 1536))[i_] = cm_[i_] * (1.0f / 127.0f);
              __syncthreads(); }
            EpiInProjT<true> E{c.ws, lds + GAIN_LDS_OFF, layer};
            pg8::gemm_phase<EpiInProjT<true>, pg8::StaticOrder, true, true, true>(lds, g, S, E); }
        SEAM(base + 4);
        if (IN(base + 5) && PHE(5)) phase_attention(c, lds, layer);
        SEAM(base + 5);
        if (IN(base + 6) && PHE(6)) for (int rep = 0; rep < REPN(6); ++rep) {
            for (int rg = 0; rg < REPN(8); ++rg) { pg8::Gemm g{(const bf16_t*)H8, WL + WL_GT, T, 3 * D, D / 2}; GateOrder S; S.base.init(T, D, G, cb);
              EpiGateI8 E{GB, SA, (const float*)(c.ws + WS_CTL + CTL_CMAX) + (size_t)layer * CMAX_PER_LAYER + 2 * 5632};
              pg8::gemm_phase<EpiGateI8, GateOrder, true, true, true>(lds, g, S, E); }
            for (int rs = 0; rs < REPN(9); ++rs) { pg8::Gemm g{OA, WL + WL_BR, T, D, 256, (size_t)T * 256 * 2, (size_t)1024 * 256 * 2}; SegOrder S; S.base.init(T, D, G, cb); EpiMergeSeg E{GB, MRG};
              pg8::gemm_phase<EpiMergeSeg, SegOrder, true, true>(lds, g, S, E); }
        }
        SEAM(base + 6);
        if (IN(base + 7) && PHE(7)) { pg8::Gemm g{MRG, WL + WL_OUT, T, D, D}; pg8::StaticOrder S; S.init(T, D, G, cb); EpiResid<true, true> E{XB, XB, 1.0f};
            pg8::gemm_phase<EpiResid<true, true>, pg8::StaticOrder, true, true>(lds, g, S, E); }
        SEAM(base + 7);
        if (IN(base + 8) && PHE(1)) for (int rep = 0; rep < REPN(1); ++rep) phase_norm<true, false, true>(XB, H, H8, SA);
        SEAM(base + 8);
        if (IN(base + 9) && PHE(2)) for (int rep = 0; rep < REPN(2); ++rep) { pg8::Gemm g{(const bf16_t*)H8, WL + WL_GU + (size_t)5632 * 1024, T, 5632, D / 2}; pg8::StaticOrder S; S.init(T, 5632, G, cb);
            EpiSwigluI8 E{ACT, SA, (const float*)(c.ws + WS_CTL + CTL_CMAX) + (size_t)layer * CMAX_PER_LAYER + 5632};
            pg8::gemm_phase<EpiSwigluI8, pg8::StaticOrder, true, true, true>(lds, g, S, E); }
        SEAM(base + 9);
        if (IN(base + 10) && PHE(3)) { pg8::Gemm g{ACT, WL + WL_DN + (size_t)1024 * 2816, T, D, DFF}; RevOrder S; S.init(T, D, G, cb);
            if (LYR() == 1) { EpiResid<true, false> E{XB, c.out, 0.5f}; pg8::gemm_phase<EpiResid<true, false>, RevOrder, true, true>(lds, g, S, E); }
            else { EpiResid<true, true> E{XB, XB, 0.5f}; pg8::gemm_phase<EpiResid<true, true>, RevOrder, true, true>(lds, g, S, E); } }
        SEAM(base + 10);
    }
#undef IN
#undef SEAM
#undef WSL
#undef LYR
#undef OUTL
#undef H8
#undef SA
#undef XB
#undef ACT
#undef MRG
#undef GB
#undef OA
#undef H
}
#define MK_AFTER_PHASE(p) do {} while (0)

extern "C" void kernel_launch(void* const* d_in, const int* in_sizes, int n_in, void* d_out, int out_size, void* d_ws, size_t ws_size, hipStream_t stream) {
    static int grid = 0;
    if (grid == 0) {
        if (n_in != 12 || in_sizes[0] != T * D || out_size != T * D || ws_size < WS_END) {
            fprintf(stderr, "kernel_launch: unexpected shapes (n_in %d, in0 %d, out %d, ws %zu < %zu); nothing launched\n", n_in, n_in > 0 ? in_sizes[0] : -1, out_size, ws_size, (size_t)WS_END); grid = -1; return; }
        int dev = 0, cus = 0, per_cu = 0;
        if (hipGetDevice(&dev) != hipSuccess || hipDeviceGetAttribute(&cus, hipDeviceAttributeMultiprocessorCount, dev) != hipSuccess) { grid = -1; return; }
        if (hipFuncSetAttribute((const void*)hybrid_fwd, hipFuncAttributeMaxDynamicSharedMemorySize, LDS_BYTES) != hipSuccess) { fprintf(stderr, "kernel_launch: hipFuncSetAttribute failed\n"); grid = -1; return; }
        if (hipOccupancyMaxActiveBlocksPerMultiprocessor(&per_cu, (const void*)hybrid_fwd, NTHREADS, LDS_BYTES) != hipSuccess || per_cu < 1)
            fprintf(stderr, "kernel_launch: occupancy query reports %d workgroups per CU\n", per_cu);
        (void)hipGetLastError();
        grid = cus > 0 ? cus : 256;
        if (grid > 256) grid = 256;
    }
    if (grid < 0) return;
    (void)hipMemsetAsync((char*)d_ws + WS_CTL, 0, CTL_BYTES, stream);
    Args a{};
    for (int i = 0; i < 12; ++i) a.in[i] = d_in[i];
    a.out = (float*)d_out; a.ws = (unsigned char*)d_ws;
#if MK_N_LAUNCHES == 1
    a.ph_lo = 0; a.ph_hi = NPHASE;
    hipLaunchKernelGGL(hybrid_fwd, dim3(grid), dim3(NTHREADS), LDS_BYTES, stream, a);
#else
    for (int p = 0; p < NPHASE; ++p) {
        a.ph_lo = p; a.ph_hi = p + 1;
        hipLaunchKernelGGL(hybrid_fwd, dim3(grid), dim3(NTHREADS), LDS_BYTES, stream, a);
        MK_AFTER_PHASE(p);
    }
#endif
}
```

```cpp
#include <hip/hip_runtime.h>
#include <cstdio>
#include <cstdint>
#ifndef MK_N_LAUNCHES
#define MK_N_LAUNCHES 1
#endif
#ifndef MK_CHECKS
#define MK_CHECKS 0
#endif
__device__ __forceinline__ int fresh_tid() { int t = threadIdx.x; asm volatile("" : "+v"(t)); return t; }
#ifndef ATT_MASK
#define ATT_MASK 7
#endif
#ifndef ATT_REP
#define ATT_REP 0
#endif
#ifndef DSA_REP
#define DSA_REP 0
#endif
#ifndef DIFF_REP
#define DIFF_REP 0
#endif
namespace pg8 {
#define PG8_LAS __attribute__((address_space(3)))
typedef unsigned short bf16_t;
typedef short bf16x8 __attribute__((ext_vector_type(8)));
typedef float f32x4 __attribute__((ext_vector_type(4)));
typedef unsigned u32x4 __attribute__((ext_vector_type(4)));
constexpr int BM = 256, BK = 64, HALF = 128, HTB = HALF * BK * 2  , STAGE_BYTES = 8 * HTB, NXCD = 8, WGM = 8;

__host__ __device__ __forceinline__ int lds_byte(int r, int c) { const int st = (r >> 4) * 2 + (c >> 5), rr = r & 15, cc = c & 31, ob = rr * 64 + cc * 2; return st * 1024 + (ob ^ (((ob >> 9) & 1) << 5)); }
__host__ __device__ __forceinline__ void stage_rc(int b, int& R, int& C) { const int st = b / 1024, sb = b % 1024, swz = sb ^ (((sb >> 9) & 1) << 5); R = (st >> 1) * 16 + swz / 64; C = (st & 1) * 32 + (swz % 64) / 2; }
__host__ __device__ __forceinline__ int perm32(int rho) { const int n = rho >> 4, i = rho & 15; return 8 * (i >> 2) + 4 * n + (i & 3); }

struct Unit { int pm, pn, seg; };
struct Gemm { const bf16_t* A; const bf16_t* Bt; int M, N, K; size_t segA = 0, segB = 0; };

struct StaticOrder {
    int nM, nN, nwg, G, c;
    __host__ __device__ void init(int M, int N, int G_, int c_) { nM = M / BM; nN = N / BM; nwg = nM * nN; G = G_; c = c_; }
    __host__ __device__ bool next(int i, Unit& u) const {
        const long L = (long)i * G + c; if (L >= nwg) return false;
        int wgid = (int)L; { const int q = nwg / NXCD, r = nwg % NXCD, xcd = wgid % NXCD, off = wgid / NXCD; wgid = (xcd < r ? xcd * (q + 1) : r * (q + 1) + (xcd - r) * q) + off; }
        const int nig = WGM * nN, gid = wgid / nig, fm = gid * WGM, gsz = (nM - fm) < WGM ? (nM - fm) : WGM;
        u.pm = fm + ((wgid % nig) % gsz); u.pn = (wgid % nig) / gsz; u.seg = 0; return true;
    }
    __device__ __forceinline__ void a_ready(const Unit&) const {}
    __device__ __forceinline__ void done(const Unit&) const {}
};

__device__ __forceinline__ unsigned cvt_pk_bf16(float lo, float hi) { unsigned r; asm volatile("v_cvt_pk_bf16_f32 %0, %1, %2" : "=v"(r) : "v"(lo), "v"(hi)); return r; }
typedef float f32x2 __attribute__((ext_vector_type(2)));
typedef int i32x4 __attribute__((ext_vector_type(4)));
template <bool I8> struct MmaOp;
template <> struct MmaOp<false> { typedef f32x4 acc_t; static __device__ __forceinline__ f32x4 mma(bf16x8 b, bf16x8 a, f32x4 c) { return __builtin_amdgcn_mfma_f32_16x16x32_bf16(b, a, c, 0, 0, 0); } };
template <> struct MmaOp<true>  { typedef i32x4 acc_t; static __device__ __forceinline__ i32x4 mma(bf16x8 b, bf16x8 a, i32x4 c) { return __builtin_amdgcn_mfma_i32_16x16x64_i8(__builtin_bit_cast(i32x4, b), __builtin_bit_cast(i32x4, a), c, 0, 0, 0); } };
template <class Epi, class Sched, bool ALIGN_EPI = false, bool SP2 = false, bool I8 = false>
__device__ __forceinline__ void gemm_phase(PG8_LAS unsigned char* lds, const Gemm g, const Sched& S, const Epi& E) {
    const int tid = fresh_tid(), wid = __builtin_amdgcn_readfirstlane(tid >> 6), lane = tid & 63, wr = wid >> 2, wc = wid & 3, fr = lane & 15, fq = lane >> 4;
    const int K = g.K, nt = K / BK;
    unsigned voffA[2], voffB[2];
#pragma unroll
    for (int i = 0; i < 2; ++i) { int R, C; stage_rc(tid * 16 + i * 8192, R, C); const int Rb = Epi::PERM ? ((R & ~31) + perm32(R & 31)) : R;
        voffA[i] = (unsigned)(R * K + C) * 2u; voffB[i] = (unsigned)(Rb * K + C) * 2u; }
    const size_t kstep = (size_t)(BK * 2);
    const size_t hstep = (size_t)HALF * K * 2;
    const size_t tstep = 2 * hstep;
    const unsigned ldsw = (unsigned)wid * 1024u;
    const int aoff = lds_byte(wr * 64 + fr, fq * 8), boff = lds_byte(wc * 32 + fr, fq * 8);
#define PG8_SA(b, h) (((b) * 2 + (h)) * HTB)
#define PG8_SB(b, h) ((4 + (b) * 2 + (h)) * HTB)
#define PG8_STAGE(bufoff, gbase, voff) do { _Pragma("unroll") for (int _i = 0; _i < 2; ++_i) \
        __builtin_amdgcn_global_load_lds((const unsigned*)((const char*)(gbase) + (voff)[_i]), (PG8_LAS unsigned*)(lds + (bufoff) + ldsw + _i * 8192), 16, 0, 0); } while (0)
#define PG8_LDA(dst, b, h) do { _Pragma("unroll") for (int m = 0; m < 4; ++m) _Pragma("unroll") for (int k = 0; k < 2; ++k) dst[m][k] = *(const PG8_LAS bf16x8*)(lds + PG8_SA(b, h) + aoff + m * 2048 + k * 1024); } while (0)
#define PG8_LDB(dst, b, h) do { _Pragma("unroll") for (int n = 0; n < 2; ++n) _Pragma("unroll") for (int k = 0; k < 2; ++k) dst[n][k] = *(const PG8_LAS bf16x8*)(lds + PG8_SB(b, h) + boff + n * 2048 + k * 1024); } while (0)
#define PG8_MMA(ai, bj, At, Bt) do { __builtin_amdgcn_s_setprio(1); _Pragma("unroll") for (int m = 0; m < 4; ++m) _Pragma("unroll") for (int n = 0; n < 2; ++n) _Pragma("unroll") for (int k = 0; k < 2; ++k) \
        acc[ai][bj][m][n] = MmaOp<I8>::mma(Bt[n][k], At[m][k], acc[ai][bj][m][n]); __builtin_amdgcn_s_setprio(0); } while (0)
#define PG8_WAIT_V(n) asm volatile("s_waitcnt vmcnt(" #n ")" ::: "memory")
#define PG8_WAIT_L(n) asm volatile("s_waitcnt lgkmcnt(" #n ")" ::: "memory")
#define PG8_BAR __builtin_amdgcn_s_barrier()
#define PG8_SCHED __builtin_amdgcn_sched_barrier(0)
    Unit cur, nxt; int ui = 0;
    if (!S.next(0, cur)) return;
    typedef typename MmaOp<I8>::acc_t acc_t;
    acc_t acc[2][2][4][2];
#pragma unroll
    for (int a = 0; a < 2; ++a)
#pragma unroll
        for (int b = 0; b < 2; ++b)
#pragma unroll
            for (int m = 0; m < 4; ++m)
#pragma unroll
                for (int n = 0; n < 2; ++n) acc[a][b][m][n] = acc_t{};
    bf16x8 At[4][2], B0[2][2], B1[2][2];
    const char* cA = (const char*)g.A + (size_t)cur.pm * tstep + (size_t)cur.seg * g.segA; const char* cB = (const char*)g.Bt + (size_t)cur.pn * tstep + (size_t)cur.seg * g.segB;
    S.a_ready(cur);
    if constexpr (SP2) {
        PG8_STAGE(PG8_SB(0, 0), cB, voffB); PG8_STAGE(PG8_SB(0, 1), cB + hstep, voffB); PG8_STAGE(PG8_SA(0, 0), cA, voffA); PG8_STAGE(PG8_SA(0, 1), cA + hstep, voffA);
        if (wr == 1) PG8_BAR;
        PG8_WAIT_V(2); PG8_BAR;
        PG8_STAGE(PG8_SB(1, 0), cB + kstep, voffB); PG8_STAGE(PG8_SA(1, 0), cA + kstep, voffA); PG8_STAGE(PG8_SB(1, 1), cB + hstep + kstep, voffB);
        PG8_WAIT_V(6); PG8_BAR;
    } else {
        PG8_STAGE(PG8_SB(0, 0), cB, voffB); PG8_STAGE(PG8_SA(0, 0), cA, voffA); PG8_STAGE(PG8_SB(0, 1), cB + hstep, voffB); PG8_STAGE(PG8_SA(0, 1), cA + hstep, voffA);
        if (wr == 1) PG8_BAR;
        PG8_WAIT_V(4); PG8_BAR;
        PG8_STAGE(PG8_SB(1, 0), cB + kstep, voffB); PG8_STAGE(PG8_SA(1, 0), cA + kstep, voffA); PG8_STAGE(PG8_SB(1, 1), cB + hstep + kstep, voffB);
        PG8_WAIT_V(6); PG8_BAR;
    }
    for (;;) {
        const bool has_next = S.next(ui + 1, nxt);
        const char* nA = has_next ? (const char*)g.A + (size_t)nxt.pm * tstep + (size_t)nxt.seg * g.segA : cA; const char* nB = has_next ? (const char*)g.Bt + (size_t)nxt.pn * tstep + (size_t)nxt.seg * g.segB : cB;
        for (int t = 0; t < nt; t += 2) {
            const bool last = (t == nt - 2);
            const char* a1 = cA + (size_t)(t + 1) * kstep;
            const char* a2 = last ? nA : cA + (size_t)(t + 2) * kstep; const char* b2 = last ? nB : cB + (size_t)(t + 2) * kstep;
            const char* a3 = a2 + kstep; const char* b3 = b2 + kstep;
            if (last && has_next) S.a_ready(nxt);
            if constexpr (SP2) {
            PG8_LDB(B0, 0, 0); PG8_LDB(B1, 0, 1); PG8_SCHED; PG8_LDA(At, 0, 0); PG8_STAGE(PG8_SA(1, 1), a1 + hstep, voffA);
            PG8_WAIT_V(8); PG8_WAIT_L(0); PG8_BAR; PG8_MMA(0, 0, At, B0); PG8_MMA(0, 1, At, B1); PG8_BAR; PG8_SCHED;
            PG8_LDA(At, 0, 1); PG8_STAGE(PG8_SB(0, 0), b2, voffB); PG8_STAGE(PG8_SB(0, 1), b2 + hstep, voffB); PG8_STAGE(PG8_SA(0, 0), a2, voffA);
            PG8_WAIT_V(8); PG8_WAIT_L(0); PG8_BAR; PG8_MMA(1, 0, At, B0); PG8_MMA(1, 1, At, B1); PG8_BAR; PG8_SCHED;
            PG8_LDB(B0, 1, 0); PG8_LDB(B1, 1, 1); PG8_SCHED; PG8_LDA(At, 1, 0); PG8_STAGE(PG8_SA(0, 1), a2 + hstep, voffA);
            PG8_WAIT_V(8); PG8_WAIT_L(0); PG8_BAR; PG8_MMA(0, 0, At, B0); PG8_MMA(0, 1, At, B1); PG8_BAR; PG8_SCHED;
            PG8_LDA(At, 1, 1); PG8_STAGE(PG8_SB(1, 0), b3, voffB); PG8_STAGE(PG8_SB(1, 1), b3 + hstep, voffB); PG8_STAGE(PG8_SA(1, 0), a3, voffA);
            PG8_WAIT_V(8); PG8_WAIT_L(0); PG8_BAR; PG8_MMA(1, 0, At, B0); PG8_MMA(1, 1, At, B1); PG8_BAR; PG8_SCHED;
            } else {
            PG8_LDB(B0, 0, 0); PG8_SCHED; PG8_LDA(At, 0, 0); PG8_STAGE(PG8_SA(1, 1), a1 + hstep, voffA);
            PG8_WAIT_L(8); PG8_BAR; PG8_WAIT_L(0); PG8_MMA(0, 0, At, B0); PG8_BAR; PG8_SCHED;
            PG8_LDB(B1, 0, 1); PG8_STAGE(PG8_SB(0, 0), b2, voffB);
            PG8_BAR; PG8_WAIT_L(0); PG8_MMA(0, 1, At, B1); PG8_BAR;
            PG8_LDA(At, 0, 1); PG8_STAGE(PG8_SA(0, 0), a2, voffA);
            PG8_BAR; PG8_WAIT_L(0); PG8_MMA(1, 0, At, B0); PG8_BAR; PG8_SCHED;
            PG8_STAGE(PG8_SB(0, 1), b2 + hstep, voffB);
            PG8_WAIT_V(6); PG8_BAR; PG8_MMA(1, 1, At, B1); PG8_BAR;
            PG8_LDB(B0, 1, 0); PG8_SCHED; PG8_LDA(At, 1, 0); PG8_STAGE(PG8_SA(0, 1), a2 + hstep, voffA);
            PG8_WAIT_L(8); PG8_BAR; PG8_WAIT_L(0); PG8_MMA(0, 0, At, B0); PG8_BAR; PG8_SCHED;
            PG8_LDB(B1, 1, 1); PG8_STAGE(PG8_SB(1, 0), b3, voffB);
            PG8_BAR; PG8_WAIT_L(0); PG8_MMA(0, 1, At, B1); PG8_BAR;
            PG8_LDA(At, 1, 1); PG8_STAGE(PG8_SA(1, 0), a3, voffA);
            PG8_BAR; PG8_WAIT_L(0); PG8_MMA(1, 0, At, B0); PG8_BAR; PG8_SCHED;
            PG8_STAGE(PG8_SB(1, 1), b3 + hstep, voffB);
            PG8_WAIT_V(6); PG8_BAR; PG8_MMA(1, 1, At, B1); PG8_BAR;
            }
        }
        if constexpr (ALIGN_EPI) { if (wr == 0) PG8_BAR; }
        if constexpr (!Epi::AFTER_DRAIN) { E(acc, cur, wr, wc, fr, fq); S.done(cur); }
        if (!has_next) break;
        if (!E.keep(cur)) {
#pragma unroll
        for (int a = 0; a < 2; ++a)
#pragma unroll
            for (int b = 0; b < 2; ++b)
#pragma unroll
                for (int m = 0; m < 4; ++m)
#pragma unroll
                    for (int n = 0; n < 2; ++n) acc[a][b][m][n] = acc_t{};
        }
        cur = nxt; cA = nA; cB = nB; ++ui;
        if constexpr (ALIGN_EPI) { if (wr == 1) PG8_BAR; }
    }
    PG8_WAIT_V(0);
    if constexpr (!ALIGN_EPI) { if (wr == 0) PG8_BAR; }
    PG8_BAR;
    if constexpr (Epi::AFTER_DRAIN) { E.fused(acc, cur, wr, wc, fr, fq, lds, wid, lane); S.done(cur); }
#undef PG8_SA
#undef PG8_SB
#undef PG8_STAGE
#undef PG8_LDA
#undef PG8_LDB
#undef PG8_MMA
#undef PG8_WAIT_V
#undef PG8_WAIT_L
#undef PG8_BAR
#undef PG8_SCHED
}
}

#define LAS __attribute__((address_space(3)))
typedef unsigned short bf16_t;
typedef short bf16x8 __attribute__((ext_vector_type(8)));
typedef float f32x4 __attribute__((ext_vector_type(4)));
typedef float f32x16 __attribute__((ext_vector_type(16)));
typedef unsigned u32x4 __attribute__((ext_vector_type(4)));
typedef unsigned u32x2 __attribute__((ext_vector_type(2)));

constexpr int NB = 16, SEQ = 2048, T = NB * SEQ, D = 1024, DFF = 2816, NIN = 6344, NINP = 3328;
constexpr float EPS = 1e-6f;
constexpr float C2 = 0.125f * 1.4426950408889634f;
constexpr int NWAVES = 8, NTHREADS = 512;
constexpr int NPHASE = 23;

constexpr int CI_QA = 0, CI_KA = 256, CI_VA = 320, CI_QI = 384, CI_KI = 896, CI_WI = 960, CI_QB = 968, CI_KB = 1224, CI_VB = 1480, CI_QC = 1736, CI_KC = 2248, CI_VC = 2760, CI_G = 3272;

constexpr size_t MiB = 1u << 20;
constexpr size_t WS_CTL = 0, CTL_BYTES = 1 * MiB;
constexpr int CW_BAR = 4096;
constexpr size_t CTL_KMEAN = 65536;
constexpr size_t CTL_DIAG = 655360;
constexpr size_t CTL_CMAX = 720896;
constexpr int CMAX_PER_LAYER = 2 * 5632 + 3072 + 3328;
constexpr size_t CTL_SA = 901120;
constexpr size_t WS_ROPE = 1 * MiB;
constexpr size_t WS_W = 3 * MiB;
constexpr size_t WL_GU = 0, WL_DN = 2 * (size_t)5632 * 1024, WL_IN = WL_DN + 2 * (size_t)1024 * 2816, WL_GT = WL_IN + (size_t)NINP * 1024,
                 WL_BR = WL_GT + 3 * (size_t)1024 * 1024, WL_OUT = WL_BR + (size_t)1024 * 1024, WL_END = WL_OUT + (size_t)1024 * 1024;
static_assert(WL_END * 2 * 2 <= 99 * MiB, "weights");
constexpr size_t WS_XB = 102 * MiB;
constexpr size_t DO_H = 0, DO_O = 64 * MiB;
constexpr size_t WS_G = 166 * MiB;
constexpr size_t WS_A = 262 * MiB;
constexpr size_t A_QA = 0, A_KA = 16 * MiB, A_VAT = 20 * MiB, A_QI = 24 * MiB, A_KI = 56 * MiB, A_WI = 60 * MiB, A_QB = 61 * MiB, A_KB = 77 * MiB, A_VBT = 93 * MiB,
                 A_QC = 109 * MiB, A_KC = 141 * MiB, A_VCT = 173 * MiB, A_END = 205 * MiB;
constexpr size_t WS_H8 = WS_A + A_END;
constexpr size_t WS_END = WS_H8 + 32 * MiB;
static_assert(WS_END <= 512 * MiB && CTL_CMAX + 2 * CMAX_PER_LAYER * 4 <= CTL_SA && CTL_SA + (size_t)T * 4 <= CTL_BYTES, "workspace");

#define XB_TMO      128
#define XB_XCNT(j)  (256  + 64 * (j))
#define XB_XSUB(j)  (1280 + 64 * (j))
#define XB_XGEN(j)  (2304 + 64 * (j))
#define XB_TOP      3328
#define XB_TOPGEN   3392
#define XCD_BAR_WORDS 3456
#define XB_SPIN_CAP (1u << 18)
__device__ __forceinline__ unsigned xb_ld(unsigned* p)              { return __hip_atomic_load(p, __ATOMIC_RELAXED, __HIP_MEMORY_SCOPE_AGENT); }
__device__ __forceinline__ unsigned xb_add(unsigned* p, unsigned v) { return __hip_atomic_fetch_add(p, v, __ATOMIC_RELAXED, __HIP_MEMORY_SCOPE_AGENT); }
__device__ __forceinline__ unsigned xb_xcc_id() { return (unsigned)__builtin_amdgcn_s_getreg((3 << 11) | 20) & 0xFu; }
#define XB_SPIN(cond, bar) do { unsigned _sp = 0; while (cond) { __builtin_amdgcn_s_sleep(1); \
    if ((++_sp & 255u) == 0u) { if (xb_ld(&(bar)[XB_TMO])) break; if (_sp > XB_SPIN_CAP) { atomicAdd(&(bar)[XB_TMO], 1u); break; } } } } while (0)
struct XcdBarrier { unsigned* bar; unsigned x; volatile LAS unsigned* st; };
__device__ __forceinline__ XcdBarrier xcd_barrier_post(unsigned* bar, volatile LAS unsigned* st) {
    XcdBarrier b; b.bar = bar; b.x = xb_xcc_id(); b.st = st;
    if (threadIdx.x == 0) (void)xb_add(&bar[XB_XCNT(b.x)], 1u);
    return b;
}
__device__ __forceinline__ void xcd_barrier_complete(unsigned* bar, unsigned x, unsigned& nloc, unsigned& nx) {
    const unsigned G = gridDim.x * gridDim.y * gridDim.z;
    unsigned sum, cnt, mine, sp = 0u;
    for (;;) {
        sum = 0u; cnt = 0u; mine = 0u;
#pragma unroll
        for (unsigned j = 0; j < 16; ++j) { const unsigned c = xb_ld(&bar[XB_XCNT(j)]); sum += c; cnt += (c > 0u) ? 1u : 0u; mine = (j == x) ? c : mine; }
        if (sum == G) break;
        __builtin_amdgcn_s_sleep(1);
        if ((++sp & 255u) == 0u) { if (xb_ld(&bar[XB_TMO])) break; if (sp > XB_SPIN_CAP) { atomicAdd(&bar[XB_TMO], 1u); break; } }
    }
    nloc = mine > 0u ? mine : 1u; nx = cnt > 0u ? cnt : 1u;
}
__device__ __forceinline__ void xcd_barrier(const XcdBarrier& b) {
    asm volatile("s_waitcnt vmcnt(0)" ::: "memory");
    __syncthreads();
    if (threadIdx.x == 0) {
        unsigned* bar = b.bar;
        __builtin_amdgcn_s_waitcnt(0);
        unsigned nloc = b.st[0], nx = b.st[1];
        if (nloc == 0u) { xcd_barrier_complete(bar, b.x, nloc, nx); b.st[0] = nloc; b.st[1] = nx; }
        const unsigned old = xb_add(&bar[XB_XSUB(b.x)], 1u);
        const unsigned gen = old / nloc;
        if (old + 1u == (gen + 1u) * nloc) {
            __builtin_amdgcn_fence(__ATOMIC_RELEASE, "agent");
            asm volatile("s_waitcnt vmcnt(0)" ::: "memory");
            const unsigned og = xb_add(&bar[XB_TOP], 1u);
            const unsigned tg = og / nx;
            if (og + 1u == (tg + 1u) * nx) xb_add(&bar[XB_TOPGEN], 1u);
            else XB_SPIN(xb_ld(&bar[XB_TOPGEN]) == tg, bar);
            __builtin_amdgcn_fence(__ATOMIC_ACQUIRE, "agent");
            xb_add(&bar[XB_XGEN(b.x)], 1u);
            asm volatile("s_waitcnt vmcnt(0)" ::: "memory");
        } else {
            XB_SPIN(xb_ld(&bar[XB_XGEN(b.x)]) == gen, bar);
            __builtin_amdgcn_fence(__ATOMIC_ACQUIRE, "agent");
            asm volatile("s_waitcnt vmcnt(0)" ::: "memory");
        }
    }
    __syncthreads();
}

typedef float f32x2_t __attribute__((ext_vector_type(2))); typedef __bf16 bf16x2_t __attribute__((ext_vector_type(2)));
__device__ __forceinline__ unsigned pk2(float lo, float hi) { f32x2_t v = {lo, hi}; bf16x2_t b = __builtin_convertvector(v, bf16x2_t); return __builtin_bit_cast(unsigned, b); }
__device__ __forceinline__ float bf2f(unsigned short h) { return __uint_as_float((unsigned)h << 16); }
#define RORF_(v, n) __uint_as_float((unsigned)__builtin_amdgcn_update_dpp(0, (int)__float_as_uint(v), 0x120 + (n), 0xf, 0xf, false))
__device__ __forceinline__ float wave_sum(float v) {
    v += RORF_(v, 1); v += RORF_(v, 2); v += RORF_(v, 4); v += RORF_(v, 8);
    { auto r = __builtin_amdgcn_permlane16_swap(__float_as_uint(v), __float_as_uint(v), false, false); v = __uint_as_float(r[0]) + __uint_as_float(r[1]); }
    { auto r = __builtin_amdgcn_permlane32_swap(__float_as_uint(v), __float_as_uint(v), false, false); v = __uint_as_float(r[0]) + __uint_as_float(r[1]); }
    return v;
}
__device__ __forceinline__ float wave_max_f(float v) {
    v = fmaxf(v, RORF_(v, 1)); v = fmaxf(v, RORF_(v, 2)); v = fmaxf(v, RORF_(v, 4)); v = fmaxf(v, RORF_(v, 8));
    { auto r = __builtin_amdgcn_permlane16_swap(__float_as_uint(v), __float_as_uint(v), false, false); v = fmaxf(__uint_as_float(r[0]), __uint_as_float(r[1])); }
    { auto r = __builtin_amdgcn_permlane32_swap(__float_as_uint(v), __float_as_uint(v), false, false); v = fmaxf(__uint_as_float(r[0]), __uint_as_float(r[1])); }
    return v;
}
__device__ __forceinline__ float fast_exp2(float x) { return __builtin_amdgcn_exp2f(x); }
__device__ __forceinline__ float fast_rcp(float x) { return __builtin_amdgcn_rcpf(x); }
__device__ __forceinline__ float sigmoidf_(float x) { return fast_rcp(1.0f + fast_exp2(-1.4426950408889634f * x)); }

struct Ctx {
    const float* x_in; const int* pos; const float* norm_g; const float* w_in; const float* qk_g; const float* lam_p; const float* subln_g;
    const float* w_branch; const float* w_out; const float* w_gate; const float* w_up; const float* w_down;
    float* out; unsigned char* ws;
};
__device__ __forceinline__ bf16_t* wsb(const Ctx& c, size_t off) { return (bf16_t*)(c.ws + off); }
__device__ __forceinline__ bf16_t* wlayer(const Ctx& c, int layer) { return (bf16_t*)(c.ws + WS_W) + (size_t)layer * WL_END; }

struct EpiSwiglu {
    static constexpr bool PERM = true, AFTER_DRAIN = false;
    __device__ __forceinline__ bool keep(const pg8::Unit&) const { return false; }
    bf16_t* O;
    __device__ __forceinline__ void operator()(const f32x4 (&acc)[2][2][4][2], const pg8::Unit& u, int wr, int wc, int fr_in, int fq_in) const {
        int fr = fr_in, fq = fq_in; asm volatile("" : "+v"(fr), "+v"(fq));
        const int row0 = u.pm * 256 + wr * 64 + fr, col = u.pn * 128 + wc * 32 + 8 * fq;
#pragma unroll
        for (int ai = 0; ai < 2; ++ai)
#pragma unroll
            for (int m = 0; m < 4; ++m) {
                float a[8];
#pragma unroll
                for (int n = 0; n < 2; ++n)
#pragma unroll
                    for (int e = 0; e < 4; ++e) { const float g = acc[ai][0][m][n][e], up = acc[ai][1][m][n][e]; a[4 * n + e] = g * sigmoidf_(g) * up; }
                u32x4 w; w.x = pk2(a[0], a[1]); w.y = pk2(a[2], a[3]); w.z = pk2(a[4], a[5]); w.w = pk2(a[6], a[7]);
                *(u32x4*)(O + (size_t)(row0 + ai * 128 + m * 16) * DFF + col) = w;
            }
    }
};
typedef int i32x4 __attribute__((ext_vector_type(4)));
struct EpiSwigluI8 {
    static constexpr bool PERM = true, AFTER_DRAIN = false;
    __device__ __forceinline__ bool keep(const pg8::Unit&) const { return false; }
    bf16_t* O; const float* sa; const float* cmax;
    __device__ __forceinline__ void operator()(const i32x4 (&acc)[2][2][4][2], const pg8::Unit& u, int wr, int wc, int fr_in, int fq_in) const {
        int fr = fr_in, fq = fq_in; asm volatile("" : "+v"(fr), "+v"(fq));
        const int row0 = u.pm * 256 + wr * 64 + fr, col = u.pn * 128 + wc * 32 + 8 * fq, bcol = u.pn * 256 + wc * 32 + 8 * fq;
        float sg[8], su[8];
        { const f32x4 g0 = *(const f32x4*)(cmax + bcol), g1 = *(const f32x4*)(cmax + bcol + 4), u0 = *(const f32x4*)(cmax + bcol + 128), u1 = *(const f32x4*)(cmax + bcol + 132);
#pragma unroll
          for (int k = 0; k < 4; ++k) { sg[k] = g0[k] * (1.0f / 127.0f); sg[4 + k] = g1[k] * (1.0f / 127.0f); su[k] = u0[k] * (1.0f / 127.0f); su[4 + k] = u1[k] * (1.0f / 127.0f); } }
        float sr[8];
#pragma unroll
        for (int s_ = 0; s_ < 8; ++s_) sr[s_] = sa[row0 + (s_ >> 2) * 128 + (s_ & 3) * 16];
#pragma unroll
        for (int ai = 0; ai < 2; ++ai)
#pragma unroll
            for (int m = 0; m < 4; ++m) {
                const float s = sr[ai * 4 + m];
                float a[8];
#pragma unroll
                for (int n = 0; n < 2; ++n)
#pragma unroll
                    for (int e = 0; e < 4; ++e) { const float g = (float)acc[ai][0][m][n][e] * (s * sg[4 * n + e]), up = (float)acc[ai][1][m][n][e] * (s * su[4 * n + e]); a[4 * n + e] = g * sigmoidf_(g) * up; }
                u32x4 w; w.x = pk2(a[0], a[1]); w.y = pk2(a[2], a[3]); w.z = pk2(a[4], a[5]); w.w = pk2(a[6], a[7]);
                *(u32x4*)(O + (size_t)(row0 + ai * 128 + m * 16) * DFF + col) = w;
            }
    }
};
struct EpiGateI8 {
    static constexpr bool PERM = true, AFTER_DRAIN = false;
    __device__ __forceinline__ bool keep(const pg8::Unit&) const { return false; }
    unsigned char* G; const float* sa; const float* cmax;
    __device__ __forceinline__ void operator()(const i32x4 (&acc)[2][2][4][2], const pg8::Unit& u, int wr, int wc, int fr_in, int fq_in) const {
        int fr = fr_in, fq = fq_in; asm volatile("" : "+v"(fr), "+v"(fq));
        const int row0 = u.pm * 256 + wr * 64 + fr, col0 = u.pn * 256 + wc * 32 + 8 * fq;
        float sc[2][8];
#pragma unroll
        for (int bj = 0; bj < 2; ++bj) { const f32x4 c0 = *(const f32x4*)(cmax + col0 + bj * 128), c1 = *(const f32x4*)(cmax + col0 + bj * 128 + 4);
#pragma unroll
            for (int k = 0; k < 4; ++k) { sc[bj][k] = c0[k] * (1.0f / 127.0f); sc[bj][4 + k] = c1[k] * (1.0f / 127.0f); } }
        float sr[8];
#pragma unroll
        for (int s_ = 0; s_ < 8; ++s_) sr[s_] = sa[row0 + (s_ >> 2) * 128 + (s_ & 3) * 16];
#pragma unroll
        for (int ai = 0; ai < 2; ++ai)
#pragma unroll
            for (int m = 0; m < 4; ++m)
#pragma unroll
                for (int bj = 0; bj < 2; ++bj) {
                    const float s = sr[ai * 4 + m];
                    unsigned q[8];
#pragma unroll
                    for (int k = 0; k < 8; ++k) q[k] = (unsigned)__builtin_fmaxf(__builtin_rintf(255.0f * sigmoidf_((float)acc[ai][bj][m][k >> 2][k & 3] * (s * sc[bj][k]))), 1.0f);
                    u32x2 w; w.x = q[0] | (q[1] << 8) | (q[2] << 16) | (q[3] << 24); w.y = q[4] | (q[5] << 8) | (q[6] << 16) | (q[7] << 24);
                    *(u32x2*)(G + (size_t)(row0 + ai * 128 + m * 16) * 3072 + col0 + bj * 128) = w;
                }
    }
};

template <bool IN_BF16, bool OUT_BF16> struct EpiResid {
    static constexpr bool PERM = true, AFTER_DRAIN = false;
    __device__ __forceinline__ bool keep(const pg8::Unit&) const { return false; }
    const void* in; void* out; float alpha;
    __device__ __forceinline__ void operator()(const f32x4 (&acc)[2][2][4][2], const pg8::Unit& u, int wr, int wc, int fr_in, int fq_in) const {
        int fr = fr_in, fq = fq_in; asm volatile("" : "+v"(fr), "+v"(fq));
        const int row0 = u.pm * 256 + wr * 64 + fr, col0 = u.pn * 256 + wc * 32 + 8 * fq;
        constexpr int DEPTH = 4;
#define RS_OFF(s_, bj_) ((size_t)(row0 + ((s_) >> 2) * 128 + ((s_) & 3) * 16) * D + col0 + (bj_) * 128)
        f32x4 bufa[DEPTH][2], bufb[DEPTH][2];
#define RS_LOAD(s_, d_) do { _Pragma("unroll") for (int bj = 0; bj < 2; ++bj) { \
            if (IN_BF16) { bufa[d_][bj] = __builtin_bit_cast(f32x4, *(const u32x4*)((const bf16_t*)in + RS_OFF(s_, bj))); } \
            else { bufa[d_][bj] = *(const f32x4*)((const float*)in + RS_OFF(s_, bj)); bufb[d_][bj] = *(const f32x4*)((const float*)in + RS_OFF(s_, bj) + 4); } } } while (0)
#pragma unroll
        for (int s_ = 0; s_ < DEPTH; ++s_) RS_LOAD(s_, s_);
        asm volatile("" ::: "memory");
#pragma unroll
        for (int s_ = 0; s_ < 8; ++s_) {
            const int ai = s_ >> 2, m = s_ & 3;
#pragma unroll
            for (int bj = 0; bj < 2; ++bj) {
                f32x4 x0, x1;
                if (IN_BF16) { const u32x4 w = __builtin_bit_cast(u32x4, bufa[s_ % DEPTH][bj]);
                    x0 = (f32x4){__uint_as_float(w.x << 16), __uint_as_float(w.x & 0xffff0000u), __uint_as_float(w.y << 16), __uint_as_float(w.y & 0xffff0000u)};
                    x1 = (f32x4){__uint_as_float(w.z << 16), __uint_as_float(w.z & 0xffff0000u), __uint_as_float(w.w << 16), __uint_as_float(w.w & 0xffff0000u)}; }
                else { x0 = bufa[s_ % DEPTH][bj]; x1 = bufb[s_ % DEPTH][bj]; }
                x0 = x0 + alpha * acc[ai][bj][m][0]; x1 = x1 + alpha * acc[ai][bj][m][1];
                if (OUT_BF16) { u32x4 w; w.x = pk2(x0[0], x0[1]); w.y = pk2(x0[2], x0[3]); w.z = pk2(x1[0], x1[1]); w.w = pk2(x1[2], x1[3]); *(u32x4*)((bf16_t*)out + RS_OFF(s_, bj)) = w; }
                else { *(f32x4*)((float*)out + RS_OFF(s_, bj)) = x0; *(f32x4*)((float*)out + RS_OFF(s_, bj) + 4) = x1; }
            }
            asm volatile("" ::: "memory");
            if (s_ + DEPTH < 8) { RS_LOAD(s_ + DEPTH, s_ % DEPTH); asm volatile("" ::: "memory"); }
        }
#undef RS_LOAD
#undef RS_OFF
    }
};
struct EpiGate {
    static constexpr bool PERM = true, AFTER_DRAIN = false;
    __device__ __forceinline__ bool keep(const pg8::Unit&) const { return false; }
    unsigned char* G;
    __device__ __forceinline__ void operator()(const f32x4 (&acc)[2][2][4][2], const pg8::Unit& u, int wr, int wc, int fr_in, int fq_in) const {
        int fr = fr_in, fq = fq_in; asm volatile("" : "+v"(fr), "+v"(fq));
        const int row0 = u.pm * 256 + wr * 64 + fr, col0 = u.pn * 256 + wc * 32 + 8 * fq;
#pragma unroll
        for (int ai = 0; ai < 2; ++ai)
#pragma unroll
            for (int m = 0; m < 4; ++m)
#pragma unroll
                for (int bj = 0; bj < 2; ++bj) {
                    unsigned q[8];
#pragma unroll
                    for (int k = 0; k < 8; ++k) q[k] = (unsigned)__builtin_fmaxf(__builtin_rintf(255.0f * sigmoidf_(acc[ai][bj][m][k >> 2][k & 3])), 1.0f);
                    u32x2 w; w.x = q[0] | (q[1] << 8) | (q[2] << 16) | (q[3] << 24); w.y = q[4] | (q[5] << 8) | (q[6] << 16) | (q[7] << 24);
                    *(u32x2*)(G + (size_t)(row0 + ai * 128 + m * 16) * 3072 + col0 + bj * 128) = w;
                }
    }
};
struct EpiMerge {
    static constexpr bool PERM = true, AFTER_DRAIN = false;
    __device__ __forceinline__ bool keep(const pg8::Unit&) const { return false; }
    const unsigned char* G; bf16_t* Mg; int first;
    __device__ __forceinline__ void operator()(const f32x4 (&acc)[2][2][4][2], const pg8::Unit& u, int wr, int wc, int fr_in, int fq_in) const {
        int fr = fr_in, fq = fq_in; asm volatile("" : "+v"(fr), "+v"(fq));
        const int row0 = u.pm * 256 + wr * 64 + fr, col0 = u.pn * 256 + wc * 32 + 8 * fq;
        constexpr int DEPTH = 4;
        u32x2 gb[DEPTH][2]; u32x4 mb[DEPTH][2];
#define MS_OFF(s_, bj_) ((size_t)(row0 + ((s_) >> 2) * 128 + ((s_) & 3) * 16) * D + col0 + (bj_) * 128)
#define GS_OFF(s_, bj_) ((size_t)(row0 + ((s_) >> 2) * 128 + ((s_) & 3) * 16) * 3072 + col0 + (bj_) * 128)
#pragma unroll
        for (int s_ = 0; s_ < DEPTH; ++s_)
#pragma unroll
            for (int bj = 0; bj < 2; ++bj) { gb[s_][bj] = *(const u32x2*)(G + GS_OFF(s_, bj)); mb[s_][bj] = (u32x4){0u, 0u, 0u, 0u}; if (!first) mb[s_][bj] = *(const u32x4*)(Mg + MS_OFF(s_, bj)); }
        asm volatile("" ::: "memory");
#pragma unroll
        for (int s_ = 0; s_ < 8; ++s_) {
            const int ai = s_ >> 2, m = s_ & 3;
#pragma unroll
            for (int bj = 0; bj < 2; ++bj) {
                const u32x2 g = gb[s_ % DEPTH][bj]; const u32x4 pm_ = mb[s_ % DEPTH][bj];
                float r[8];
#pragma unroll
                for (int k = 0; k < 4; ++k) {
                    const unsigned mw = pm_[k], gw = g[k >> 1] >> (16 * (k & 1));
                    const float a0 = acc[ai][bj][m][k >> 1][(k & 1) * 2], a1 = acc[ai][bj][m][k >> 1][(k & 1) * 2 + 1];
                    r[2 * k] = __uint_as_float(mw << 16) + (float)(gw & 0xffu) * (1.0f / 255.0f) * a0;
                    r[2 * k + 1] = __uint_as_float(mw & 0xffff0000u) + (float)((gw >> 8) & 0xffu) * (1.0f / 255.0f) * a1;
                }
                u32x4 w; w.x = pk2(r[0], r[1]); w.y = pk2(r[2], r[3]); w.z = pk2(r[4], r[5]); w.w = pk2(r[6], r[7]);
                *(u32x4*)(Mg + MS_OFF(s_, bj)) = w;
            }
            asm volatile("" ::: "memory");
            if (s_ + DEPTH < 8) {
#pragma unroll
                for (int bj = 0; bj < 2; ++bj) { gb[s_ % DEPTH][bj] = *(const u32x2*)(G + GS_OFF(s_ + DEPTH, bj)); if (!first) mb[s_ % DEPTH][bj] = *(const u32x4*)(Mg + MS_OFF(s_ + DEPTH, bj)); }
                asm volatile("" ::: "memory");
            }
        }
#undef MS_OFF
#undef GS_OFF
    }
};

struct EpiMergeSeg {
    static constexpr bool PERM = true, AFTER_DRAIN = false;
    const unsigned char* G3; bf16_t* Mg;
    __device__ __forceinline__ bool keep(const pg8::Unit& u) const { return u.seg != 3; }
    __device__ __forceinline__ void operator()(f32x4 (&acc)[2][2][4][2], const pg8::Unit& u, int wr, int wc, int fr_in, int fq_in) const {
        if (u.seg == 2) return;
        int fr = fr_in, fq = fq_in; asm volatile("" : "+v"(fr), "+v"(fq));
        const int row0 = u.pm * 256 + wr * 64 + fr, col0 = u.pn * 256 + wc * 32 + 8 * fq;
        const bool last = u.seg == 3;
        const unsigned char* Gn = G3 + (last ? 2 : u.seg) * 1024;
        const unsigned char* Gd = G3 + (u.seg + 1) * 1024;
        constexpr int DEPTH = 4;
        u32x2 nb[DEPTH][2], db[DEPTH][2];
#define GS_OFF(s_, bj_) ((size_t)(row0 + ((s_) >> 2) * 128 + ((s_) & 3) * 16) * 3072 + col0 + (bj_) * 128)
#define MS_OFF(s_, bj_) ((size_t)(row0 + ((s_) >> 2) * 128 + ((s_) & 3) * 16) * D + col0 + (bj_) * 128)
#pragma unroll
        for (int s_ = 0; s_ < DEPTH; ++s_)
#pragma unroll
            for (int bj = 0; bj < 2; ++bj) { nb[s_][bj] = *(const u32x2*)(Gn + GS_OFF(s_, bj)); db[s_][bj] = (u32x2){0x01010101u, 0x01010101u}; if (!last) db[s_][bj] = *(const u32x2*)(Gd + GS_OFF(s_, bj)); }
        asm volatile("" ::: "memory");
#pragma unroll
        for (int s_ = 0; s_ < 8; ++s_) {
            const int ai = s_ >> 2, m = s_ & 3;
#pragma unroll
            for (int bj = 0; bj < 2; ++bj) {
                const u32x2 gn = nb[s_ % DEPTH][bj], gd = db[s_ % DEPTH][bj];
                float r[8];
#pragma unroll
                for (int k = 0; k < 8; ++k) {
                    const float fn = (float)((gn[k >> 2] >> (8 * (k & 3))) & 0xffu), fd = last ? 255.0f : (float)((gd[k >> 2] >> (8 * (k & 3))) & 0xffu);
                    r[k] = acc[ai][bj][m][k >> 2][k & 3] * (fn * fast_rcp(fd));
                    acc[ai][bj][m][k >> 2][k & 3] = r[k];
                }
                if (last) { u32x4 w; w.x = pk2(r[0], r[1]); w.y = pk2(r[2], r[3]); w.z = pk2(r[4], r[5]); w.w = pk2(r[6], r[7]); *(u32x4*)(Mg + MS_OFF(s_, bj)) = w; }
            }
            asm volatile("" ::: "memory");
            if (s_ + DEPTH < 8) {
#pragma unroll
                for (int bj = 0; bj < 2; ++bj) { nb[s_ % DEPTH][bj] = *(const u32x2*)(Gn + GS_OFF(s_ + DEPTH, bj)); if (!last) db[s_ % DEPTH][bj] = *(const u32x2*)(Gd + GS_OFF(s_ + DEPTH, bj)); }
                asm volatile("" ::: "memory");
            }
        }
#undef GS_OFF
#undef MS_OFF
    }
};
struct SegOrder {
    pg8::StaticOrder base;
    __device__ __forceinline__ bool next(int i, pg8::Unit& u) const { if (!base.next(i >> 2, u)) return false; u.seg = i & 3; return true; }
    __device__ __forceinline__ void a_ready(const pg8::Unit&) const {}
    __device__ __forceinline__ void done(const pg8::Unit&) const {}
};

struct RevOrder {
    pg8::StaticOrder base; int rounds;
    __device__ __forceinline__ void init(int M, int N, int G_, int c_) { base.init(M, N, G_, c_); rounds = (base.nwg - c_ + G_ - 1) / G_; }
    __device__ __forceinline__ bool next(int i, pg8::Unit& u) const { return i < rounds && base.next(rounds - 1 - i, u); }
    __device__ __forceinline__ void a_ready(const pg8::Unit&) const {}
    __device__ __forceinline__ void done(const pg8::Unit&) const {}
};

struct GateOrder {
    pg8::StaticOrder base;
    __device__ __forceinline__ bool next(int i, pg8::Unit& u) const { if (!base.next(i / 3, u)) return false; u.pn += 4 * (i % 3); return true; }
    __device__ __forceinline__ void a_ready(const pg8::Unit&) const {}
    __device__ __forceinline__ void done(const pg8::Unit&) const {}
};

template <bool I8> struct EpiInProjT {
    typedef typename pg8::MmaOp<I8>::acc_t acc_t;
    static constexpr bool PERM = true, AFTER_DRAIN = false;
    __device__ __forceinline__ bool keep(const pg8::Unit&) const { return false; }
    unsigned char* ws;
    const LAS unsigned char* gains_lds;
    int layer;
    __device__ __forceinline__ void operator()(const acc_t (&acc)[2][2][4][2], const pg8::Unit& u, int wr, int wc, int fr_in, int fq_in) const {
        int fr = fr_in, fq = fq_in; asm volatile("" : "+v"(fr), "+v"(fq));
        const int pn = u.pn;
        unsigned char* A = ws + WS_A; const float* rope = (const float*)(ws + WS_ROPE);
        float* kmean = (float*)(ws + WS_CTL + CTL_KMEAN) + (size_t)layer * (16 * 4 * 8 * 2 * 64);
        int kind = 0;
        int ng = -1;
        bool do_rope = false; float scale = 1.0f; bool do_kmean = false;
        bf16_t* dst = nullptr; int pitch = 0, coloff = 0; int vdims = 0, vdimoff = 0;
        if (pn == 0)      { dst = (bf16_t*)(A + A_QA); pitch = 256; coloff = 64 * wc; ng = 0; do_rope = true; scale = C2; }
        else if (pn == 1) {
            if (wc == 0)      { dst = (bf16_t*)(A + A_KA); pitch = 64; coloff = 0; ng = 1; do_rope = true; }
            else if (wc == 1) { kind = 1; dst = (bf16_t*)(A + A_VAT); vdims = 64; vdimoff = 0; }
            else if (wc == 2) { dst = (bf16_t*)(A + A_KI); pitch = 64; coloff = 0; do_rope = true; }
            else              { kind = 2; }
        }
        else if (pn <= 3) { dst = (bf16_t*)(A + A_QI); pitch = 512; coloff = 64 * (4 * (pn - 2) + wc); do_rope = true; }
        else if (pn == 4) { dst = (bf16_t*)(A + A_QB); pitch = 256; coloff = 64 * wc; ng = 2; do_rope = true; scale = C2; }
        else if (pn == 5) { dst = (bf16_t*)(A + A_KB); pitch = 256; coloff = 64 * wc; ng = 3; do_rope = true; do_kmean = true; }
        else if (pn == 6) { kind = 1; dst = (bf16_t*)(A + A_VBT); vdims = 256; vdimoff = 64 * wc; }
        else if (pn <= 8) { dst = (bf16_t*)(A + A_QC); pitch = 512; coloff = 64 * (4 * (pn - 7) + wc); ng = 4; do_rope = true; scale = C2; }
        else if (pn <= 10){ dst = (bf16_t*)(A + A_KC); pitch = 512; coloff = 64 * (4 * (pn - 9) + wc); ng = 5; do_rope = true; }
        else              { kind = 1; dst = (bf16_t*)(A + A_VCT); vdims = 512; vdimoff = 64 * (4 * (pn - 11) + wc); }
        const int row0 = u.pm * 256 + wr * 64 + fr;
        const float* sa = (const float*)(ws + WS_CTL + CTL_SA);
        const LAS float* scp = (const LAS float*)(gains_lds + 1536) + u.pn * 256 + wc * 32 + 8 * fq;
#define IPS(ai_, m_) (sa[row0 + (ai_) * 128 + (m_) * 16])
#define IPSC() float sc_[16]; if (I8) { const LAS float* q_ = scp; asm volatile("" : "+v"(q_)); const f32x4 a_ = *(const LAS f32x4*)q_, b_ = *(const LAS f32x4*)(q_ + 4), c_ = *(const LAS f32x4*)(q_ + 128), d_ = *(const LAS f32x4*)(q_ + 132); \
        _Pragma("unroll") for (int k_ = 0; k_ < 4; ++k_) { sc_[k_] = a_[k_]; sc_[4 + k_] = b_[k_]; sc_[8 + k_] = c_[k_]; sc_[12 + k_] = d_[k_]; } }
#define IPV(ai_, bj_, m_, n_, e_) (I8 ? (float)acc[ai_][bj_][m_][n_][e_] * (rs_ * sc_[8 * (bj_) + 4 * (n_) + (e_)]) : (float)acc[ai_][bj_][m_][n_][e_])
        if (kind == 2) {
            if (fq == 0) {
                float* WI = (float*)(A + A_WI);
#pragma unroll
                for (int ai = 0; ai < 2; ++ai)
#pragma unroll
                    for (int m = 0; m < 4; ++m) { const size_t tok = (size_t)(row0 + ai * 128 + m * 16); const float rs_ = I8 ? IPS(ai, m) : 1.0f; IPSC();
                        *(f32x4*)(WI + tok * 8) = (f32x4){IPV(ai, 0, m, 0, 0), IPV(ai, 0, m, 0, 1), IPV(ai, 0, m, 0, 2), IPV(ai, 0, m, 0, 3)} * 0.04419417382415922f;
                        *(f32x4*)(WI + tok * 8 + 4) = (f32x4){IPV(ai, 0, m, 1, 0), IPV(ai, 0, m, 1, 1), IPV(ai, 0, m, 1, 2), IPV(ai, 0, m, 1, 3)} * 0.04419417382415922f; }
            }
            return;
        }
        if (kind == 1) {
            const int b = u.pm >> 3;
#pragma unroll
            for (int ai = 0; ai < 2; ++ai)
#pragma unroll
                for (int m = 0; m < 4; ++m) {
                    const float rs_ = I8 ? IPS(ai, m) : 1.0f; IPSC();
                    const int s = (row0 + ai * 128 + m * 16) & (SEQ - 1);
                    bf16_t* base = dst + ((size_t)b * vdims + vdimoff + 16 * fq) * SEQ + s;
#pragma unroll
                    for (int bj = 0; bj < 2; ++bj)
#pragma unroll
                        for (int n = 0; n < 2; ++n)
#pragma unroll
                            for (int e = 0; e < 4; e += 2) { const unsigned w = pk2(IPV(ai, bj, m, n, e), IPV(ai, bj, m, n, e + 1));
                                base[(size_t)(8 * bj + 4 * n + e) * SEQ] = (bf16_t)(w & 0xffffu); base[(size_t)(8 * bj + 4 * n + e + 1) * SEQ] = (bf16_t)(w >> 16); }
                }
            return;
        }
        const LAS float* gp = (const LAS float*)gains_lds + (ng >= 0 ? ng : 0) * 64 + 16 * fq;
        float ksum[16];
#pragma unroll
        for (int k = 0; k < 16; ++k) ksum[k] = 0.0f;
        const bool roper = do_rope && fq == 0;
        const unsigned* ropeu = (const unsigned*)rope;
        float rs_n = I8 ? IPS(0, 0) : 1.0f;
        u32x4 rt_n[2];
        if (roper) { const unsigned* rp = ropeu + (size_t)row0 * 8; rt_n[0] = *(const u32x4*)rp; rt_n[1] = *(const u32x4*)(rp + 4); }
#pragma unroll
        for (int sl = 0; sl < 8; ++sl) {
                const int ai = sl >> 2, m = sl & 3;
                const size_t tok = (size_t)(row0 + ai * 128 + m * 16);
                const float rs_ = rs_n;
                const u32x4 t0 = rt_n[0], t1 = rt_n[1];
                if (sl < 7) {
                    const int ai1 = (sl + 1) >> 2, m1 = (sl + 1) & 3;
                    if (I8) rs_n = IPS(ai1, m1);
                    if (roper) { const unsigned* rp = ropeu + (size_t)(row0 + ai1 * 128 + m1 * 16) * 8; rt_n[0] = *(const u32x4*)rp; rt_n[1] = *(const u32x4*)(rp + 4); }
                }
                float v[16];
                { IPSC();
#pragma unroll
                for (int bj = 0; bj < 2; ++bj)
#pragma unroll
                    for (int n = 0; n < 2; ++n)
#pragma unroll
                        for (int e = 0; e < 4; ++e) v[8 * bj + 4 * n + e] = IPV(ai, bj, m, n, e); }
                if (ng >= 0) {
                    float ss = 0.0f;
#pragma unroll
                    for (int k = 0; k < 16; ++k) ss += v[k] * v[k];
                    ss += __shfl_xor(ss, 16); ss += __shfl_xor(ss, 32);
                    const float rstd = rsqrtf(ss * (1.0f / 64.0f) + EPS);
                    const f32x4 g0 = *(const LAS f32x4*)gp, g1 = *(const LAS f32x4*)(gp + 4), g2 = *(const LAS f32x4*)(gp + 8), g3 = *(const LAS f32x4*)(gp + 12);
#pragma unroll
                    for (int k = 0; k < 4; ++k) { v[k] = v[k] * rstd * g0[k]; v[4 + k] = v[4 + k] * rstd * g1[k]; v[8 + k] = v[8 + k] * rstd * g2[k]; v[12 + k] = v[12 + k] * rstd * g3[k]; }
                }
                if (roper) {
#pragma unroll
                    for (int i = 0; i < 8; ++i) { const unsigned cs_ = i < 4 ? t0[i & 3] : t1[i & 3]; const float c = __uint_as_float(cs_ << 16), s = __uint_as_float(cs_ & 0xffff0000u);
                        const float x1 = v[i], x2 = v[8 + i]; v[i] = x1 * c - x2 * s; v[8 + i] = x2 * c + x1 * s; }
                }
                if (do_kmean) {
#pragma unroll
                    for (int k = 0; k < 16; ++k) ksum[k] += v[k];
                }
#pragma unroll
                for (int k = 0; k < 16; ++k) v[k] *= scale;
                bf16_t* p = dst + tok * pitch + coloff + 16 * fq;
                u32x4 w0, w1; w0.x = pk2(v[0], v[1]); w0.y = pk2(v[2], v[3]); w0.z = pk2(v[4], v[5]); w0.w = pk2(v[6], v[7]);
                w1.x = pk2(v[8], v[9]); w1.y = pk2(v[10], v[11]); w1.z = pk2(v[12], v[13]); w1.w = pk2(v[14], v[15]);
                *(u32x4*)p = w0; *(u32x4*)(p + 8) = w1;
            }
        if (do_kmean) {
#pragma unroll
            for (int k = 0; k < 16; ++k) { float s = ksum[k]; s += __shfl_xor(s, 1); s += __shfl_xor(s, 2); s += __shfl_xor(s, 4); s += __shfl_xor(s, 8); ksum[k] = s; }
            if (fr == 0) {
                float* km = kmean + (((size_t)((u.pm >> 3) * 4 + wc) * 8 + (u.pm & 7)) * 2 + wr) * 64 + 16 * fq;
#pragma unroll
                for (int k = 0; k < 16; k += 4) *(f32x4*)(km + k) = (f32x4){ksum[k], ksum[k + 1], ksum[k + 2], ksum[k + 3]};
            }
        }
    }
};
#undef IPV
#undef IPS
#undef IPSC

template <class Map> __device__ __forceinline__ void conv_item(const Map& map, int ld, int K, bf16_t* WT, const float* gk, LAS float* scr, int item, int nblk, int lane) {
    const int kb = item / nblk, nb = item % nblk, k0 = 64 * kb, n0 = 32 * nb;
    typedef const __attribute__((address_space(1))) float* gptr;
    const float* src0 = map(n0 + (lane & 31)); const bool valid = src0 != nullptr; const gptr src = (gptr)(uintptr_t)(valid ? src0 : map(0));
    float tv[32];
#pragma unroll
    for (int i = 0; i < 32; ++i) { const int kk = 2 * i + (lane >> 5); tv[i] = src[(size_t)(k0 + kk) * ld]; }
#pragma unroll
    for (int i = 0; i < 32; ++i) { const int kk = 2 * i + (lane >> 5); float v = valid ? tv[i] : 0.0f; if (gk) v *= gk[k0 + kk]; scr[kk * 33 + (lane & 31)] = v; }
    asm volatile("s_waitcnt lgkmcnt(0)" ::: "memory");
    const int c = lane & 7;
#pragma unroll
    for (int j = 0; j < 4; ++j) { const int n = (lane >> 3) + 8 * j; const LAS float* s = scr + (8 * c) * 33 + n;
        u32x4 o; o.x = pk2(s[0 * 33], s[1 * 33]); o.y = pk2(s[2 * 33], s[3 * 33]); o.z = pk2(s[4 * 33], s[5 * 33]); o.w = pk2(s[6 * 33], s[7 * 33]);
        *(u32x4*)(WT + (size_t)(n0 + n) * K + k0 + 8 * c) = o; }
    asm volatile("s_waitcnt lgkmcnt(0)" ::: "memory");
}
struct MapPlain { const float* W; __device__ __forceinline__ const float* operator()(int n) const { return W + n; } };
struct MapGU { const float* Wg; const float* Wu; __device__ __forceinline__ const float* operator()(int n) const { const int t = n >> 8, w = n & 255;
    const uintptr_t a = (uintptr_t)Wg, d = (uintptr_t)Wu - (uintptr_t)Wg; return (const float*)(a + d * (uintptr_t)(w >> 7)) + t * 128 + (w & 127); } };
struct MapIn { const float* W;
    __device__ __forceinline__ const float* operator()(int n) const {
        const int pn = n >> 8, w = n & 255, bj = w >> 7, wc = (w >> 5) & 3, fq = (w >> 3) & 3, j = w & 7, dim = 16 * fq + 8 * bj + j;
        int base;
        if (pn == 0) base = CI_QA + 64 * wc;
        else if (pn == 1) { if (wc == 0) base = CI_KA; else if (wc == 1) base = CI_VA; else if (wc == 2) base = CI_KI; else { if (dim >= 8) return nullptr; base = CI_WI; } }
        else if (pn <= 3) base = CI_QI + 64 * (4 * (pn - 2) + wc);
        else if (pn == 4) base = CI_QB + 64 * wc;
        else if (pn == 5) base = CI_KB + 64 * wc;
        else if (pn == 6) base = CI_VB + 64 * wc;
        else if (pn <= 8) base = CI_QC + 64 * (4 * (pn - 7) + wc);
        else if (pn <= 10) base = CI_KC + 64 * (4 * (pn - 9) + wc);
        else base = CI_VC + 64 * (4 * (pn - 11) + wc);
        return W + base + dim;
    } };

template <bool G64, class Map> __device__ __forceinline__ void colmax_item(const Map& map, int ld, const float* gk, unsigned* cmax, int item, int nblk, int lane) {
    const int kb = item / nblk, nb = item % nblk, k0 = 64 * kb, n0 = 32 * nb;
    typedef const __attribute__((address_space(1))) float* gptr;
    const float* src0 = map(n0 + (lane & 31)); const bool valid = src0 != nullptr; const gptr src = (gptr)(uintptr_t)(valid ? src0 : map(0));
    float tv[32];
#pragma unroll
    for (int i = 0; i < 32; ++i) { const int kk = 2 * i + (lane >> 5); tv[i] = src[(size_t)(k0 + kk) * ld]; }
    float mx = 0.0f;
#pragma unroll
    for (int i = 0; i < 32; ++i) { const int kk = 2 * i + (lane >> 5); mx = fmaxf(mx, valid ? fabsf(tv[i] * gk[k0 + kk]) : 0.0f); }
    mx = fmaxf(mx, __shfl_xor(mx, 32));
    if (G64) { mx = wave_max_f(mx); if (lane == 0) atomicMax(cmax + (n0 >> 8) * 4 + ((n0 >> 5) & 3), __float_as_uint(mx)); }
    else if (lane < 32) atomicMax(cmax + n0 + lane, __float_as_uint(mx));
}
template <bool G64, class Map> __device__ __forceinline__ void conv_item_i8(const Map& map, int ld, int K, signed char* WT, const float* gk, const float* cmax, LAS float* scr, int item, int nblk, int lane) {
    const int kb = item / nblk, nb = item % nblk, k0 = 64 * kb, n0 = 32 * nb;
    typedef const __attribute__((address_space(1))) float* gptr;
    const float* src0 = map(n0 + (lane & 31)); const bool valid = src0 != nullptr; const gptr src = (gptr)(uintptr_t)(valid ? src0 : map(0));
    const float am = G64 ? cmax[(n0 >> 8) * 4 + ((n0 >> 5) & 3)] : cmax[n0 + (lane & 31)], qs = (valid && am > 0.0f) ? 127.0f / am : 0.0f;
    float tv[32];
#pragma unroll
    for (int i = 0; i < 32; ++i) { const int kk = 2 * i + (lane >> 5); tv[i] = src[(size_t)(k0 + kk) * ld]; }
#pragma unroll
    for (int i = 0; i < 32; ++i) { const int kk = 2 * i + (lane >> 5); scr[kk * 33 + (lane & 31)] = __builtin_rintf(tv[i] * gk[k0 + kk] * qs); }
    asm volatile("s_waitcnt lgkmcnt(0)" ::: "memory");
    const int c = lane & 7;
#pragma unroll
    for (int j = 0; j < 4; ++j) { const int n = (lane >> 3) + 8 * j; const LAS float* s = scr + (8 * c) * 33 + n;
        unsigned b[8];
#pragma unroll
        for (int k = 0; k < 8; ++k) b[k] = (unsigned)(int)s[k * 33] & 0xffu;
        u32x2 o; o.x = b[0] | (b[1] << 8) | (b[2] << 16) | (b[3] << 24); o.y = b[4] | (b[5] << 8) | (b[6] << 16) | (b[7] << 24);
        *(u32x2*)(WT + (size_t)(n0 + n) * K + k0 + 8 * c) = o; }
    asm volatile("s_waitcnt lgkmcnt(0)" ::: "memory");
}
template <int PASS> __device__ __forceinline__ void prologue_i8(const Ctx& c, LAS unsigned char* lds) {
    const int tid = fresh_tid(), lane = tid & 63, wave = __builtin_amdgcn_readfirstlane(tid >> 6);
    LAS float* scr = (LAS float*)(lds + wave * 16384);
    const int gw = blockIdx.x * NWAVES + wave, NGW = gridDim.x * NWAVES;
    constexpr int I_GU = 16 * 176, I_GT3 = 16 * 96, I_IN8 = 16 * 104, PER_LAYER = 2 * I_GU + I_GT3 + I_IN8;
    for (int it = gw; it < 2 * PER_LAYER; it += NGW) {
        const int layer = it / PER_LAYER; int r = it % PER_LAYER;
        bf16_t* WL = wlayer(c, layer);
        const float* ng = c.norm_g + (size_t)layer * 3 * D;
        float* cm = (float*)(c.ws + WS_CTL + CTL_CMAX) + (size_t)layer * CMAX_PER_LAYER;
        if (r < 2 * I_GU) { const int f = r / I_GU; r %= I_GU; const size_t wo = ((size_t)layer * 2 + f) * D * DFF; const MapGU map{c.w_gate + wo, c.w_up + wo};
            if (PASS == 0) colmax_item<false>(map, DFF, ng + (f ? 2 : 0) * D, (unsigned*)cm + f * 5632, r, 176, lane);
            else conv_item_i8<false>(map, DFF, D, (signed char*)(WL + WL_GU + (size_t)f * 5632 * 1024), ng + (f ? 2 : 0) * D, cm + f * 5632, scr, r, 176, lane);
            continue; }
        r -= 2 * I_GU;
        if (r < I_GT3) { const MapPlain map{c.w_in + (size_t)layer * D * NIN + CI_G};
          if (PASS == 0) colmax_item<false>(map, NIN, ng + D, (unsigned*)cm + 2 * 5632, r, 96, lane);
          else conv_item_i8<false>(map, NIN, D, (signed char*)(WL + WL_GT), ng + D, cm + 2 * 5632, scr, r, 96, lane);
          continue; }
        r -= I_GT3;
        { const MapIn map{c.w_in + (size_t)layer * D * NIN};
          if (PASS == 0) colmax_item<false>(map, NIN, ng + D, (unsigned*)cm + 2 * 5632 + 3072, r, 104, lane);
          else conv_item_i8<false>(map, NIN, D, (signed char*)(WL + WL_IN), ng + D, cm + 2 * 5632 + 3072, scr, r, 104, lane); }
    }
}

__device__ __forceinline__ void phase_prologue(const Ctx& c, LAS unsigned char* lds) {
    const int tid = fresh_tid(), lane = tid & 63, wave = __builtin_amdgcn_readfirstlane(tid >> 6);
    LAS float* scr = (LAS float*)(lds + wave * 16384);
    const int gw = blockIdx.x * NWAVES + wave, NGW = gridDim.x * NWAVES;
    constexpr int I_GU = 16 * 176, I_DN = 44 * 32, I_IN = 16 * 104, I_GT = 16 * 32, I_BA = 4 * 32, I_BC = 8 * 32, I_OUT = 16 * 32;
    constexpr int PER_LAYER = 2 * I_DN + 4 * I_BA + I_OUT;
    for (int it = gw; it < 2 * PER_LAYER; it += NGW) {
        const int layer = it / PER_LAYER; int r = it % PER_LAYER;
        bf16_t* WL = wlayer(c, layer);
        const float* ng = c.norm_g + (size_t)layer * 3 * D;
        if (r < 2 * I_DN) { const int f = r / I_DN; r %= I_DN; const size_t wo = ((size_t)layer * 2 + f) * D * DFF;
            conv_item(MapPlain{c.w_down + wo}, D, DFF, WL + WL_DN + (size_t)f * 1024 * 2816, nullptr, scr, r, 32, lane); continue; } r -= 2 * I_DN;
        if (r < 4 * I_BA) { const int i = r / I_BA; r %= I_BA; conv_item(MapPlain{c.w_branch + (size_t)layer * D * D + (size_t)i * 256 * D}, D, 256, WL + WL_BR + (size_t)i * 1024 * 256, nullptr, scr, r, 32, lane); continue; } r -= 4 * I_BA;
        conv_item(MapPlain{c.w_out + (size_t)layer * D * D}, D, D, WL + WL_OUT, nullptr, scr, r, 32, lane);
    }
    unsigned* rope = (unsigned*)(c.ws + WS_ROPE);
    for (int idx = blockIdx.x * NTHREADS + tid; idx < T * 8; idx += gridDim.x * NTHREADS) {
        const int tok = idx >> 3, i = idx & 7;
        const float inv = i == 0 ? 1.0f : i == 1 ? 0x1.8d275ep-3f : i == 2 ? 0x1.341190p-5f : i == 3 ? 0x1.ddee9cp-8f : i == 4 ? 0x1.72ba44p-10f : i == 5 ? 0x1.1f91f0p-12f : i == 6 ? 0x1.be2188p-15f : 0x1.5a0f4ep-17f;
        const float ang = (float)c.pos[tok] * inv;
        const double rev = (double)ang * 0.15915494309189535;
        const float fr_ = (float)(rev - __builtin_rint(rev));
        rope[(size_t)tok * 8 + i] = pk2(__builtin_amdgcn_cosf(fr_), __builtin_amdgcn_sinf(fr_));
    }
}

template <bool IN_BF16, bool OUT_BF, bool OUT_I8> __device__ __forceinline__ void phase_norm(const void* xin, bf16_t* h, signed char* h8, float* sa) {
    const int tid = fresh_tid(), lane = tid & 63, wave = tid >> 6;
    const int gw = blockIdx.x * NWAVES + wave, NGW = gridDim.x * NWAVES;
    constexpr int NR = 4;
    for (int row0 = gw; row0 < T; row0 += NR * NGW) {
        float v[NR][16];
#pragma unroll
        for (int k = 0; k < NR; ++k) {
            const int row = min(row0 + k * NGW, T - 1);
            if (IN_BF16) {
                const u32x4* xr = (const u32x4*)((const bf16_t*)xin + (size_t)row * D) + 2 * lane;
                const u32x4 a = xr[0], b = xr[1]; const unsigned w[8] = {a.x, a.y, a.z, a.w, b.x, b.y, b.z, b.w};
#pragma unroll
                for (int j = 0; j < 8; ++j) { v[k][2 * j] = __uint_as_float(w[j] << 16); v[k][2 * j + 1] = __uint_as_float(w[j] & 0xffff0000u); }
            } else {
                const f32x4* xr = (const f32x4*)((const float*)xin + (size_t)row * D) + lane;
#pragma unroll
                for (int j = 0; j < 4; ++j) { const f32x4 t = xr[64 * j]; v[k][4 * j] = t.x; v[k][4 * j + 1] = t.y; v[k][4 * j + 2] = t.z; v[k][4 * j + 3] = t.w; }
            }
        }
#pragma unroll
        for (int k = 0; k < NR; ++k) {
            const int row = row0 + k * NGW;
            if (row >= T) break;
            float s = 0.0f, am = 0.0f;
#pragma unroll
            for (int j = 0; j < 16; ++j) { s += v[k][j] * v[k][j]; am = fmaxf(am, fabsf(v[k][j])); }
            const float rstd = rsqrtf(wave_sum(s) * (1.0f / D) + EPS);
            if (OUT_BF) {
                if (IN_BF16) {
                    u32x4* o = (u32x4*)(h + (size_t)row * D) + 2 * lane;
                    u32x4 a, b; a.x = pk2(v[k][0] * rstd, v[k][1] * rstd); a.y = pk2(v[k][2] * rstd, v[k][3] * rstd); a.z = pk2(v[k][4] * rstd, v[k][5] * rstd); a.w = pk2(v[k][6] * rstd, v[k][7] * rstd);
                    b.x = pk2(v[k][8] * rstd, v[k][9] * rstd); b.y = pk2(v[k][10] * rstd, v[k][11] * rstd); b.z = pk2(v[k][12] * rstd, v[k][13] * rstd); b.w = pk2(v[k][14] * rstd, v[k][15] * rstd);
                    o[0] = a; o[1] = b;
                } else {
                    u32x2* o = (u32x2*)(h + (size_t)row * D) + lane;
#pragma unroll
                    for (int j = 0; j < 4; ++j) { u32x2 w; w.x = pk2(v[k][4 * j] * rstd, v[k][4 * j + 1] * rstd); w.y = pk2(v[k][4 * j + 2] * rstd, v[k][4 * j + 3] * rstd); o[64 * j] = w; }
                }
            }
            if (OUT_I8) {
                am = wave_max_f(am);
                const float qs = am > 0.0f ? 127.0f / am : 0.0f;
                unsigned b[16];
#pragma unroll
                for (int j = 0; j < 16; ++j) b[j] = (unsigned)(int)__builtin_rintf(v[k][j] * qs) & 0xffu;
                if (IN_BF16) { u32x4 w; w.x = b[0] | (b[1] << 8) | (b[2] << 16) | (b[3] << 24); w.y = b[4] | (b[5] << 8) | (b[6] << 16) | (b[7] << 24);
                               w.z = b[8] | (b[9] << 8) | (b[10] << 16) | (b[11] << 24); w.w = b[12] | (b[13] << 8) | (b[14] << 16) | (b[15] << 24);
                               *((u32x4*)(h8 + (size_t)row * D) + lane) = w; }
                else {
#pragma unroll
                    for (int j = 0; j < 4; ++j) *((unsigned*)(h8 + (size_t)row * D) + lane + 64 * j) = b[4 * j] | (b[4 * j + 1] << 8) | (b[4 * j + 2] << 16) | (b[4 * j + 3] << 24); }
                if (lane == 0) sa[row] = rstd * am * (1.0f / 127.0f);
            }
        }
    }
}

namespace att {
constexpr int KP = 144;
constexpr int KT_BYTES = 64 * KP;
constexpr float NEG = -INFINITY;
__device__ __forceinline__ int pi32(int m) { return (m & ~12) | ((m & 8) >> 1) | ((m & 4) << 1); }
__device__ __forceinline__ f32x16 mfma32(bf16x8 a, bf16x8 b, f32x16 c) { return __builtin_amdgcn_mfma_f32_32x32x16_bf16(a, b, c, 0, 0, 0); }

__device__ __forceinline__ void qk_tile(f32x16& p0, f32x16& p1, const LAS unsigned char* Kt, const bf16x8 (&qr)[4], int koff) {
    bf16x8 kf[2][2];
    kf[0][0] = *(const LAS bf16x8*)(Kt + koff); kf[0][1] = *(const LAS bf16x8*)(Kt + koff + 32 * KP);
    const f32x16 z = {0.f, 0.f, 0.f, 0.f, 0.f, 0.f, 0.f, 0.f, 0.f, 0.f, 0.f, 0.f, 0.f, 0.f, 0.f, 0.f};
#pragma unroll
    for (int d0 = 0; d0 < 4; ++d0) {
        if (d0 < 3) { kf[(d0 + 1) & 1][0] = *(const LAS bf16x8*)(Kt + koff + (d0 + 1) * 32); kf[(d0 + 1) & 1][1] = *(const LAS bf16x8*)(Kt + koff + 32 * KP + (d0 + 1) * 32); }
        if (d0 == 0) { p0 = mfma32(kf[0][0], qr[0], z); p1 = mfma32(kf[0][1], qr[0], z); }
        else { p0 = mfma32(kf[d0 & 1][0], qr[d0], p0); p1 = mfma32(kf[d0 & 1][1], qr[d0], p1); }
    }
}
struct SoftState { float mref, l; bool valid; };
constexpr float SM_THR = 6.0f;
template <int NDB, int PMASK> __device__ __forceinline__ void softmax_tile(const f32x16& p0, const f32x16& p1, SoftState& st, f32x16 (&o)[NDB], bf16x8 (&pb)[4], unsigned w0, unsigned w1) {
    float a = __builtin_fmaxf(__builtin_fmaxf(p0[0], p0[1]), p1[0]), b = __builtin_fmaxf(__builtin_fmaxf(p0[2], p0[3]), p1[1]);
    a = __builtin_fmaxf(__builtin_fmaxf(a, p1[2]), p1[3]);
#pragma unroll
    for (int r = 4; r < 16; r += 4) { a = __builtin_fmaxf(__builtin_fmaxf(a, p0[r]), p0[r + 1]); b = __builtin_fmaxf(__builtin_fmaxf(b, p0[r + 2]), p0[r + 3]);
                                      a = __builtin_fmaxf(__builtin_fmaxf(a, p1[r]), p1[r + 1]); b = __builtin_fmaxf(__builtin_fmaxf(b, p1[r + 2]), p1[r + 3]); }
    float rm = __builtin_fmaxf(a, b);
    { auto rr = __builtin_amdgcn_permlane32_swap(__float_as_uint(rm), __float_as_uint(rm), false, false); rm = __builtin_fmaxf(__uint_as_float(rr[0]), __uint_as_float(rr[1])); }
    const bool seen = rm > -1e30f;
    const bool need = (rm - st.mref > SM_THR) || (!st.valid && seen);
    st.valid = st.valid || seen;
    if (__ballot(need) != 0ull) {
        const float mnew = need ? rm : st.mref;
        const float f = fast_exp2(st.mref - mnew);
        st.mref = mnew;
        st.l *= f;
#pragma unroll
        for (int db = 0; db < NDB; ++db)
#pragma unroll
            for (int r = 0; r < 16; ++r) o[db][r] *= f;
    }
    float sum = 0.0f;
    const float mr = (PMASK == 2 && w0 == 0u) ? INFINITY : st.mref;
#pragma unroll
    for (int ks = 0; ks < 4; ++ks) {
        float e[8];
#pragma unroll
        for (int k = 0; k < 8; ++k) {
            const int r = 8 * (ks & 1) + k; const int bit = 16 * (r >> 3) + (r & 7);
            float v = fast_exp2((ks < 2 ? p0[r] : p1[r]) - mr);
            if (PMASK == 1) v = __uint_as_float(__float_as_uint(v) & (unsigned)__builtin_amdgcn_sbfe((int)(ks < 2 ? w0 : w1), bit, 1));
            e[k] = v; sum += v;
        }
        u32x4 w; w.x = pk2(e[0], e[1]); w.y = pk2(e[2], e[3]); w.z = pk2(e[4], e[5]); w.w = pk2(e[6], e[7]);
        pb[ks] = __builtin_bit_cast(bf16x8, w);
    }
    st.l += sum;
}
template <int NDB> __device__ __forceinline__ void pv_tile(f32x16 (&o)[NDB], const bf16x8 (&pb)[4], const LAS unsigned char* Vt, int voff) {
    constexpr int NS = 4 * NDB;
    bf16x8 vf[2][2];
#define VF_LD(s_) (*(const LAS bf16x8*)(Vt + voff + ((s_) % NDB) * 32 * KP + ((s_) / NDB) * 32))
    vf[0][0] = VF_LD(0); vf[0][1] = VF_LD(1);
#pragma unroll
    for (int s_ = 0; s_ < NS; s_ += 2) {
        const int cur = (s_ >> 1) & 1;
        if (s_ + 2 < NS) { vf[cur ^ 1][0] = VF_LD(s_ + 2); vf[cur ^ 1][1] = VF_LD(s_ + 3); }
        o[s_ % NDB] = mfma32(vf[cur][0], pb[s_ / NDB], o[s_ % NDB]);
        o[(s_ + 1) % NDB] = mfma32(vf[cur][1], pb[(s_ + 1) / NDB], o[(s_ + 1) % NDB]);
    }
#undef VF_LD
}
#define LDS_BAR() asm volatile("s_waitcnt lgkmcnt(0)\n\ts_barrier" ::: "memory")
template <int NK, int NV, int PMASK, class MaskF>
__device__ __forceinline__ void flash_run(LAS unsigned char* lds, const bf16_t* const (&ksrc)[NK], size_t ktile, const bf16_t* const (&vsrc)[NV], int NT, int nact, int ksel,
                                          const bf16x8 (&qr)[4], const MaskF& maskf, f32x16 (&o)[2 * NV], float& l_out, int tid, int r32, int hi) {
    constexpr int KB = NK * KT_BYTES, VB = NV * KT_BYTES, VBASE = 2 * KB;
    const int srow = tid >> 3, sch = tid & 7, sdst = srow * KP + sch * 16;
    const int koff = pi32(r32) * KP + hi * 16 + ksel * KT_BYTES, voff = r32 * KP + hi * 16;
    u32x4 kreg[2][NK], vreg[2][NV];
#pragma unroll
    for (int i = 0; i < NK; ++i) { kreg[0][i] = *(const u32x4*)ksrc[i]; *(LAS u32x4*)(lds + i * KT_BYTES + sdst) = kreg[0][i]; }
    if (NT > 1) {
#pragma unroll
        for (int i = 0; i < NK; ++i) { kreg[0][i] = *(const u32x4*)(ksrc[i] + ktile); *(LAS u32x4*)(lds + KB + i * KT_BYTES + sdst) = kreg[0][i]; } }
#pragma unroll
    for (int i = 0; i < NV; ++i) { vreg[0][i] = *(const u32x4*)vsrc[i]; *(LAS u32x4*)(lds + VBASE + i * KT_BYTES + sdst) = vreg[0][i]; }
    if (NT > 2) {
#pragma unroll
        for (int i = 0; i < NK; ++i) kreg[1][i] = *(const u32x4*)(ksrc[i] + 2 * ktile); }
    if (NT > 1) {
#pragma unroll
        for (int i = 0; i < NV; ++i) vreg[1][i] = *(const u32x4*)(vsrc[i] + 64); }
    LDS_BAR();
    SoftState st; st.mref = 0.0f; st.l = 0.0f; st.valid = false;
    f32x16 s0, s1, u0, u1;
    if (nact > 0) { qk_tile(s0, s1, lds, qr, koff); maskf.pre(s0, s1, 0); }
#define FLASH_STEP(t, LD, ST, C0, C1, N0, N1) do { \
        if ((t) + 3 < NT) { _Pragma("unroll") for (int i = 0; i < NK; ++i) kreg[LD][i] = *(const u32x4*)(ksrc[i] + (size_t)((t) + 3) * ktile); } \
        if ((t) + 2 < NT) { _Pragma("unroll") for (int i = 0; i < NV; ++i) vreg[LD][i] = *(const u32x4*)(vsrc[i] + ((t) + 2) * 64); } \
        if ((t) < nact) { \
            bf16x8 pb[4]; unsigned w0 = 0u, w1 = 0u; \
            if (PMASK) maskf.pbits((t), w0, w1); \
            softmax_tile<2 * NV, PMASK>(C0, C1, st, o, pb, w0, w1); \
            if ((t) + 1 < nact) { qk_tile(N0, N1, lds + (((t) + 1) & 1) * KB, qr, koff); maskf.pre(N0, N1, (t) + 1); } \
            pv_tile<2 * NV>(o, pb, lds + VBASE + ((t) & 1) * VB, voff); \
        } \
        if ((t) + 2 < NT) { _Pragma("unroll") for (int i = 0; i < NK; ++i) *(LAS u32x4*)(lds + ((t) & 1) * KB + i * KT_BYTES + sdst) = kreg[ST][i]; } \
        if ((t) + 1 < NT) { _Pragma("unroll") for (int i = 0; i < NV; ++i) *(LAS u32x4*)(lds + VBASE + (((t) + 1) & 1) * VB + i * KT_BYTES + sdst) = vreg[ST][i]; } \
        LDS_BAR(); \
    } while (0)
    int t = 0;
    for (; t + 1 < NT; t += 2) { FLASH_STEP(t, 0, 1, s0, s1, u0, u1); FLASH_STEP(t + 1, 1, 0, u0, u1, s0, s1); }
    if (t < NT) FLASH_STEP(t, 0, 1, s0, s1, u0, u1);
#undef FLASH_STEP
    asm volatile("s_waitcnt vmcnt(0)" ::: "memory");
    l_out = st.l;
}
__device__ __forceinline__ void causal_mask(f32x16& p0, f32x16& p1, int kb, int q, int hi) {
#pragma unroll
    for (int r = 0; r < 16; ++r) { const int key = kb + 16 * (r >> 3) + 8 * hi + (r & 7); if (key > q) p0[r] = NEG; if (key + 32 > q) p1[r] = NEG; }
}
__device__ __forceinline__ void store_pair16(bf16_t* dst, u32x2 a, u32x2 b, int hi) {
    { auto r = __builtin_amdgcn_permlane32_swap(a.x, b.x, false, false); a.x = r[0]; b.x = r[1]; }
    { auto r = __builtin_amdgcn_permlane32_swap(a.y, b.y, false, false); a.y = r[0]; b.y = r[1]; }
    u32x4 w; w.x = a.x; w.y = a.y; w.z = b.x; w.w = b.y;
    *(u32x4*)(dst + 8 * hi) = w;
}
template <int NDB> __device__ __forceinline__ void store_o(const f32x16 (&o)[NDB], float inv, bf16_t* dst, int hi) {
#pragma unroll
    for (int db = 0; db < NDB; ++db)
#pragma unroll
        for (int g = 0; g < 4; g += 2) {
            u32x2 a, b;
            a.x = pk2(o[db][4 * g] * inv, o[db][4 * g + 1] * inv); a.y = pk2(o[db][4 * g + 2] * inv, o[db][4 * g + 3] * inv);
            b.x = pk2(o[db][4 * g + 4] * inv, o[db][4 * g + 5] * inv); b.y = pk2(o[db][4 * g + 6] * inv, o[db][4 * g + 7] * inv);
            store_pair16(dst + 32 * db + 8 * g, a, b, hi);
        }
}

__device__ __forceinline__ void moba_unit(const bf16_t* QB, const bf16_t* KB, const bf16_t* VBT, const float* kmean, bf16_t* OB, LAS unsigned char* lds, int b, int h, int j) {
    const int tid = fresh_tid(), lane = tid & 63, r32 = lane & 31, hi = lane >> 5, wid = __builtin_amdgcn_readfirstlane(tid >> 6);
    const size_t tok0 = (size_t)b * SEQ;
    const int q = 256 * j + 32 * wid + r32;
    bf16x8 qr[4];
    { const bf16_t* qp = QB + (tok0 + q) * 256 + h * 64 + hi * 8;
#pragma unroll
      for (int d0 = 0; d0 < 4; ++d0) qr[d0] = *(const bf16x8*)(qp + d0 * 16); }
    unsigned sel = 0u;
    if (j > 0) {
        if (j <= 3) sel = (1u << j) - 1u;
        else {
            float gate[7];
#pragma unroll
            for (int n = 0; n < 7; ++n) {
                gate[n] = NEG;
                if (n < j) {
                    const float* km = kmean + ((size_t)(b * 4 + h) * 8 + n) * 128 + hi * 8; float s = 0.0f;
#pragma unroll
                    for (int d0 = 0; d0 < 4; ++d0) { const f32x4 a = *(const f32x4*)(km + d0 * 16) + *(const f32x4*)(km + 64 + d0 * 16), c = *(const f32x4*)(km + d0 * 16 + 4) + *(const f32x4*)(km + 64 + d0 * 16 + 4);
#pragma unroll
                        for (int e = 0; e < 4; ++e) { s += bf2f((unsigned short)qr[d0][e]) * a[e]; s += bf2f((unsigned short)qr[d0][4 + e]) * c[e]; } }
                    s += __shfl_xor(s, 32); gate[n] = s;
                }
            }
#pragma unroll
            for (int it = 0; it < 3; ++it) { float best = 0.0f; int bi = -1;
#pragma unroll
                for (int n = 0; n < 7; ++n) { if (n < j && !((sel >> n) & 1u) && (bi < 0 || gate[n] > best)) { best = gate[n]; bi = n; } }
                sel |= 1u << bi; }
        }
    }
    const int NT = 4 * (j + 1);
    const int srow = tid >> 3, sch = tid & 7;
    const bf16_t* const ksrc[1] = {KB + (tok0 + srow) * 256 + h * 64 + sch * 8};
    const bf16_t* const vsrc[1] = {VBT + ((size_t)(b * 4 + h) * 64 + srow) * SEQ + sch * 8};
    f32x16 o[2]; float l = 0.0f;
#pragma unroll
    for (int db = 0; db < 2; ++db)
#pragma unroll
        for (int r = 0; r < 16; ++r) o[db][r] = 0.0f;
    const int qmin = 256 * j + 32 * wid;
    struct MaskMoba { unsigned sel; int j, qmin, q, hi;
        __device__ __forceinline__ void pre(f32x16& p0, f32x16& p1, int t) const { const int kb = 64 * t; if ((t >> 2) >= j && kb + 63 > qmin) causal_mask(p0, p1, kb, q, hi); }
        __device__ __forceinline__ void pbits(int t, unsigned& w0, unsigned& w1) const { const int blk = t >> 2; const unsigned m_ = (blk >= j || ((sel >> blk) & 1u)) ? 0xffffffffu : 0u; w0 = m_; w1 = m_; } };
    const MaskMoba maskf{sel, j, qmin, q, hi};
    flash_run<1, 1, 2>(lds, ksrc, (size_t)64 * 256, vsrc, NT, (qmin + 31) / 64 + 1, 0, qr, maskf, o, l, tid, r32, hi);
    l += __shfl_xor(l, 32);
    store_o<2>(o, 1.0f / l, OB + (tok0 + q) * 256 + h * 64, hi);
}

__device__ __forceinline__ void diff_unit(const bf16_t* QC, const bf16_t* KC, const bf16_t* VCT, bf16_t* OC, LAS unsigned char* lds, int b, int h, int qblk, float lam, float outscale, const float* subg) {
    const int tid = fresh_tid(), lane = tid & 63, r32 = lane & 31, hi = lane >> 5, wid = __builtin_amdgcn_readfirstlane(tid >> 6);
    const int cmp = wid & 1, sub = wid >> 1;
    const size_t tok0 = (size_t)b * SEQ;
    const int q = 128 * qblk + 32 * sub + r32;
    bf16x8 qr[4];
    { const bf16_t* qp = QC + (tok0 + q) * 512 + (2 * h + cmp) * 64 + hi * 8;
#pragma unroll
      for (int d0 = 0; d0 < 4; ++d0) qr[d0] = *(const bf16x8*)(qp + d0 * 16); }
    const int NT = 2 * (qblk + 1);
    const int srow = tid >> 3, sch = tid & 7;
    const bf16_t* const k0p = KC + (tok0 + srow) * 512 + (2 * h) * 64 + sch * 8;
    const bf16_t* const v0p = VCT + ((size_t)(b * 4 + h) * 128 + srow) * SEQ + sch * 8;
    const bf16_t* const ksrc[2] = {k0p, k0p + 64};
    const bf16_t* const vsrc[2] = {v0p, v0p + (size_t)64 * SEQ};
    f32x16 o[4]; float l = 0.0f;
#pragma unroll
    for (int db = 0; db < 4; ++db)
#pragma unroll
        for (int r = 0; r < 16; ++r) o[db][r] = 0.0f;
    const int qmin = 128 * qblk + 32 * sub;
    struct MaskCausal { int qmin, q, hi;
        __device__ __forceinline__ void pre(f32x16& p0, f32x16& p1, int t) const { const int kb = 64 * t; if (kb + 63 > qmin) causal_mask(p0, p1, kb, q, hi); }
        __device__ __forceinline__ void pbits(int, unsigned&, unsigned&) const {} };
    const MaskCausal maskf{qmin, q, hi};
    for (int repd = 0; repd < 1 + (DIFF_REP & 1); ++repd) {
        if (repd) {
#pragma unroll
            for (int db = 0; db < 4; ++db)
#pragma unroll
                for (int r = 0; r < 16; ++r) o[db][r] = 0.0f; }
        flash_run<2, 2, 0>(lds, ksrc, (size_t)64 * 512, vsrc, NT, (qmin + 31) / 64 + 1, cmp, qr, maskf, o, l, tid, r32, hi);
    }
    l += __shfl_xor(l, 32);
    const float inv = 1.0f / l;
    LAS float* xch = (LAS float*)lds + (size_t)sub * 64 * 64 + lane;
    if (cmp == 1) {
#pragma unroll
        for (int db = 0; db < 4; ++db)
#pragma unroll
            for (int r = 0; r < 16; ++r) xch[(db * 16 + r) * 64] = o[db][r] * inv;
    }
    __syncthreads();
    if (cmp == 0) {
        float ss = 0.0f;
#pragma unroll
        for (int db = 0; db < 4; ++db)
#pragma unroll
            for (int r = 0; r < 16; ++r) { const float v = o[db][r] * inv - lam * xch[(db * 16 + r) * 64]; o[db][r] = v; ss += v * v; }
        ss += __shfl_xor(ss, 32);
        const float rstd = rsqrtf(ss * (1.0f / 128.0f) + EPS) * outscale;
        bf16_t* dst = OC + (size_t)(h >> 1) * T * 256 + (tok0 + q) * 256 + (h & 1) * 128;
#pragma unroll
        for (int db = 0; db < 4; ++db)
#pragma unroll
            for (int g = 0; g < 4; g += 2) { const int d = 32 * db + 8 * g + 4 * hi; const f32x4 sg = *(const f32x4*)(subg + d), sh = *(const f32x4*)(subg + d + 8);
                u32x2 a, b; a.x = pk2(o[db][4 * g] * rstd * sg[0], o[db][4 * g + 1] * rstd * sg[1]); a.y = pk2(o[db][4 * g + 2] * rstd * sg[2], o[db][4 * g + 3] * rstd * sg[3]);
                b.x = pk2(o[db][4 * g + 4] * rstd * sh[0], o[db][4 * g + 5] * rstd * sh[1]); b.y = pk2(o[db][4 * g + 6] * rstd * sh[2], o[db][4 * g + 7] * rstd * sh[3]);
                store_pair16(dst + 32 * db + 8 * g, a, b, hi); }
    }
    __syncthreads();
}

__device__ __forceinline__ unsigned f2key(float v) { unsigned b = __float_as_uint(v); if ((b << 1) == 0u) b = 0u; return (b & 0x80000000u) ? ~b : (b | 0x80000000u); }
__device__ __forceinline__ float key2f(unsigned k) { return (k & 0x80000000u) ? __uint_as_float(k & 0x7fffffffu) : __uint_as_float(~k); }
#define ROR_(v, n) ((unsigned)__builtin_amdgcn_update_dpp(0, (int)(v), 0x120 + (n), 0xf, 0xf, false))
__device__ __forceinline__ unsigned wave_max_u32(unsigned v) {
    v = max(v, ROR_(v, 1)); v = max(v, ROR_(v, 2)); v = max(v, ROR_(v, 4)); v = max(v, ROR_(v, 8));
    { auto r = __builtin_amdgcn_permlane16_swap(v, v, false, false); v = max((unsigned)r[0], (unsigned)r[1]); }
    { auto r = __builtin_amdgcn_permlane32_swap(v, v, false, false); v = max((unsigned)r[0], (unsigned)r[1]); }
    return v;
}
__device__ __forceinline__ unsigned wave_min_u32(unsigned v) { return ~wave_max_u32(~v); }
__device__ __forceinline__ unsigned wave_add_u32(unsigned v) {
    v += ROR_(v, 1); v += ROR_(v, 2); v += ROR_(v, 4); v += ROR_(v, 8);
    { auto r = __builtin_amdgcn_permlane16_swap(v, v, false, false); v = (unsigned)r[0] + (unsigned)r[1]; }
    { auto r = __builtin_amdgcn_permlane32_swap(v, v, false, false); v = (unsigned)r[0] + (unsigned)r[1]; }
    return v;
}
__device__ __forceinline__ int count_ge(const unsigned (&u)[32], unsigned thr, int ng) {
    int c = 0;
#pragma unroll
    for (int g = 0; g < 4; ++g) if (g < ng) {
        unsigned long long m0, m1, m2, m3, m4, m5, m6, m7;
        asm("v_cmp_ge_u32_e64 %0, %8, %16\n\tv_cmp_ge_u32_e64 %1, %9, %16\n\tv_cmp_ge_u32_e64 %2, %10, %16\n\tv_cmp_ge_u32_e64 %3, %11, %16\n\t"
            "v_cmp_ge_u32_e64 %4, %12, %16\n\tv_cmp_ge_u32_e64 %5, %13, %16\n\tv_cmp_ge_u32_e64 %6, %14, %16\n\tv_cmp_ge_u32_e64 %7, %15, %16"
            : "=&s"(m0), "=&s"(m1), "=&s"(m2), "=&s"(m3), "=&s"(m4), "=&s"(m5), "=&s"(m6), "=&s"(m7)
            : "v"(u[8 * g]), "v"(u[8 * g + 1]), "v"(u[8 * g + 2]), "v"(u[8 * g + 3]), "v"(u[8 * g + 4]), "v"(u[8 * g + 5]), "v"(u[8 * g + 6]), "v"(u[8 * g + 7]), "v"(thr));
        c += (__popcll(m0) + __popcll(m1)) + (__popcll(m2) + __popcll(m3)) + (__popcll(m4) + __popcll(m5)) + (__popcll(m6) + __popcll(m7));
    }
    return c;
}
__device__ __forceinline__ unsigned pick_mid(unsigned lo, unsigned hi, int clo, int chi, int it) {
    const unsigned span = hi - lo;
    const float flo = key2f(lo << 16), fhi = key2f(((hi - 1u) << 16) | 0xffffu);
    const float fr = (it & 1) ? 0.5f : ((float)(clo - 256) - 0.5f) * fast_rcp((float)(clo - chi));
    unsigned mid = f2key(flo + fr * (fhi - flo)) >> 16;
    if ((it & 1) && it >= 8) mid = lo + (span >> 1);
    if (mid <= lo || mid >= hi) mid = lo + (span >> 1);
    return mid;
}
#define WRITELANE2(lo_, hi_, bal_, i_) asm("s_nop 1\n\tv_writelane_b32 %0, %2, %4\n\tv_writelane_b32 %1, %3, %4" : "+v"(lo_), "+v"(hi_) : "s"((unsigned)(bal_)), "s"((unsigned)((bal_) >> 32)), "n"(i_))
__device__ __forceinline__ void write_mask_row(const unsigned (&u)[32], unsigned thr, int clo, int ng, LAS unsigned* bm, int lane) {
    int wlo = 0, whi = 0;
    if (clo == 256) {
#pragma unroll
        for (int i = 0; i < 32; ++i) { const unsigned long long bal = __ballot(u[i] >= thr); WRITELANE2(wlo, whi, bal, i); }
    } else {
        const int need = 256 - count_ge(u, thr + 1u, ng);
        int run = 0; const unsigned long long below = (1ull << lane) - 1ull;
#pragma unroll
        for (int i = 0; i < 32; ++i) {
            const unsigned long long eq = __ballot(u[i] == thr); const int rank = run + __popcll(eq & below);
            const unsigned long long bal = __ballot(u[i] > thr || (u[i] == thr && rank < need)); run += __popcll(eq);
            WRITELANE2(wlo, whi, bal, i);
        }
    }
    if (lane < 32) { u32x2 w; w.x = (unsigned)wlo; w.y = (unsigned)whi; *(LAS u32x2*)(bm + 2 * lane) = w; }
}
__device__ __forceinline__ void compact_row(const unsigned (&u)[32], unsigned lo, unsigned hi, int ng, LAS unsigned* scr, int lane, unsigned& c0, unsigned& c1) {
    int base = 0;
#pragma unroll
    for (int g = 0; g < 4; ++g) if (g < ng) {
#pragma unroll
        for (int i = 8 * g; i < 8 * g + 8; ++i) {
            const bool inb = u[i] >= lo && u[i] < hi;
            const unsigned long long bal = __ballot(inb);
            const int pos = base + (int)__builtin_amdgcn_mbcnt_hi((unsigned)(bal >> 32), __builtin_amdgcn_mbcnt_lo((unsigned)bal, 0u));
            if (inb) scr[pos] = u[i];
            base += __popcll(bal);
        }
    }
    asm volatile("s_waitcnt lgkmcnt(0)" ::: "memory");
    c0 = lane < base ? scr[lane] : 0u; c1 = 64 + lane < base ? scr[64 + lane] : 0u;
}
__device__ __forceinline__ void select_rows2(const unsigned (&va)[32], const unsigned (&vb)[32], int ta, int tb, LAS unsigned* bma, LAS unsigned* bmb, LAS unsigned* scr, int lane) {
    const int na = ta + 1, nb = tb + 1;
    if (nb <= 256) {
        const int ca = na - 32 * lane, cb = nb - 32 * lane;
        bma[lane] = ca >= 32 ? 0xffffffffu : (ca <= 0 ? 0u : ((1u << ca) - 1u)); bmb[lane] = cb >= 32 ? 0xffffffffu : (cb <= 0 ? 0u : ((1u << cb) - 1u)); return; }
    const int ng = (nb + 511) >> 9;
    unsigned ua[32], ub[32];
    unsigned mxa = 0u, mna = 0xffffffffu, mxb = 0u, mnb = 0xffffffffu;
#pragma unroll
    for (int i = 0; i < 32; ++i) { const bool oka = 64 * i + lane <= ta, okb = 64 * i + lane <= tb; ua[i] = oka ? va[i] : 0u; ub[i] = okb ? vb[i] : 0u;
        mxa = max(mxa, ua[i]); mna = min(mna, oka ? va[i] : 0xffffffffu); mxb = max(mxb, ub[i]); mnb = min(mnb, okb ? vb[i] : 0xffffffffu); }
    mxa = (unsigned)__builtin_amdgcn_readfirstlane((int)wave_max_u32(mxa)); mna = (unsigned)__builtin_amdgcn_readfirstlane((int)wave_min_u32(mna));
    mxb = (unsigned)__builtin_amdgcn_readfirstlane((int)wave_max_u32(mxb)); mnb = (unsigned)__builtin_amdgcn_readfirstlane((int)wave_min_u32(mnb));
    unsigned loa = mna, hia = mxa + 1u, lob = mnb, hib = mxb + 1u;
    int cloa = na, chia = 0, clob = nb, chib = 0;
    bool acta = na > 256, actb = true;
    int it = 0;
    for (; it < 96 && ((acta && cloa - chia > 128) || (actb && clob - chib > 128)); ++it) {
        const unsigned mida = acta ? pick_mid(loa, hia, cloa, chia, it) : loa, midb = actb ? pick_mid(lob, hib, clob, chib, it) : lob;
        int ca = 0, cb = 0;
#pragma unroll
        for (int g = 0; g < 4; ++g) if (g < ng) {
            unsigned long long m0, m1, m2, m3, m4, m5, m6, m7, q0, q1, q2, q3, q4, q5, q6, q7;
            asm("v_cmp_ge_u32_e64 %0, %8, %16\n\tv_cmp_ge_u32_e64 %1, %9, %16\n\tv_cmp_ge_u32_e64 %2, %10, %16\n\tv_cmp_ge_u32_e64 %3, %11, %16\n\t"
                "v_cmp_ge_u32_e64 %4, %12, %16\n\tv_cmp_ge_u32_e64 %5, %13, %16\n\tv_cmp_ge_u32_e64 %6, %14, %16\n\tv_cmp_ge_u32_e64 %7, %15, %16"
                : "=&s"(m0), "=&s"(m1), "=&s"(m2), "=&s"(m3), "=&s"(m4), "=&s"(m5), "=&s"(m6), "=&s"(m7)
                : "v"(ua[8 * g]), "v"(ua[8 * g + 1]), "v"(ua[8 * g + 2]), "v"(ua[8 * g + 3]), "v"(ua[8 * g + 4]), "v"(ua[8 * g + 5]), "v"(ua[8 * g + 6]), "v"(ua[8 * g + 7]), "v"(mida));
            asm("v_cmp_ge_u32_e64 %0, %8, %16\n\tv_cmp_ge_u32_e64 %1, %9, %16\n\tv_cmp_ge_u32_e64 %2, %10, %16\n\tv_cmp_ge_u32_e64 %3, %11, %16\n\t"
                "v_cmp_ge_u32_e64 %4, %12, %16\n\tv_cmp_ge_u32_e64 %5, %13, %16\n\tv_cmp_ge_u32_e64 %6, %14, %16\n\tv_cmp_ge_u32_e64 %7, %15, %16"
                : "=&s"(q0), "=&s"(q1), "=&s"(q2), "=&s"(q3), "=&s"(q4), "=&s"(q5), "=&s"(q6), "=&s"(q7)
                : "v"(ub[8 * g]), "v"(ub[8 * g + 1]), "v"(ub[8 * g + 2]), "v"(ub[8 * g + 3]), "v"(ub[8 * g + 4]), "v"(ub[8 * g + 5]), "v"(ub[8 * g + 6]), "v"(ub[8 * g + 7]), "v"(midb));
            ca += (__popcll(m0) + __popcll(m1)) + (__popcll(m2) + __popcll(m3)) + (__popcll(m4) + __popcll(m5)) + (__popcll(m6) + __popcll(m7));
            cb += (__popcll(q0) + __popcll(q1)) + (__popcll(q2) + __popcll(q3)) + (__popcll(q4) + __popcll(q5)) + (__popcll(q6) + __popcll(q7));
        }
        if (acta) { if (ca >= 256) { loa = mida; cloa = ca; } else { hia = mida; chia = ca; } acta = ca != 256 && hia - loa > 1u; }
        if (actb) { if (cb >= 256) { lob = midb; clob = cb; } else { hib = midb; chib = cb; } actb = cb != 256 && hib - lob > 1u; }
    }
    if (acta || actb) {
        unsigned a0 = 0u, a1 = 0u, b0 = 0u, b1 = 0u;
        const int basea = chia, baseb = chib;
        if (acta) compact_row(ua, loa, hia, ng, scr, lane, a0, a1);
        if (actb) compact_row(ub, lob, hib, ng, scr + 128, lane, b0, b1);
        for (; it < 200 && (acta || actb); ++it) {
            const unsigned mida = acta ? pick_mid(loa, hia, cloa, chia, it) : loa, midb = actb ? pick_mid(lob, hib, clob, chib, it) : lob;
            const int ca = basea + __popcll(__ballot(a0 >= mida)) + __popcll(__ballot(a1 >= mida));
            const int cb = baseb + __popcll(__ballot(b0 >= midb)) + __popcll(__ballot(b1 >= midb));
            if (acta) { if (ca >= 256) { loa = mida; cloa = ca; } else { hia = mida; chia = ca; } acta = ca != 256 && hia - loa > 1u; }
            if (actb) { if (cb >= 256) { lob = midb; clob = cb; } else { hib = midb; chib = cb; } actb = cb != 256 && hib - lob > 1u; }
        }
    }
    if (na <= 256) { const int c = na - 32 * lane; bma[lane] = c >= 32 ? 0xffffffffu : (c <= 0 ? 0u : ((1u << c) - 1u)); }
    else write_mask_row(ua, loa, cloa, ng, bma, lane);
    write_mask_row(ub, lob, clob, ng, bmb, lane);
}

__device__ __forceinline__ void dsa_unit(const bf16_t* QA, const bf16_t* KA, const bf16_t* VAT, const bf16_t* QI, const bf16_t* KI, const float* WI, float* strip, bf16_t* OA,
                                         LAS unsigned char* lds, int b, int qblk) {
    const int tid = fresh_tid(), lane = tid & 63, r32 = lane & 31, hi = lane >> 5, wid = __builtin_amdgcn_readfirstlane(tid >> 6);
    const size_t tok0 = (size_t)b * SEQ;
    constexpr int BM_OFF = 4 * KT_BYTES;
    constexpr int QI_OFF = BM_OFF + 64 * 256, QI_PITCH = 1040, WI_OFF = QI_OFF + 32 * QI_PITCH, SCR_OFF = WI_OFF + 1024;
    LAS unsigned* bm = (LAS unsigned*)(lds + BM_OFF);
    for (int s = 0; s < 2; ++s) {
        const int qt = 2 * qblk + s;
        {
            { const int row = tid >> 4, ch = tid & 15;
              const u32x4* src = (const u32x4*)(QI + (tok0 + 32 * qt + row) * 512 + ch * 32);
              LAS u32x4* dq = (LAS u32x4*)(lds + QI_OFF + row * QI_PITCH + ch * 64);
              const u32x4 a0 = src[0], a1 = src[1], a2 = src[2], a3 = src[3]; dq[0] = a0; dq[1] = a1; dq[2] = a2; dq[3] = a3; }
            if (tid < 256) { const int row = tid >> 3, hh = tid & 7; ((LAS float*)(lds + WI_OFF))[row * 8 + hh] = WI[(tok0 + 32 * qt + row) * 8 + hh]; }
            __syncthreads();
            const LAS unsigned char* qb = lds + QI_OFF + r32 * QI_PITCH + hi * 16;
            const LAS float* wl = (const LAS float*)(lds + WI_OFF) + r32 * 8;
            for (int rep1 = 0; rep1 < 1 + (DSA_REP & 1); ++rep1) {
            bf16x8 kfn[4];
            if (wid <= qt) {
#pragma unroll
                for (int d0 = 0; d0 < 4; ++d0) kfn[d0] = *(const bf16x8*)(KI + (tok0 + 32 * wid + r32) * 64 + d0 * 16 + hi * 8); }
            for (int kt = wid; kt <= qt; kt += NWAVES) {
                bf16x8 kf[4];
#pragma unroll
                for (int d0 = 0; d0 < 4; ++d0) kf[d0] = kfn[d0];
                if (kt + NWAVES <= qt) {
#pragma unroll
                    for (int d0 = 0; d0 < 4; ++d0) kfn[d0] = *(const bf16x8*)(KI + (tok0 + 32 * (kt + NWAVES) + r32) * 64 + d0 * 16 + hi * 8); }
                f32x16 isc;
#pragma unroll
                for (int r = 0; r < 16; ++r) isc[r] = 0.0f;
#pragma unroll 1
                for (int hh = 0; hh < 8; ++hh) {
                    f32x16 lg;
#pragma unroll
                    for (int r = 0; r < 16; ++r) lg[r] = 0.0f;
#pragma unroll
                    for (int d0 = 0; d0 < 4; ++d0) { const bf16x8 qf = *(const LAS bf16x8*)(qb + hh * 128 + d0 * 32); lg = mfma32(kf[d0], qf, lg); }
                    const float w = wl[hh];
#pragma unroll
                    for (int r = 0; r < 16; ++r) isc[r] += __int_as_float(max(__float_as_int(lg[r]), 0)) * w;
                }
                unsigned short* sp = (unsigned short*)strip + (size_t)r32 * SEQ + 32 * kt + 4 * hi;
#pragma unroll
                for (int g = 0; g < 4; ++g) { u32x2 w;
                    w.x = (f2key(isc[4 * g]) >> 16) | (f2key(isc[4 * g + 1]) & 0xffff0000u); w.y = (f2key(isc[4 * g + 2]) >> 16) | (f2key(isc[4 * g + 3]) & 0xffff0000u);
                    *(u32x2*)(sp + 8 * g) = w; }
            }
            }
        }
        asm volatile("s_waitcnt vmcnt(0)" ::: "memory");
        __syncthreads();
        for (int rep2 = 0; rep2 < 1 + ((DSA_REP >> 1) & 1); ++rep2) {
#pragma unroll 1
            for (int rp = 0; rp < 2; ++rp) {
                unsigned v2[2][32];
#pragma unroll
                for (int rr = 0; rr < 2; ++rr)
#pragma unroll
                    for (int i = 0; i < 32; ++i) v2[rr][i] = ((const unsigned short*)strip)[(size_t)(wid + 8 * (2 * rp + rr)) * SEQ + 64 * i + lane];
                { const int ra = wid + 16 * rp, rb = ra + 8; select_rows2(v2[0], v2[1], 32 * qt + ra, 32 * qt + rb, bm + (32 * s + ra) * 64, bm + (32 * s + rb) * 64, (LAS unsigned*)(lds + SCR_OFF) + wid * 256, lane); }
            }
        }
        __syncthreads();
    }
    const int head = wid & 3, sub = wid >> 2;
    const int q = 64 * qblk + 32 * sub + r32;
    bf16x8 qr[4];
    { const bf16_t* qp = QA + (tok0 + q) * 256 + head * 64 + hi * 8;
#pragma unroll
      for (int d0 = 0; d0 < 4; ++d0) qr[d0] = *(const bf16x8*)(qp + d0 * 16); }
    const int NT = qblk + 1;
    const int srow = tid >> 3, sch = tid & 7;
    const bf16_t* const ksrc[1] = {KA + (tok0 + srow) * 64 + sch * 8};
    const bf16_t* const vsrc[1] = {VAT + ((size_t)b * 64 + srow) * SEQ + sch * 8};
    for (int rep3 = 0; rep3 < 1 + ((DSA_REP >> 2) & 1); ++rep3) {
    f32x16 o[2]; float l = 0.0f;
#pragma unroll
    for (int db = 0; db < 2; ++db)
#pragma unroll
        for (int r = 0; r < 16; ++r) o[db][r] = 0.0f;
    const LAS unsigned* bmq = bm + (32 * sub + r32) * 64;
    struct MaskBits { const LAS unsigned* bmq; int hi;
        __device__ __forceinline__ void pre(f32x16&, f32x16&, int) const {}
        __device__ __forceinline__ void pbits(int t, unsigned& w0, unsigned& w1) const { w0 = bmq[2 * t] >> (8 * hi); w1 = bmq[2 * t + 1] >> (8 * hi); } };
    const MaskBits maskf{bmq, hi};
    flash_run<1, 1, 1>(lds, ksrc, (size_t)64 * 64, vsrc, NT, NT, 0, qr, maskf, o, l, tid, r32, hi);
    l += __shfl_xor(l, 32);
    store_o<2>(o, 1.0f / l, OA + (tok0 + q) * 256 + head * 64, hi);
    }
}
}

__device__ __forceinline__ void phase_attention(const Ctx& c, LAS unsigned char* lds, int layer) {
    unsigned char* A = c.ws + WS_A;
    const bf16_t *QA = (const bf16_t*)(A + A_QA), *KA = (const bf16_t*)(A + A_KA), *VAT = (const bf16_t*)(A + A_VAT), *QI = (const bf16_t*)(A + A_QI), *KI = (const bf16_t*)(A + A_KI);
    const float* WI = (const float*)(A + A_WI);
    const bf16_t *QB = (const bf16_t*)(A + A_QB), *KB = (const bf16_t*)(A + A_KB), *VBT = (const bf16_t*)(A + A_VBT), *QC = (const bf16_t*)(A + A_QC), *KC = (const bf16_t*)(A + A_KC), *VCT = (const bf16_t*)(A + A_VCT);
    bf16_t *OA = (bf16_t*)((unsigned char*)c.out + DO_O), *OB = OA + (size_t)T * 256, *OC = OB + (size_t)T * 256;
    const float* kmean = (const float*)(c.ws + WS_CTL + CTL_KMEAN) + (size_t)layer * (16 * 4 * 8 * 2 * 64);
    float* strip = (float*)(c.ws + WS_G) + (size_t)blockIdx.x * 32 * SEQ;
    const int GW = gridDim.x, vcu = (GW % 8 == 0) ? ((int)blockIdx.x % 8) * (GW / 8) + (int)blockIdx.x / 8 : (int)blockIdx.x;

    if (ATT_MASK & 1) for (int rep = 0; rep < 1 + (ATT_REP & 1); ++rep) for (int w = vcu; w < 256; w += GW) {
        const int b = w >> 4, p = w & 15;
        for (int k = 0; k < 2; ++k) att::dsa_unit(QA, KA, VAT, QI, KI, WI, strip, OA, lds, b, k ? 31 - p : p);
    }
    if (ATT_MASK & 2) for (int rep = 0; rep < 1 + ((ATT_REP >> 1) & 1); ++rep) for (int w = vcu; w < 256; w += GW) {
        const int b = w >> 4, h = (w >> 2) & 3, jp = w & 3;
        for (int k = 0; k < 2; ++k) att::moba_unit(QB, KB, VBT, kmean, OB, lds, b, h, k ? 7 - jp : jp);
    }
    if (ATT_MASK & 4) {
        const float* lp = c.lam_p + (size_t)layer * 4 * 64; const int lane = fresh_tid() & 63;
        const float s1 = wave_sum(lp[lane] * lp[64 + lane]), s2 = wave_sum(lp[128 + lane] * lp[192 + lane]);
        const float lam_init = 0.8f - 0.6f * expf(-0.3f * (float)layer);
        const float lam = expf(s1) - expf(s2) + lam_init;
        const float* subg = c.subln_g + (size_t)layer * 128;
        for (int rep = 0; rep < 1 + ((ATT_REP >> 2) & 1); ++rep) for (int w = vcu; w < 512; w += GW) {
            const int b = w >> 5, h = (w >> 3) & 3, qp = w & 7;
            for (int k = 0; k < 2; ++k) att::diff_unit(QC, KC, VCT, OC, lds, b, h, k ? 15 - qp : qp, lam, 1.0f - lam_init, subg);
        }
    }
}

constexpr int RING_BYTES = 131072, MISC_OFF = RING_BYTES, GAIN_LDS_OFF = MISC_OFF + 1024, LDS_BYTES = 147456;
struct Args { const void* in[12]; float* out; unsigned char* ws; int ph_lo, ph_hi; };
static_assert(sizeof(Args) == 12 * 8 + 8 + 8 + 8, "Args has no padding");

__global__ void __launch_bounds__(NTHREADS, 2) hybrid_fwd(Args args) {
    extern __shared__ __attribute__((aligned(16))) unsigned char lds_raw[];
    LAS unsigned char* lds = (LAS unsigned char*)lds_raw;
    volatile LAS unsigned* MISC = (volatile LAS unsigned*)(lds + MISC_OFF);
    const int tid = threadIdx.x;
    if (tid < 64) MISC[tid] = 0u;
    __syncthreads();
    Ctx c;
    c.x_in = (const float*)args.in[0]; c.pos = (const int*)args.in[1]; c.norm_g = (const float*)args.in[2]; c.w_in = (const float*)args.in[3]; c.qk_g = (const float*)args.in[4];
    c.lam_p = (const float*)args.in[5]; c.subln_g = (const float*)args.in[6]; c.w_branch = (const float*)args.in[7]; c.w_out = (const float*)args.in[8];
    c.w_gate = (const float*)args.in[9]; c.w_up = (const float*)args.in[10]; c.w_down = (const float*)args.in[11];
    c.out = args.out; c.ws = args.ws;
    const int lo = args.ph_lo, hi = args.ph_hi;
    unsigned* ctl = (unsigned*)(c.ws + WS_CTL);
    XcdBarrier bar; bar.bar = ctl + CW_BAR; bar.x = 0u; bar.st = MISC + 8;
    if (hi - lo > 1) bar = xcd_barrier_post(ctl + CW_BAR, MISC + 8);
#ifndef PH_MASK
#define PH_MASK 0xffu
#endif
#define PHE(id) ((PH_MASK >> (id)) & 1u)
#ifndef REP_MASK
#define REP_MASK 0u
#endif
#define REPN(id) (1 + (int)((REP_MASK >> (id)) & 1u))
#define IN(k) (lo <= (k) && (k) < hi)
#define SEAM(k) do { if (lo <= (k) && (k) + 1 < hi) xcd_barrier(bar); } while (0)
    const int G = gridDim.x, cb = blockIdx.x;
#define LYR() ({ int l_ = layer; asm volatile("" : "+s"(l_)); l_; })
#define WSL() ({ __attribute__((address_space(1))) unsigned char* p_ = (__attribute__((address_space(1))) unsigned char*)c.ws; asm volatile("" : "+s"(p_)); (unsigned char*)p_; })
#define OUTL() ({ __attribute__((address_space(1))) unsigned char* p_ = (__attribute__((address_space(1))) unsigned char*)c.out; asm volatile("" : "+s"(p_)); (unsigned char*)p_; })
#define H8 ((signed char*)(WSL() + WS_H8))
#define SA ((float*)(WSL() + WS_CTL + CTL_SA))
#define XB ((bf16_t*)(WSL() + WS_XB))
#define ACT ((bf16_t*)(WSL() + WS_A))
#define MRG ((bf16_t*)(WSL() + WS_A))
#define GB (WSL() + WS_G)
#define OA ((bf16_t*)(OUTL() + DO_O))
#define H ((bf16_t*)(OUTL() + DO_H))

    if (IN(0) && PHE(0)) for (int rep = 0; rep < REPN(0); ++rep) { phase_prologue(c, lds); prologue_i8<0>(c, lds); }
    SEAM(0);
    for (int layer = 0; layer < 2; ++layer) {
        const int base = 1 + 11 * layer;
        bf16_t* WL = wlayer(c, layer);
        if (IN(base + 0) && PHE(1)) for (int rep = 0; rep < REPN(1); ++rep) { if (LYR() == 0) { prologue_i8<1>(c, lds); phase_norm<false, false, true>(c.x_in, H, H8, SA); } else phase_norm<true, false, true>(XB, H, H8, SA); }
        SEAM(base + 0);
        if (IN(base + 1) && PHE(2)) for (int rep = 0; rep < REPN(2); ++rep) { pg8::Gemm g{(const bf16_t*)H8, WL + WL_GU, T, 5632, D / 2}; pg8::StaticOrder S; S.init(T, 5632, G, cb);
            EpiSwigluI8 E{ACT, SA, (const float*)(c.ws + WS_CTL + CTL_CMAX) + (size_t)layer * CMAX_PER_LAYER};
            pg8::gemm_phase<EpiSwigluI8, pg8::StaticOrder, true, true, true>(lds, g, S, E); }
        SEAM(base + 1);
        if (IN(base + 2) && PHE(3)) { pg8::Gemm g{ACT, WL + WL_DN, T, D, DFF}; RevOrder S; S.init(T, D, G, cb);
            if (LYR() == 0) { EpiResid<false, true> E{c.x_in, XB, 0.5f}; pg8::gemm_phase<EpiResid<false, true>, RevOrder, true, true>(lds, g, S, E); }
            else { EpiResid<true, true> E{XB, XB, 0.5f}; pg8::gemm_phase<EpiResid<true, true>, RevOrder, true, true>(lds, g, S, E); } }
        SEAM(base + 2);
        if (IN(base + 3) && PHE(1)) for (int rep = 0; rep < REPN(1); ++rep) phase_norm<true, false, true>(XB, H, H8, SA);
        SEAM(base + 3);
        if (IN(base + 4) && PHE(4)) for (int rep = 0; rep < REPN(4); ++rep) { pg8::Gemm g{(const bf16_t*)H8, WL + WL_IN, T, NINP, D / 2}; pg8::StaticOrder S; S.init(T, NINP, G, cb);
            { const int t_ = fresh_tid(); if (t_ < 384) ((LAS float*)(lds + GAIN_LDS_OFF))[t_] = c.qk_g[(size_t)layer * 6 * 64 + t_];
              const float* cm_ = (const float*)(WSL() + WS_CTL + CTL_CMAX) + (size_t)layer * CMAX_PER_LAYER + 2 * 5632 + 3072;
              for (int i_ = t_; i_ < NINP; i_ += NTHREADS) ((LAS float*)(lds + GAIN_LDS_OFF + 1536))[i_] = cm_[i_] * (1.0f / 127.0f);
              __syncthreads(); }
            EpiInProjT<true> E{c.ws, lds + GAIN_LDS_OFF, layer};
            pg8::gemm_phase<EpiInProjT<true>, pg8::StaticOrder, true, true, true>(lds, g, S, E); }
        SEAM(base + 4);
        if (IN(base + 5) && PHE(5)) phase_attention(c, lds, layer);
        SEAM(base + 5);
        if (IN(base + 6) && PHE(6)) for (int rep = 0; rep < REPN(6); ++rep) {
            for (int rg = 0; rg < REPN(8); ++rg) { pg8::Gemm g{(const bf16_t*)H8, WL + WL_GT, T, 3 * D, D / 2}; GateOrder S; S.base.init(T, D, G, cb);
              EpiGateI8 E{GB, SA, (const float*)(c.ws + WS_CTL + CTL_CMAX) + (size_t)layer * CMAX_PER_LAYER + 2 * 5632};
              pg8::gemm_phase<EpiGateI8, GateOrder, true, true, true>(lds, g, S, E); }
            for (int rs = 0; rs < REPN(9); ++rs) { pg8::Gemm g{OA, WL + WL_BR, T, D, 256, (size_t)T * 256 * 2, (size_t)1024 * 256 * 2}; SegOrder S; S.base.init(T, D, G, cb); EpiMergeSeg E{GB, MRG};
              pg8::gemm_phase<EpiMergeSeg, SegOrder, true, true>(lds, g, S, E); }
        }
        SEAM(base + 6);
        if (IN(base + 7) && PHE(7)) { pg8::Gemm g{MRG, WL + WL_OUT, T, D, D}; pg8::StaticOrder S; S.init(T, D, G, cb); EpiResid<true, true> E{XB, XB, 1.0f};
            pg8::gemm_phase<EpiResid<true, true>, pg8::StaticOrder, true, true>(lds, g, S, E); }
        SEAM(base + 7);
        if (IN(base + 8) && PHE(1)) for (int rep = 0; rep < REPN(1); ++rep) phase_norm<true, false, true>(XB, H, H8, SA);
        SEAM(base + 8);
        if (IN(base + 9) && PHE(2)) for (int rep = 0; rep < REPN(2); ++rep) { pg8::Gemm g{(const bf16_t*)H8, WL + WL_GU + (size_t)5632 * 1024, T, 5632, D / 2}; pg8::StaticOrder S; S.init(T, 5632, G, cb);
            EpiSwigluI8 E{ACT, SA, (const float*)(c.ws + WS_CTL + CTL_CMAX) + (size_t)layer * CMAX_PER_LAYER + 5632};
            pg8::gemm_phase<EpiSwigluI8, pg8::StaticOrder, true, true, true>(lds, g, S, E); }
        SEAM(base + 9);
        if (IN(base + 10) && PHE(3)) { pg8::Gemm g{ACT, WL + WL_DN + (size_t)1024 * 2816, T, D, DFF}; RevOrder S; S.init(T, D, G, cb);
            if (LYR() == 1) { EpiResid<true, false> E{XB, c.out, 0.5f}; pg8::gemm_phase<EpiResid<true, false>, RevOrder, true, true>(lds, g, S, E); }
            else { EpiResid<true, true> E{XB, XB, 0.5f}; pg8::gemm_phase<EpiResid<true, true>, RevOrder, true, true>(lds, g, S, E); } }
        SEAM(base + 10);
    }
#undef IN
#undef SEAM
#undef WSL
#undef LYR
#undef OUTL
#undef H8
#undef SA
#undef XB
#undef ACT
#undef MRG
#undef GB
#undef OA
#undef H
}
#define MK_AFTER_PHASE(p) do {} while (0)

extern "C" void kernel_launch(void* const* d_in, const int* in_sizes, int n_in, void* d_out, int out_size, void* d_ws, size_t ws_size, hipStream_t stream) {
    static int grid = 0;
    if (grid == 0) {
        if (n_in != 12 || in_sizes[0] != T * D || out_size != T * D || ws_size < WS_END) {
            fprintf(stderr, "kernel_launch: unexpected shapes (n_in %d, in0 %d, out %d, ws %zu < %zu); nothing launched\n", n_in, n_in > 0 ? in_sizes[0] : -1, out_size, ws_size, (size_t)WS_END); grid = -1; return; }
        int dev = 0, cus = 0, per_cu = 0;
        if (hipGetDevice(&dev) != hipSuccess || hipDeviceGetAttribute(&cus, hipDeviceAttributeMultiprocessorCount, dev) != hipSuccess) { grid = -1; return; }
        if (hipFuncSetAttribute((const void*)hybrid_fwd, hipFuncAttributeMaxDynamicSharedMemorySize, LDS_BYTES) != hipSuccess) { fprintf(stderr, "kernel_launch: hipFuncSetAttribute failed\n"); grid = -1; return; }
        if (hipOccupancyMaxActiveBlocksPerMultiprocessor(&per_cu, (const void*)hybrid_fwd, NTHREADS, LDS_BYTES) != hipSuccess || per_cu < 1)
            fprintf(stderr, "kernel_launch: occupancy query reports %d workgroups per CU\n", per_cu);
        (void)hipGetLastError();
        grid = cus > 0 ? cus : 256;
        if (grid > 256) grid = 256;
    }
    if (grid < 0) return;
    (void)hipMemsetAsync((char*)d_ws + WS_CTL, 0, CTL_BYTES, stream);
    Args a{};
    for (int i = 0; i < 12; ++i) a.in[i] = d_in[i];
    a.out = (float*)d_out; a.ws = (unsigned char*)d_ws;
#if MK_N_LAUNCHES == 1
    a.ph_lo = 0; a.ph_hi = NPHASE;
    hipLaunchKernelGGL(hybrid_fwd, dim3(grid), dim3(NTHREADS), LDS_BYTES, stream, a);
#else
    for (int p = 0; p < NPHASE; ++p) {
        a.ph_lo = p; a.ph_hi = p + 1;
        hipLaunchKernelGGL(hybrid_fwd, dim3(grid), dim3(NTHREADS), LDS_BYTES, stream, a);
        MK_AFTER_PHASE(p);
    }
#endif
}
```

```cpp
#include <hip/hip_runtime.h>
#include <cstdio>
#include <cstdint>
#ifndef MK_N_LAUNCHES
#define MK_N_LAUNCHES 1
#endif
#ifndef MK_CHECKS
#define MK_CHECKS 0
#endif
__device__ __forceinline__ int fresh_tid() { int t = threadIdx.x; asm volatile("" : "+v"(t)); return t; }
#ifndef ATT_MASK
#define ATT_MASK 7
#endif
#ifndef ATT_REP
#define ATT_REP 0
#endif
#ifndef DSA_REP
#define DSA_REP 0
#endif
#ifndef DIFF_REP
#define DIFF_REP 0
#endif
namespace pg8 {
#define PG8_LAS __attribute__((address_space(3)))
typedef unsigned short bf16_t;
typedef short bf16x8 __attribute__((ext_vector_type(8)));
typedef float f32x4 __attribute__((ext_vector_type(4)));
typedef unsigned u32x4 __attribute__((ext_vector_type(4)));
constexpr int BM = 256, BK = 64, HALF = 128, HTB = HALF * BK * 2  , STAGE_BYTES = 8 * HTB, NXCD = 8, WGM = 8;

__host__ __device__ __forceinline__ int lds_byte(int r, int c) { const int st = (r >> 4) * 2 + (c >> 5), rr = r & 15, cc = c & 31, ob = rr * 64 + cc * 2; return st * 1024 + (ob ^ (((ob >> 9) & 1) << 5)); }
__host__ __device__ __forceinline__ void stage_rc(int b, int& R, int& C) { const int st = b / 1024, sb = b % 1024, swz = sb ^ (((sb >> 9) & 1) << 5); R = (st >> 1) * 16 + swz / 64; C = (st & 1) * 32 + (swz % 64) / 2; }
__host__ __device__ __forceinline__ int perm32(int rho) { const int n = rho >> 4, i = rho & 15; return 8 * (i >> 2) + 4 * n + (i & 3); }

struct Unit { int pm, pn, seg; };
struct Gemm { const bf16_t* A; const bf16_t* Bt; int M, N, K; size_t segA = 0, segB = 0; };

struct StaticOrder {
    int nM, nN, nwg, G, c;
    __host__ __device__ void init(int M, int N, int G_, int c_) { nM = M / BM; nN = N / BM; nwg = nM * nN; G = G_; c = c_; }
    __host__ __device__ bool next(int i, Unit& u) const {
        const long L = (long)i * G + c; if (L >= nwg) return false;
        int wgid = (int)L; { const int q = nwg / NXCD, r = nwg % NXCD, xcd = wgid % NXCD, off = wgid / NXCD; wgid = (xcd < r ? xcd * (q + 1) : r * (q + 1) + (xcd - r) * q) + off; }
        const int nig = WGM * nN, gid = wgid / nig, fm = gid * WGM, gsz = (nM - fm) < WGM ? (nM - fm) : WGM;
        u.pm = fm + ((wgid % nig) % gsz); u.pn = (wgid % nig) / gsz; u.seg = 0; return true;
    }
    __device__ __forceinline__ void a_ready(const Unit&) const {}
    __device__ __forceinline__ void done(const Unit&) const {}
};

__device__ __forceinline__ unsigned cvt_pk_bf16(float lo, float hi) { unsigned r; asm volatile("v_cvt_pk_bf16_f32 %0, %1, %2" : "=v"(r) : "v"(lo), "v"(hi)); return r; }
typedef float f32x2 __attribute__((ext_vector_type(2)));
typedef int i32x4 __attribute__((ext_vector_type(4)));
template <bool I8> struct MmaOp;
template <> struct MmaOp<false> { typedef f32x4 acc_t; static __device__ __forceinline__ f32x4 mma(bf16x8 b, bf16x8 a, f32x4 c) { return __builtin_amdgcn_mfma_f32_16x16x32_bf16(b, a, c, 0, 0, 0); } };
template <> struct MmaOp<true>  { typedef i32x4 acc_t; static __device__ __forceinline__ i32x4 mma(bf16x8 b, bf16x8 a, i32x4 c) { return __builtin_amdgcn_mfma_i32_16x16x64_i8(__builtin_bit_cast(i32x4, b), __builtin_bit_cast(i32x4, a), c, 0, 0, 0); } };
template <class Epi, class Sched, bool ALIGN_EPI = false, bool SP2 = false, bool I8 = false>
__device__ __forceinline__ void gemm_phase(PG8_LAS unsigned char* lds, const Gemm g, const Sched& S, const Epi& E) {
    const int tid = fresh_tid(), wid = __builtin_amdgcn_readfirstlane(tid >> 6), lane = tid & 63, wr = wid >> 2, wc = wid & 3, fr = lane & 15, fq = lane >> 4;
    const int K = g.K, nt = K / BK;
    unsigned voffA[2], voffB[2];
#pragma unroll
    for (int i = 0; i < 2; ++i) { int R, C; stage_rc(tid * 16 + i * 8192, R, C); const int Rb = Epi::PERM ? ((R & ~31) + perm32(R & 31)) : R;
        voffA[i] = (unsigned)(R * K + C) * 2u; voffB[i] = (unsigned)(Rb * K + C) * 2u; }
    const size_t kstep = (size_t)(BK * 2);
    const size_t hstep = (size_t)HALF * K * 2;
    const size_t tstep = 2 * hstep;
    const unsigned ldsw = (unsigned)wid * 1024u;
    const int aoff = lds_byte(wr * 64 + fr, fq * 8), boff = lds_byte(wc * 32 + fr, fq * 8);
#define PG8_SA(b, h) (((b) * 2 + (h)) * HTB)
#define PG8_SB(b, h) ((4 + (b) * 2 + (h)) * HTB)
#define PG8_STAGE(bufoff, gbase, voff) do { _Pragma("unroll") for (int _i = 0; _i < 2; ++_i) \
        __builtin_amdgcn_global_load_lds((const unsigned*)((const char*)(gbase) + (voff)[_i]), (PG8_LAS unsigned*)(lds + (bufoff) + ldsw + _i * 8192), 16, 0, 0); } while (0)
#define PG8_LDA(dst, b, h) do { _Pragma("unroll") for (int m = 0; m < 4; ++m) _Pragma("unroll") for (int k = 0; k < 2; ++k) dst[m][k] = *(const PG8_LAS bf16x8*)(lds + PG8_SA(b, h) + aoff + m * 2048 + k * 1024); } while (0)
#define PG8_LDB(dst, b, h) do { _Pragma("unroll") for (int n = 0; n < 2; ++n) _Pragma("unroll") for (int k = 0; k < 2; ++k) dst[n][k] = *(const PG8_LAS bf16x8*)(lds + PG8_SB(b, h) + boff + n * 2048 + k * 1024); } while (0)
#define PG8_MMA(ai, bj, At, Bt) do { __builtin_amdgcn_s_setprio(1); _Pragma("unroll") for (int m = 0; m < 4; ++m) _Pragma("unroll") for (int n = 0; n < 2; ++n) _Pragma("unroll") for (int k = 0; k < 2; ++k) \
        acc[ai][bj][m][n] = MmaOp<I8>::mma(Bt[n][k], At[m][k], acc[ai][bj][m][n]); __builtin_amdgcn_s_setprio(0); } while (0)
#define PG8_WAIT_V(n) asm volatile("s_waitcnt vmcnt(" #n ")" ::: "memory")
#define PG8_WAIT_L(n) asm volatile("s_waitcnt lgkmcnt(" #n ")" ::: "memory")
#define PG8_BAR __builtin_amdgcn_s_barrier()
#define PG8_SCHED __builtin_amdgcn_sched_barrier(0)
    Unit cur, nxt; int ui = 0;
    if (!S.next(0, cur)) return;
    typedef typename MmaOp<I8>::acc_t acc_t;
    acc_t acc[2][2][4][2];
#pragma unroll
    for (int a = 0; a < 2; ++a)
#pragma unroll
        for (int b = 0; b < 2; ++b)
#pragma unroll
            for (int m = 0; m < 4; ++m)
#pragma unroll
                for (int n = 0; n < 2; ++n) acc[a][b][m][n] = acc_t{};
    bf16x8 At[4][2], B0[2][2], B1[2][2];
    const char* cA = (const char*)g.A + (size_t)cur.pm * tstep + (size_t)cur.seg * g.segA; const char* cB = (const char*)g.Bt + (size_t)cur.pn * tstep + (size_t)cur.seg * g.segB;
    S.a_ready(cur);
    if constexpr (SP2) {
        PG8_STAGE(PG8_SB(0, 0), cB, voffB); PG8_STAGE(PG8_SB(0, 1), cB + hstep, voffB); PG8_STAGE(PG8_SA(0, 0), cA, voffA); PG8_STAGE(PG8_SA(0, 1), cA + hstep, voffA);
        if (wr == 1) PG8_BAR;
        PG8_WAIT_V(2); PG8_BAR;
        PG8_STAGE(PG8_SB(1, 0), cB + kstep, voffB); PG8_STAGE(PG8_SA(1, 0), cA + kstep, voffA); PG8_STAGE(PG8_SB(1, 1), cB + hstep + kstep, voffB);
        PG8_WAIT_V(6); PG8_BAR;
    } else {
        PG8_STAGE(PG8_SB(0, 0), cB, voffB); PG8_STAGE(PG8_SA(0, 0), cA, voffA); PG8_STAGE(PG8_SB(0, 1), cB + hstep, voffB); PG8_STAGE(PG8_SA(0, 1), cA + hstep, voffA);
        if (wr == 1) PG8_BAR;
        PG8_WAIT_V(4); PG8_BAR;
        PG8_STAGE(PG8_SB(1, 0), cB + kstep, voffB); PG8_STAGE(PG8_SA(1, 0), cA + kstep, voffA); PG8_STAGE(PG8_SB(1, 1), cB + hstep + kstep, voffB);
        PG8_WAIT_V(6); PG8_BAR;
    }
    for (;;) {
        const bool has_next = S.next(ui + 1, nxt);
        const char* nA = has_next ? (const char*)g.A + (size_t)nxt.pm * tstep + (size_t)nxt.seg * g.segA : cA; const char* nB = has_next ? (const char*)g.Bt + (size_t)nxt.pn * tstep + (size_t)nxt.seg * g.segB : cB;
        for (int t = 0; t < nt; t += 2) {
            const bool last = (t == nt - 2);
            const char* a1 = cA + (size_t)(t + 1) * kstep;
            const char* a2 = last ? nA : cA + (size_t)(t + 2) * kstep; const char* b2 = last ? nB : cB + (size_t)(t + 2) * kstep;
            const char* a3 = a2 + kstep; const char* b3 = b2 + kstep;
            if (last && has_next) S.a_ready(nxt);
            if constexpr (SP2) {
            PG8_LDB(B0, 0, 0); PG8_LDB(B1, 0, 1); PG8_SCHED; PG8_LDA(At, 0, 0); PG8_STAGE(PG8_SA(1, 1), a1 + hstep, voffA);
            PG8_WAIT_V(8); PG8_WAIT_L(0); PG8_BAR; PG8_MMA(0, 0, At, B0); PG8_MMA(0, 1, At, B1); PG8_BAR; PG8_SCHED;
            PG8_LDA(At, 0, 1); PG8_STAGE(PG8_SB(0, 0), b2, voffB); PG8_STAGE(PG8_SB(0, 1), b2 + hstep, voffB); PG8_STAGE(PG8_SA(0, 0), a2, voffA);
            PG8_WAIT_V(8); PG8_WAIT_L(0); PG8_BAR; PG8_MMA(1, 0, At, B0); PG8_MMA(1, 1, At, B1); PG8_BAR; PG8_SCHED;
            PG8_LDB(B0, 1, 0); PG8_LDB(B1, 1, 1); PG8_SCHED; PG8_LDA(At, 1, 0); PG8_STAGE(PG8_SA(0, 1), a2 + hstep, voffA);
            PG8_WAIT_V(8); PG8_WAIT_L(0); PG8_BAR; PG8_MMA(0, 0, At, B0); PG8_MMA(0, 1, At, B1); PG8_BAR; PG8_SCHED;
            PG8_LDA(At, 1, 1); PG8_STAGE(PG8_SB(1, 0), b3, voffB); PG8_STAGE(PG8_SB(1, 1), b3 + hstep, voffB); PG8_STAGE(PG8_SA(1, 0), a3, voffA);
            PG8_WAIT_V(8); PG8_WAIT_L(0); PG8_BAR; PG8_MMA(1, 0, At, B0); PG8_MMA(1, 1, At, B1); PG8_BAR; PG8_SCHED;
            } else {
            PG8_LDB(B0, 0, 0); PG8_SCHED; PG8_LDA(At, 0, 0); PG8_STAGE(PG8_SA(1, 1), a1 + hstep, voffA);
            PG8_WAIT_L(8); PG8_BAR; PG8_WAIT_L(0); PG8_MMA(0, 0, At, B0); PG8_BAR; PG8_SCHED;
            PG8_LDB(B1, 0, 1); PG8_STAGE(PG8_SB(0, 0), b2, voffB);
            PG8_BAR; PG8_WAIT_L(0); PG8_MMA(0, 1, At, B1); PG8_BAR;
            PG8_LDA(At, 0, 1); PG8_STAGE(PG8_SA(0, 0), a2, voffA);
            PG8_BAR; PG8_WAIT_L(0); PG8_MMA(1, 0, At, B0); PG8_BAR; PG8_SCHED;
            PG8_STAGE(PG8_SB(0, 1), b2 + hstep, voffB);
            PG8_WAIT_V(6); PG8_BAR; PG8_MMA(1, 1, At, B1); PG8_BAR;
            PG8_LDB(B0, 1, 0); PG8_SCHED; PG8_LDA(At, 1, 0); PG8_STAGE(PG8_SA(0, 1), a2 + hstep, voffA);
            PG8_WAIT_L(8); PG8_BAR; PG8_WAIT_L(0); PG8_MMA(0, 0, At, B0); PG8_BAR; PG8_SCHED;
            PG8_LDB(B1, 1, 1); PG8_STAGE(PG8_SB(1, 0), b3, voffB);
            PG8_BAR; PG8_WAIT_L(0); PG8_MMA(0, 1, At, B1); PG8_BAR;
            PG8_LDA(At, 1, 1); PG8_STAGE(PG8_SA(1, 0), a3, voffA);
            PG8_BAR; PG8_WAIT_L(0); PG8_MMA(1, 0, At, B0); PG8_BAR; PG8_SCHED;
            PG8_STAGE(PG8_SB(1, 1), b3 + hstep, voffB);
            PG8_WAIT_V(6); PG8_BAR; PG8_MMA(1, 1, At, B1); PG8_BAR;
            }
        }
        if constexpr (ALIGN_EPI) { if (wr == 0) PG8_BAR; }
        if constexpr (!Epi::AFTER_DRAIN) { E(acc, cur, wr, wc, fr, fq); S.done(cur); }
        if (!has_next) break;
        if (!E.keep(cur)) {
#pragma unroll
        for (int a = 0; a < 2; ++a)
#pragma unroll
            for (int b = 0; b < 2; ++b)
#pragma unroll
                for (int m = 0; m < 4; ++m)
#pragma unroll
                    for (int n = 0; n < 2; ++n) acc[a][b][m][n] = acc_t{};
        }
        cur = nxt; cA = nA; cB = nB; ++ui;
        if constexpr (ALIGN_EPI) { if (wr == 1) PG8_BAR; }
    }
    PG8_WAIT_V(0);
    if constexpr (!ALIGN_EPI) { if (wr == 0) PG8_BAR; }
    PG8_BAR;
    if constexpr (Epi::AFTER_DRAIN) { E.fused(acc, cur, wr, wc, fr, fq, lds, wid, lane); S.done(cur); }
#undef PG8_SA
#undef PG8_SB
#undef PG8_STAGE
#undef PG8_LDA
#undef PG8_LDB
#undef PG8_MMA
#undef PG8_WAIT_V
#undef PG8_WAIT_L
#undef PG8_BAR
#undef PG8_SCHED
}
}

#define LAS __attribute__((address_space(3)))
typedef unsigned short bf16_t;
typedef short bf16x8 __attribute__((ext_vector_type(8)));
typedef float f32x4 __attribute__((ext_vector_type(4)));
typedef float f32x16 __attribute__((ext_vector_type(16)));
typedef unsigned u32x4 __attribute__((ext_vector_type(4)));
typedef unsigned u32x2 __attribute__((ext_vector_type(2)));

constexpr int NB = 16, SEQ = 2048, T = NB * SEQ, D = 1024, DFF = 2816, NIN = 6344, NINP = 3328;
constexpr float EPS = 1e-6f;
constexpr float C2 = 0.125f * 1.4426950408889634f;
constexpr int NWAVES = 8, NTHREADS = 512;
constexpr int NPHASE = 23;

constexpr int CI_QA = 0, CI_KA = 256, CI_VA = 320, CI_QI = 384, CI_KI = 896, CI_WI = 960, CI_QB = 968, CI_KB = 1224, CI_VB = 1480, CI_QC = 1736, CI_KC = 2248, CI_VC = 2760, CI_G = 3272;

constexpr size_t MiB = 1u << 20;
constexpr size_t WS_CTL = 0, CTL_BYTES = 1 * MiB;
constexpr int CW_BAR = 4096;
constexpr size_t CTL_KMEAN = 65536;
constexpr size_t CTL_DIAG = 655360;
constexpr size_t CTL_CMAX = 720896;
constexpr int CMAX_PER_LAYER = 2 * 5632 + 3072 + 3328;
constexpr size_t CTL_SA = 901120;
constexpr size_t WS_ROPE = 1 * MiB;
constexpr size_t WS_W = 3 * MiB;
constexpr size_t WL_GU = 0, WL_DN = 2 * (size_t)5632 * 1024, WL_IN = WL_DN + 2 * (size_t)1024 * 2816, WL_GT = WL_IN + (size_t)NINP * 1024,
                 WL_BR = WL_GT + 3 * (size_t)1024 * 1024, WL_OUT = WL_BR + (size_t)1024 * 1024, WL_END = WL_OUT + (size_t)1024 * 1024;
static_assert(WL_END * 2 * 2 <= 99 * MiB, "weights");
constexpr size_t WS_XB = 102 * MiB;
constexpr size_t DO_H = 0, DO_O = 64 * MiB;
constexpr size_t WS_G = 166 * MiB;
constexpr size_t WS_A = 262 * MiB;
constexpr size_t A_QA = 0, A_KA = 16 * MiB, A_VAT = 20 * MiB, A_QI = 24 * MiB, A_KI = 56 * MiB, A_WI = 60 * MiB, A_QB = 61 * MiB, A_KB = 77 * MiB, A_VBT = 93 * MiB,
                 A_QC = 109 * MiB, A_KC = 141 * MiB, A_VCT = 173 * MiB, A_END = 205 * MiB;
constexpr size_t WS_H8 = WS_A + A_END;
constexpr size_t WS_END = WS_H8 + 32 * MiB;
static_assert(WS_END <= 512 * MiB && CTL_CMAX + 2 * CMAX_PER_LAYER * 4 <= CTL_SA && CTL_SA + (size_t)T * 4 <= CTL_BYTES, "workspace");

#define XB_TMO      128
#define XB_XCNT(j)  (256  + 64 * (j))
#define XB_XSUB(j)  (1280 + 64 * (j))
#define XB_XGEN(j)  (2304 + 64 * (j))
#define XB_TOP      3328
#define XB_TOPGEN   3392
#define XCD_BAR_WORDS 3456
#define XB_SPIN_CAP (1u << 18)
__device__ __forceinline__ unsigned xb_ld(unsigned* p)              { return __hip_atomic_load(p, __ATOMIC_RELAXED, __HIP_MEMORY_SCOPE_AGENT); }
__device__ __forceinline__ unsigned xb_add(unsigned* p, unsigned v) { return __hip_atomic_fetch_add(p, v, __ATOMIC_RELAXED, __HIP_MEMORY_SCOPE_AGENT); }
__device__ __forceinline__ unsigned xb_xcc_id() { return (unsigned)__builtin_amdgcn_s_getreg((3 << 11) | 20) & 0xFu; }
#define XB_SPIN(cond, bar) do { unsigned _sp = 0; while (cond) { __builtin_amdgcn_s_sleep(1); \
    if ((++_sp & 255u) == 0u) { if (xb_ld(&(bar)[XB_TMO])) break; if (_sp > XB_SPIN_CAP) { atomicAdd(&(bar)[XB_TMO], 1u); break; } } } } while (0)
struct XcdBarrier { unsigned* bar; unsigned x; volatile LAS unsigned* st; };
__device__ __forceinline__ XcdBarrier xcd_barrier_post(unsigned* bar, volatile LAS unsigned* st) {
    XcdBarrier b; b.bar = bar; b.x = xb_xcc_id(); b.st = st;
    if (threadIdx.x == 0) (void)xb_add(&bar[XB_XCNT(b.x)], 1u);
    return b;
}
__device__ __forceinline__ void xcd_barrier_complete(unsigned* bar, unsigned x, unsigned& nloc, unsigned& nx) {
    const unsigned G = gridDim.x * gridDim.y * gridDim.z;
    unsigned sum, cnt, mine, sp = 0u;
    for (;;) {
        sum = 0u; cnt = 0u; mine = 0u;
#pragma unroll
        for (unsigned j = 0; j < 16; ++j) { const unsigned c = xb_ld(&bar[XB_XCNT(j)]); sum += c; cnt += (c > 0u) ? 1u : 0u; mine = (j == x) ? c : mine; }
        if (sum == G) break;
        __builtin_amdgcn_s_sleep(1);
        if ((++sp & 255u) == 0u) { if (xb_ld(&bar[XB_TMO])) break; if (sp > XB_SPIN_CAP) { atomicAdd(&bar[XB_TMO], 1u); break; } }
    }
    nloc = mine > 0u ? mine : 1u; nx = cnt > 0u ? cnt : 1u;
}
__device__ __forceinline__ void xcd_barrier(const XcdBarrier& b) {
    asm volatile("s_waitcnt vmcnt(0)" ::: "memory");
    __syncthreads();
    if (threadIdx.x == 0) {
        unsigned* bar = b.bar;
        __builtin_amdgcn_s_waitcnt(0);
        unsigned nloc = b.st[0], nx = b.st[1];
        if (nloc == 0u) { xcd_barrier_complete(bar, b.x, nloc, nx); b.st[0] = nloc; b.st[1] = nx; }
        const unsigned old = xb_add(&bar[XB_XSUB(b.x)], 1u);
        const unsigned gen = old / nloc;
        if (old + 1u == (gen + 1u) * nloc) {
            __builtin_amdgcn_fence(__ATOMIC_RELEASE, "agent");
            asm volatile("s_waitcnt vmcnt(0)" ::: "memory");
            const unsigned og = xb_add(&bar[XB_TOP], 1u);
            const unsigned tg = og / nx;
            if (og + 1u == (tg + 1u) * nx) xb_add(&bar[XB_TOPGEN], 1u);
            else XB_SPIN(xb_ld(&bar[XB_TOPGEN]) == tg, bar);
            __builtin_amdgcn_fence(__ATOMIC_ACQUIRE, "agent");
            xb_add(&bar[XB_XGEN(b.x)], 1u);
            asm volatile("s_waitcnt vmcnt(0)" ::: "memory");
        } else {
            XB_SPIN(xb_ld(&bar[XB_XGEN(b.x)]) == gen, bar);
            __builtin_amdgcn_fence(__ATOMIC_ACQUIRE, "agent");
            asm volatile("s_waitcnt vmcnt(0)" ::: "memory");
        }
    }
    __syncthreads();
}

typedef float f32x2_t __attribute__((ext_vector_type(2))); typedef __bf16 bf16x2_t __attribute__((ext_vector_type(2)));
__device__ __forceinline__ unsigned pk2(float lo, float hi) { f32x2_t v = {lo, hi}; bf16x2_t b = __builtin_convertvector(v, bf16x2_t); return __builtin_bit_cast(unsigned, b); }
__device__ __forceinline__ float bf2f(unsigned short h) { return __uint_as_float((unsigned)h << 16); }
#define RORF_(v, n) __uint_as_float((unsigned)__builtin_amdgcn_update_dpp(0, (int)__float_as_uint(v), 0x120 + (n), 0xf, 0xf, false))
__device__ __forceinline__ float wave_sum(float v) {
    v += RORF_(v, 1); v += RORF_(v, 2); v += RORF_(v, 4); v += RORF_(v, 8);
    { auto r = __builtin_amdgcn_permlane16_swap(__float_as_uint(v), __float_as_uint(v), false, false); v = __uint_as_float(r[0]) + __uint_as_float(r[1]); }
    { auto r = __builtin_amdgcn_permlane32_swap(__float_as_uint(v), __float_as_uint(v), false, false); v = __uint_as_float(r[0]) + __uint_as_float(r[1]); }
    return v;
}
__device__ __forceinline__ float wave_max_f(float v) {
    v = fmaxf(v, RORF_(v, 1)); v = fmaxf(v, RORF_(v, 2)); v = fmaxf(v, RORF_(v, 4)); v = fmaxf(v, RORF_(v, 8));
    { auto r = __builtin_amdgcn_permlane16_swap(__float_as_uint(v), __float_as_uint(v), false, false); v = fmaxf(__uint_as_float(r[0]), __uint_as_float(r[1])); }
    { auto r = __builtin_amdgcn_permlane32_swap(__float_as_uint(v), __float_as_uint(v), false, false); v = fmaxf(__uint_as_float(r[0]), __uint_as_float(r[1])); }
    return v;
}
__device__ __forceinline__ float fast_exp2(float x) { return __builtin_amdgcn_exp2f(x); }
__device__ __forceinline__ float fast_rcp(float x) { return __builtin_amdgcn_rcpf(x); }
__device__ __forceinline__ float sigmoidf_(float x) { return fast_rcp(1.0f + fast_exp2(-1.4426950408889634f * x)); }

struct Ctx {
    const float* x_in; const int* pos; const float* norm_g; const float* w_in; const float* qk_g; const float* lam_p; const float* subln_g;
    const float* w_branch; const float* w_out; const float* w_gate; const float* w_up; const float* w_down;
    float* out; unsigned char* ws;
};
__device__ __forceinline__ bf16_t* wsb(const Ctx& c, size_t off) { return (bf16_t*)(c.ws + off); }
__device__ __forceinline__ bf16_t* wlayer(const Ctx& c, int layer) { return (bf16_t*)(c.ws + WS_W) + (size_t)layer * WL_END; }

struct EpiSwiglu {
    static constexpr bool PERM = true, AFTER_DRAIN = false;
    __device__ __forceinline__ bool keep(const pg8::Unit&) const { return false; }
    bf16_t* O;
    __device__ __forceinline__ void operator()(const f32x4 (&acc)[2][2][4][2], const pg8::Unit& u, int wr, int wc, int fr_in, int fq_in) const {
        int fr = fr_in, fq = fq_in; asm volatile("" : "+v"(fr), "+v"(fq));
        const int row0 = u.pm * 256 + wr * 64 + fr, col = u.pn * 128 + wc * 32 + 8 * fq;
#pragma unroll
        for (int ai = 0; ai < 2; ++ai)
#pragma unroll
            for (int m = 0; m < 4; ++m) {
                float a[8];
#pragma unroll
                for (int n = 0; n < 2; ++n)
#pragma unroll
                    for (int e = 0; e < 4; ++e) { const float g = acc[ai][0][m][n][e], up = acc[ai][1][m][n][e]; a[4 * n + e] = g * sigmoidf_(g) * up; }
                u32x4 w; w.x = pk2(a[0], a[1]); w.y = pk2(a[2], a[3]); w.z = pk2(a[4], a[5]); w.w = pk2(a[6], a[7]);
                *(u32x4*)(O + (size_t)(row0 + ai * 128 + m * 16) * DFF + col) = w;
            }
    }
};
typedef int i32x4 __attribute__((ext_vector_type(4)));
struct EpiSwigluI8 {
    static constexpr bool PERM = true, AFTER_DRAIN = false;
    __device__ __forceinline__ bool keep(const pg8::Unit&) const { return false; }
    bf16_t* O; const float* sa; const float* cmax;
    __device__ __forceinline__ void operator()(const i32x4 (&acc)[2][2][4][2], const pg8::Unit& u, int wr, int wc, int fr_in, int fq_in) const {
        int fr = fr_in, fq = fq_in; asm volatile("" : "+v"(fr), "+v"(fq));
        const int row0 = u.pm * 256 + wr * 64 + fr, col = u.pn * 128 + wc * 32 + 8 * fq, bcol = u.pn * 256 + wc * 32 + 8 * fq;
        float sg[8], su[8];
        { const f32x4 g0 = *(const f32x4*)(cmax + bcol), g1 = *(const f32x4*)(cmax + bcol + 4), u0 = *(const f32x4*)(cmax + bcol + 128), u1 = *(const f32x4*)(cmax + bcol + 132);
#pragma unroll
          for (int k = 0; k < 4; ++k) { sg[k] = g0[k] * (1.0f / 127.0f); sg[4 + k] = g1[k] * (1.0f / 127.0f); su[k] = u0[k] * (1.0f / 127.0f); su[4 + k] = u1[k] * (1.0f / 127.0f); } }
        float sr[8];
#pragma unroll
        for (int s_ = 0; s_ < 8; ++s_) sr[s_] = sa[row0 + (s_ >> 2) * 128 + (s_ & 3) * 16];
#pragma unroll
        for (int ai = 0; ai < 2; ++ai)
#pragma unroll
            for (int m = 0; m < 4; ++m) {
                const float s = sr[ai * 4 + m];
                float a[8];
#pragma unroll
                for (int n = 0; n < 2; ++n)
#pragma unroll
                    for (int e = 0; e < 4; ++e) { const float g = (float)acc[ai][0][m][n][e] * (s * sg[4 * n + e]), up = (float)acc[ai][1][m][n][e] * (s * su[4 * n + e]); a[4 * n + e] = g * sigmoidf_(g) * up; }
                u32x4 w; w.x = pk2(a[0], a[1]); w.y = pk2(a[2], a[3]); w.z = pk2(a[4], a[5]); w.w = pk2(a[6], a[7]);
                *(u32x4*)(O + (size_t)(row0 + ai * 128 + m * 16) * DFF + col) = w;
            }
    }
};
struct EpiGateI8 {
    static constexpr bool PERM = true, AFTER_DRAIN = false;
    __device__ __forceinline__ bool keep(const pg8::Unit&) const { return false; }
    unsigned char* G; const float* sa; const float* cmax;
    __device__ __forceinline__ void operator()(const i32x4 (&acc)[2][2][4][2], const pg8::Unit& u, int wr, int wc, int fr_in, int fq_in) const {
        int fr = fr_in, fq = fq_in; asm volatile("" : "+v"(fr), "+v"(fq));
        const int row0 = u.pm * 256 + wr * 64 + fr, col0 = u.pn * 256 + wc * 32 + 8 * fq;
        float sc[2][8];
#pragma unroll
        for (int bj = 0; bj < 2; ++bj) { const f32x4 c0 = *(const f32x4*)(cmax + col0 + bj * 128), c1 = *(const f32x4*)(cmax + col0 + bj * 128 + 4);
#pragma unroll
            for (int k = 0; k < 4; ++k) { sc[bj][k] = c0[k] * (1.0f / 127.0f); sc[bj][4 + k] = c1[k] * (1.0f / 127.0f); } }
        float sr[8];
#pragma unroll
        for (int s_ = 0; s_ < 8; ++s_) sr[s_] = sa[row0 + (s_ >> 2) * 128 + (s_ & 3) * 16];
#pragma unroll
        for (int ai = 0; ai < 2; ++ai)
#pragma unroll
            for (int m = 0; m < 4; ++m)
#pragma unroll
                for (int bj = 0; bj < 2; ++bj) {
                    const float s = sr[ai * 4 + m];
                    unsigned q[8];
#pragma unroll
                    for (int k = 0; k < 8; ++k) q[k] = (unsigned)__builtin_fmaxf(__builtin_rintf(255.0f * sigmoidf_((float)acc[ai][bj][m][k >> 2][k & 3] * (s * sc[bj][k]))), 1.0f);
                    u32x2 w; w.x = q[0] | (q[1] << 8) | (q[2] << 16) | (q[3] << 24); w.y = q[4] | (q[5] << 8) | (q[6] << 16) | (q[7] << 24);
                    *(u32x2*)(G + (size_t)(row0 + ai * 128 + m * 16) * 3072 + col0 + bj * 128) = w;
                }
    }
};

template <bool IN_BF16, bool OUT_BF16> struct EpiResid {
    static constexpr bool PERM = true, AFTER_DRAIN = false;
    __device__ __forceinline__ bool keep(const pg8::Unit&) const { return false; }
    const void* in; void* out; float alpha;
    __device__ __forceinline__ void operator()(const f32x4 (&acc)[2][2][4][2], const pg8::Unit& u, int wr, int wc, int fr_in, int fq_in) const {
        int fr = fr_in, fq = fq_in; asm volatile("" : "+v"(fr), "+v"(fq));
        const int row0 = u.pm * 256 + wr * 64 + fr, col0 = u.pn * 256 + wc * 32 + 8 * fq;
        constexpr int DEPTH = 4;
#define RS_OFF(s_, bj_) ((size_t)(row0 + ((s_) >> 2) * 128 + ((s_) & 3) * 16) * D + col0 + (bj_) * 128)
        f32x4 bufa[DEPTH][2], bufb[DEPTH][2];
#define RS_LOAD(s_, d_) do { _Pragma("unroll") for (int bj = 0; bj < 2; ++bj) { \
            if (IN_BF16) { bufa[d_][bj] = __builtin_bit_cast(f32x4, *(const u32x4*)((const bf16_t*)in + RS_OFF(s_, bj))); } \
            else { bufa[d_][bj] = *(const f32x4*)((const float*)in + RS_OFF(s_, bj)); bufb[d_][bj] = *(const f32x4*)((const float*)in + RS_OFF(s_, bj) + 4); } } } while (0)
#pragma unroll
        for (int s_ = 0; s_ < DEPTH; ++s_) RS_LOAD(s_, s_);
        asm volatile("" ::: "memory");
#pragma unroll
        for (int s_ = 0; s_ < 8; ++s_) {
            const int ai = s_ >> 2, m = s_ & 3;
#pragma unroll
            for (int bj = 0; bj < 2; ++bj) {
                f32x4 x0, x1;
                if (IN_BF16) { const u32x4 w = __builtin_bit_cast(u32x4, bufa[s_ % DEPTH][bj]);
                    x0 = (f32x4){__uint_as_float(w.x << 16), __uint_as_float(w.x & 0xffff0000u), __uint_as_float(w.y << 16), __uint_as_float(w.y & 0xffff0000u)};
                    x1 = (f32x4){__uint_as_float(w.z << 16), __uint_as_float(w.z & 0xffff0000u), __uint_as_float(w.w << 16), __uint_as_float(w.w & 0xffff0000u)}; }
                else { x0 = bufa[s_ % DEPTH][bj]; x1 = bufb[s_ % DEPTH][bj]; }
                x0 = x0 + alpha * acc[ai][bj][m][0]; x1 = x1 + alpha * acc[ai][bj][m][1];
                if (OUT_BF16) { u32x4 w; w.x = pk2(x0[0], x0[1]); w.y = pk2(x0[2], x0[3]); w.z = pk2(x1[0], x1[1]); w.w = pk2(x1[2], x1[3]); *(u32x4*)((bf16_t*)out + RS_OFF(s_, bj)) = w; }
                else { *(f32x4*)((float*)out + RS_OFF(s_, bj)) = x0; *(f32x4*)((float*)out + RS_OFF(s_, bj) + 4) = x1; }
            }
            asm volatile("" ::: "memory");
            if (s_ + DEPTH < 8) { RS_LOAD(s_ + DEPTH, s_ % DEPTH); asm volatile("" ::: "memory"); }
        }
#undef RS_LOAD
#undef RS_OFF
    }
};
struct EpiGate {
    static constexpr bool PERM = true, AFTER_DRAIN = false;
    __device__ __forceinline__ bool keep(const pg8::Unit&) const { return false; }
    unsigned char* G;
    __device__ __forceinline__ void operator()(const f32x4 (&acc)[2][2][4][2], const pg8::Unit& u, int wr, int wc, int fr_in, int fq_in) const {
        int fr = fr_in, fq = fq_in; asm volatile("" : "+v"(fr), "+v"(fq));
        const int row0 = u.pm * 256 + wr * 64 + fr, col0 = u.pn * 256 + wc * 32 + 8 * fq;
#pragma unroll
        for (int ai = 0; ai < 2; ++ai)
#pragma unroll
            for (int m = 0; m < 4; ++m)
#pragma unroll
                for (int bj = 0; bj < 2; ++bj) {
                    unsigned q[8];
#pragma unroll
                    for (int k = 0; k < 8; ++k) q[k] = (unsigned)__builtin_fmaxf(__builtin_rintf(255.0f * sigmoidf_(acc[ai][bj][m][k >> 2][k & 3])), 1.0f);
                    u32x2 w; w.x = q[0] | (q[1] << 8) | (q[2] << 16) | (q[3] << 24); w.y = q[4] | (q[5] << 8) | (q[6] << 16) | (q[7] << 24);
                    *(u32x2*)(G + (size_t)(row0 + ai * 128 + m * 16) * 3072 + col0 + bj * 128) = w;
                }
    }
};
struct EpiMerge {
    static constexpr bool PERM = true, AFTER_DRAIN = false;
    __device__ __forceinline__ bool keep(const pg8::Unit&) const { return false; }
    const unsigned char* G; bf16_t* Mg; int first;
    __device__ __forceinline__ void operator()(const f32x4 (&acc)[2][2][4][2], const pg8::Unit& u, int wr, int wc, int fr_in, int fq_in) const {
        int fr = fr_in, fq = fq_in; asm volatile("" : "+v"(fr), "+v"(fq));
        const int row0 = u.pm * 256 + wr * 64 + fr, col0 = u.pn * 256 + wc * 32 + 8 * fq;
        constexpr int DEPTH = 4;
        u32x2 gb[DEPTH][2]; u32x4 mb[DEPTH][2];
#define MS_OFF(s_, bj_) ((size_t)(row0 + ((s_) >> 2) * 128 + ((s_) & 3) * 16) * D + col0 + (bj_) * 128)
#define GS_OFF(s_, bj_) ((size_t)(row0 + ((s_) >> 2) * 128 + ((s_) & 3) * 16) * 3072 + col0 + (bj_) * 128)
#pragma unroll
        for (int s_ = 0; s_ < DEPTH; ++s_)
#pragma unroll
            for (int bj = 0; bj < 2; ++bj) { gb[s_][bj] = *(const u32x2*)(G + GS_OFF(s_, bj)); mb[s_][bj] = (u32x4){0u, 0u, 0u, 0u}; if (!first) mb[s_][bj] = *(const u32x4*)(Mg + MS_OFF(s_, bj)); }
        asm volatile("" ::: "memory");
#pragma unroll
        for (int s_ = 0; s_ < 8; ++s_) {
            const int ai = s_ >> 2, m = s_ & 3;
#pragma unroll
            for (int bj = 0; bj < 2; ++bj) {
                const u32x2 g = gb[s_ % DEPTH][bj]; const u32x4 pm_ = mb[s_ % DEPTH][bj];
                float r[8];
#pragma unroll
                for (int k = 0; k < 4; ++k) {
                    const unsigned mw = pm_[k], gw = g[k >> 1] >> (16 * (k & 1));
                    const float a0 = acc[ai][bj][m][k >> 1][(k & 1) * 2], a1 = acc[ai][bj][m][k >> 1][(k & 1) * 2 + 1];
                    r[2 * k] = __uint_as_float(mw << 16) + (float)(gw & 0xffu) * (1.0f / 255.0f) * a0;
                    r[2 * k + 1] = __uint_as_float(mw & 0xffff0000u) + (float)((gw >> 8) & 0xffu) * (1.0f / 255.0f) * a1;
                }
                u32x4 w; w.x = pk2(r[0], r[1]); w.y = pk2(r[2], r[3]); w.z = pk2(r[4], r[5]); w.w = pk2(r[6], r[7]);
                *(u32x4*)(Mg + MS_OFF(s_, bj)) = w;
            }
            asm volatile("" ::: "memory");
            if (s_ + DEPTH < 8) {
#pragma unroll
                for (int bj = 0; bj < 2; ++bj) { gb[s_ % DEPTH][bj] = *(const u32x2*)(G + GS_OFF(s_ + DEPTH, bj)); if (!first) mb[s_ % DEPTH][bj] = *(const u32x4*)(Mg + MS_OFF(s_ + DEPTH, bj)); }
                asm volatile("" ::: "memory");
            }
        }
#undef MS_OFF
#undef GS_OFF
    }
};

struct EpiMergeSeg {
    static constexpr bool PERM = true, AFTER_DRAIN = false;
    const unsigned char* G3; bf16_t* Mg;
    __device__ __forceinline__ bool keep(const pg8::Unit& u) const { return u.seg != 3; }
    __device__ __forceinline__ void operator()(f32x4 (&acc)[2][2][4][2], const pg8::Unit& u, int wr, int wc, int fr_in, int fq_in) const {
        if (u.seg == 2) return;
        int fr = fr_in, fq = fq_in; asm volatile("" : "+v"(fr), "+v"(fq));
        const int row0 = u.pm * 256 + wr * 64 + fr, col0 = u.pn * 256 + wc * 32 + 8 * fq;
        const bool last = u.seg == 3;
        const unsigned char* Gn = G3 + (last ? 2 : u.seg) * 1024;
        const unsigned char* Gd = G3 + (u.seg + 1) * 1024;
        constexpr int DEPTH = 4;
        u32x2 nb[DEPTH][2], db[DEPTH][2];
#define GS_OFF(s_, bj_) ((size_t)(row0 + ((s_) >> 2) * 128 + ((s_) & 3) * 16) * 3072 + col0 + (bj_) * 128)
#define MS_OFF(s_, bj_) ((size_t)(row0 + ((s_) >> 2) * 128 + ((s_) & 3) * 16) * D + col0 + (bj_) * 128)
#pragma unroll
        for (int s_ = 0; s_ < DEPTH; ++s_)
#pragma unroll
            for (int bj = 0; bj < 2; ++bj) { nb[s_][bj] = *(const u32x2*)(Gn + GS_OFF(s_, bj)); db[s_][bj] = (u32x2){0x01010101u, 0x01010101u}; if (!last) db[s_][bj] = *(const u32x2*)(Gd + GS_OFF(s_, bj)); }
        asm volatile("" ::: "memory");
#pragma unroll
        for (int s_ = 0; s_ < 8; ++s_) {
            const int ai = s_ >> 2, m = s_ & 3;
#pragma unroll
            for (int bj = 0; bj < 2; ++bj) {
                const u32x2 gn = nb[s_ % DEPTH][bj], gd = db[s_ % DEPTH][bj];
                float r[8];
#pragma unroll
                for (int k = 0; k < 8; ++k) {
                    const float fn = (float)((gn[k >> 2] >> (8 * (k & 3))) & 0xffu), fd = last ? 255.0f : (float)((gd[k >> 2] >> (8 * (k & 3))) & 0xffu);
                    r[k] = acc[ai][bj][m][k >> 2][k & 3] * (fn * fast_rcp(fd));
                    acc[ai][bj][m][k >> 2][k & 3] = r[k];
                }
                if (last) { u32x4 w; w.x = pk2(r[0], r[1]); w.y = pk2(r[2], r[3]); w.z = pk2(r[4], r[5]); w.w = pk2(r[6], r[7]); *(u32x4*)(Mg + MS_OFF(s_, bj)) = w; }
            }
            asm volatile("" ::: "memory");
            if (s_ + DEPTH < 8) {
#pragma unroll
                for (int bj = 0; bj < 2; ++bj) { nb[s_ % DEPTH][bj] = *(const u32x2*)(Gn + GS_OFF(s_ + DEPTH, bj)); if (!last) db[s_ % DEPTH][bj] = *(const u32x2*)(Gd + GS_OFF(s_ + DEPTH, bj)); }
                asm volatile("" ::: "memory");
            }
        }
#undef GS_OFF
#undef MS_OFF
    }
};
struct SegOrder {
    pg8::StaticOrder base;
    __device__ __forceinline__ bool next(int i, pg8::Unit& u) const { if (!base.next(i >> 2, u)) return false; u.seg = i & 3; return true; }
    __device__ __forceinline__ void a_ready(const pg8::Unit&) const {}
    __device__ __forceinline__ void done(const pg8::Unit&) const {}
};

struct RevOrder {
    pg8::StaticOrder base; int rounds;
    __device__ __forceinline__ void init(int M, int N, int G_, int c_) { base.init(M, N, G_, c_); rounds = (base.nwg - c_ + G_ - 1) / G_; }
    __device__ __forceinline__ bool next(int i, pg8::Unit& u) const { return i < rounds && base.next(rounds - 1 - i, u); }
    __device__ __forceinline__ void a_ready(const pg8::Unit&) const {}
    __device__ __forceinline__ void done(const pg8::Unit&) const {}
};

struct GateOrder {
    pg8::StaticOrder base;
    __device__ __forceinline__ bool next(int i, pg8::Unit& u) const { if (!base.next(i / 3, u)) return false; u.pn += 4 * (i % 3); return true; }
    __device__ __forceinline__ void a_ready(const pg8::Unit&) const {}
    __device__ __forceinline__ void done(const pg8::Unit&) const {}
};

template <bool I8> struct EpiInProjT {
    typedef typename pg8::MmaOp<I8>::acc_t acc_t;
    static constexpr bool PERM = true, AFTER_DRAIN = false;
    __device__ __forceinline__ bool keep(const pg8::Unit&) const { return false; }
    unsigned char* ws;
    const LAS unsigned char* gains_lds;
    int layer;
    __device__ __forceinline__ void operator()(const acc_t (&acc)[2][2][4][2], const pg8::Unit& u, int wr, int wc, int fr_in, int fq_in) const {
        int fr = fr_in, fq = fq_in; asm volatile("" : "+v"(fr), "+v"(fq));
        const int pn = u.pn;
        unsigned char* A = ws + WS_A; const float* rope = (const float*)(ws + WS_ROPE);
        float* kmean = (float*)(ws + WS_CTL + CTL_KMEAN) + (size_t)layer * (16 * 4 * 8 * 2 * 64);
        int kind = 0;
        int ng = -1;
        bool do_rope = false; float scale = 1.0f; bool do_kmean = false;
        bf16_t* dst = nullptr; int pitch = 0, coloff = 0; int vdims = 0, vdimoff = 0;
        if (pn == 0)      { dst = (bf16_t*)(A + A_QA); pitch = 256; coloff = 64 * wc; ng = 0; do_rope = true; scale = C2; }
        else if (pn == 1) {
            if (wc == 0)      { dst = (bf16_t*)(A + A_KA); pitch = 64; coloff = 0; ng = 1; do_rope = true; }
            else if (wc == 1) { kind = 1; dst = (bf16_t*)(A + A_VAT); vdims = 64; vdimoff = 0; }
            else if (wc == 2) { dst = (bf16_t*)(A + A_KI); pitch = 64; coloff = 0; do_rope = true; }
            else              { kind = 2; }
        }
        else if (pn <= 3) { dst = (bf16_t*)(A + A_QI); pitch = 512; coloff = 64 * (4 * (pn - 2) + wc); do_rope = true; }
        else if (pn == 4) { dst = (bf16_t*)(A + A_QB); pitch = 256; coloff = 64 * wc; ng = 2; do_rope = true; scale = C2; }
        else if (pn == 5) { dst = (bf16_t*)(A + A_KB); pitch = 256; coloff = 64 * wc; ng = 3; do_rope = true; do_kmean = true; }
        else if (pn == 6) { kind = 1; dst = (bf16_t*)(A + A_VBT); vdims = 256; vdimoff = 64 * wc; }
        else if (pn <= 8) { dst = (bf16_t*)(A + A_QC); pitch = 512; coloff = 64 * (4 * (pn - 7) + wc); ng = 4; do_rope = true; scale = C2; }
        else if (pn <= 10){ dst = (bf16_t*)(A + A_KC); pitch = 512; coloff = 64 * (4 * (pn - 9) + wc); ng = 5; do_rope = true; }
        else              { kind = 1; dst = (bf16_t*)(A + A_VCT); vdims = 512; vdimoff = 64 * (4 * (pn - 11) + wc); }
        const int row0 = u.pm * 256 + wr * 64 + fr;
        const float* sa = (const float*)(ws + WS_CTL + CTL_SA);
        const LAS float* scp = (const LAS float*)(gains_lds + 1536) + u.pn * 256 + wc * 32 + 8 * fq;
#define IPS(ai_, m_) (sa[row0 + (ai_) * 128 + (m_) * 16])
#define IPSC() float sc_[16]; if (I8) { const LAS float* q_ = scp; asm volatile("" : "+v"(q_)); const f32x4 a_ = *(const LAS f32x4*)q_, b_ = *(const LAS f32x4*)(q_ + 4), c_ = *(const LAS f32x4*)(q_ + 128), d_ = *(const LAS f32x4*)(q_ + 132); \
        _Pragma("unroll") for (int k_ = 0; k_ < 4; ++k_) { sc_[k_] = a_[k_]; sc_[4 + k_] = b_[k_]; sc_[8 + k_] = c_[k_]; sc_[12 + k_] = d_[k_]; } }
#define IPV(ai_, bj_, m_, n_, e_) (I8 ? (float)acc[ai_][bj_][m_][n_][e_] * (rs_ * sc_[8 * (bj_) + 4 * (n_) + (e_)]) : (float)acc[ai_][bj_][m_][n_][e_])
        if (kind == 2) {
            if (fq == 0) {
                float* WI = (float*)(A + A_WI);
#pragma unroll
                for (int ai = 0; ai < 2; ++ai)
#pragma unroll
                    for (int m = 0; m < 4; ++m) { const size_t tok = (size_t)(row0 + ai * 128 + m * 16); const float rs_ = I8 ? IPS(ai, m) : 1.0f; IPSC();
                        *(f32x4*)(WI + tok * 8) = (f32x4){IPV(ai, 0, m, 0, 0), IPV(ai, 0, m, 0, 1), IPV(ai, 0, m, 0, 2), IPV(ai, 0, m, 0, 3)} * 0.04419417382415922f;
                        *(f32x4*)(WI + tok * 8 + 4) = (f32x4){IPV(ai, 0, m, 1, 0), IPV(ai, 0, m, 1, 1), IPV(ai, 0, m, 1, 2), IPV(ai, 0, m, 1, 3)} * 0.04419417382415922f; }
            }
            return;
        }
        if (kind == 1) {
            const int b = u.pm >> 3;
#pragma unroll
            for (int ai = 0; ai < 2; ++ai)
#pragma unroll
                for (int m = 0; m < 4; ++m) {
                    const float rs_ = I8 ? IPS(ai, m) : 1.0f; IPSC();
                    const int s = (row0 + ai * 128 + m * 16) & (SEQ - 1);
                    bf16_t* base = dst + ((size_t)b * vdims + vdimoff + 16 * fq) * SEQ + s;
#pragma unroll
                    for (int bj = 0; bj < 2; ++bj)
#pragma unroll
                        for (int n = 0; n < 2; ++n)
#pragma unroll
                            for (int e = 0; e < 4; e += 2) { const unsigned w = pk2(IPV(ai, bj, m, n, e), IPV(ai, bj, m, n, e + 1));
                                base[(size_t)(8 * bj + 4 * n + e) * SEQ] = (bf16_t)(w & 0xffffu); base[(size_t)(8 * bj + 4 * n + e + 1) * SEQ] = (bf16_t)(w >> 16); }
                }
            return;
        }
        const LAS float* gp = (const LAS float*)gains_lds + (ng >= 0 ? ng : 0) * 64 + 16 * fq;
        float ksum[16];
#pragma unroll
        for (int k = 0; k < 16; ++k) ksum[k] = 0.0f;
        const bool roper = do_rope && fq == 0;
        const unsigned* ropeu = (const unsigned*)rope;
        float rs_n = I8 ? IPS(0, 0) : 1.0f;
        u32x4 rt_n[2];
        if (roper) { const unsigned* rp = ropeu + (size_t)row0 * 8; rt_n[0] = *(const u32x4*)rp; rt_n[1] = *(const u32x4*)(rp + 4); }
#pragma unroll
        for (int sl = 0; sl < 8; ++sl) {
                const int ai = sl >> 2, m = sl & 3;
                const size_t tok = (size_t)(row0 + ai * 128 + m * 16);
                const float rs_ = rs_n;
                const u32x4 t0 = rt_n[0], t1 = rt_n[1];
                if (sl < 7) {
                    const int ai1 = (sl + 1) >> 2, m1 = (sl + 1) & 3;
                    if (I8) rs_n = IPS(ai1, m1);
                    if (roper) { const unsigned* rp = ropeu + (size_t)(row0 + ai1 * 128 + m1 * 16) * 8; rt_n[0] = *(const u32x4*)rp; rt_n[1] = *(const u32x4*)(rp + 4); }
                }
                float v[16];
                { IPSC();
#pragma unroll
                for (int bj = 0; bj < 2; ++bj)
#pragma unroll
                    for (int n = 0; n < 2; ++n)
#pragma unroll
                        for (int e = 0; e < 4; ++e) v[8 * bj + 4 * n + e] = IPV(ai, bj, m, n, e); }
                if (ng >= 0) {
                    float ss = 0.0f;
#pragma unroll
                    for (int k = 0; k < 16; ++k) ss += v[k] * v[k];
                    ss += __shfl_xor(ss, 16); ss += __shfl_xor(ss, 32);
                    const float rstd = rsqrtf(ss * (1.0f / 64.0f) + EPS);
                    const f32x4 g0 = *(const LAS f32x4*)gp, g1 = *(const LAS f32x4*)(gp + 4), g2 = *(const LAS f32x4*)(gp + 8), g3 = *(const LAS f32x4*)(gp + 12);
#pragma unroll
                    for (int k = 0; k < 4; ++k) { v[k] = v[k] * rstd * g0[k]; v[4 + k] = v[4 + k] * rstd * g1[k]; v[8 + k] = v[8 + k] * rstd * g2[k]; v[12 + k] = v[12 + k] * rstd * g3[k]; }
                }
                if (roper) {
#pragma unroll
                    for (int i = 0; i < 8; ++i) { const unsigned cs_ = i < 4 ? t0[i & 3] : t1[i & 3]; const float c = __uint_as_float(cs_ << 16), s = __uint_as_float(cs_ & 0xffff0000u);
                        const float x1 = v[i], x2 = v[8 + i]; v[i] = x1 * c - x2 * s; v[8 + i] = x2 * c + x1 * s; }
                }
                if (do_kmean) {
#pragma unroll
                    for (int k = 0; k < 16; ++k) ksum[k] += v[k];
                }
#pragma unroll
                for (int k = 0; k < 16; ++k) v[k] *= scale;
                bf16_t* p = dst + tok * pitch + coloff + 16 * fq;
                u32x4 w0, w1; w0.x = pk2(v[0], v[1]); w0.y = pk2(v[2], v[3]); w0.z = pk2(v[4], v[5]); w0.w = pk2(v[6], v[7]);
                w1.x = pk2(v[8], v[9]); w1.y = pk2(v[10], v[11]); w1.z = pk2(v[12], v[13]); w1.w = pk2(v[14], v[15]);
                *(u32x4*)p = w0; *(u32x4*)(p + 8) = w1;
            }
        if (do_kmean) {
#pragma unroll
            for (int k = 0; k < 16; ++k) { float s = ksum[k]; s += __shfl_xor(s, 1); s += __shfl_xor(s, 2); s += __shfl_xor(s, 4); s += __shfl_xor(s, 8); ksum[k] = s; }
            if (fr == 0) {
                float* km = kmean + (((size_t)((u.pm >> 3) * 4 + wc) * 8 + (u.pm & 7)) * 2 + wr) * 64 + 16 * fq;
#pragma unroll
                for (int k = 0; k < 16; k += 4) *(f32x4*)(km + k) = (f32x4){ksum[k], ksum[k + 1], ksum[k + 2], ksum[k + 3]};
            }
        }
    }
};
#undef IPV
#undef IPS
#undef IPSC

template <class Map> __device__ __forceinline__ void conv_item(const Map& map, int ld, int K, bf16_t* WT, const float* gk, LAS float* scr, int item, int nblk, int lane) {
    const int kb = item / nblk, nb = item % nblk, k0 = 64 * kb, n0 = 32 * nb;
    typedef const __attribute__((address_space(1))) float* gptr;
    const float* src0 = map(n0 + (lane & 31)); const bool valid = src0 != nullptr; const gptr src = (gptr)(uintptr_t)(valid ? src0 : map(0));
    float tv[32];
#pragma unroll
    for (int i = 0; i < 32; ++i) { const int kk = 2 * i + (lane >> 5); tv[i] = src[(size_t)(k0 + kk) * ld]; }
#pragma unroll
    for (int i = 0; i < 32; ++i) { const int kk = 2 * i + (lane >> 5); float v = valid ? tv[i] : 0.0f; if (gk) v *= gk[k0 + kk]; scr[kk * 33 + (lane & 31)] = v; }
    asm volatile("s_waitcnt lgkmcnt(0)" ::: "memory");
    const int c = lane & 7;
#pragma unroll
    for (int j = 0; j < 4; ++j) { const int n = (lane >> 3) + 8 * j; const LAS float* s = scr + (8 * c) * 33 + n;
        u32x4 o; o.x = pk2(s[0 * 33], s[1 * 33]); o.y = pk2(s[2 * 33], s[3 * 33]); o.z = pk2(s[4 * 33], s[5 * 33]); o.w = pk2(s[6 * 33], s[7 * 33]);
        *(u32x4*)(WT + (size_t)(n0 + n) * K + k0 + 8 * c) = o; }
    asm volatile("s_waitcnt lgkmcnt(0)" ::: "memory");
}
struct MapPlain { const float* W; __device__ __forceinline__ const float* operator()(int n) const { return W + n; } };
struct MapGU { const float* Wg; const float* Wu; __device__ __forceinline__ const float* operator()(int n) const { const int t = n >> 8, w = n & 255;
    const uintptr_t a = (uintptr_t)Wg, d = (uintptr_t)Wu - (uintptr_t)Wg; return (const float*)(a + d * (uintptr_t)(w >> 7)) + t * 128 + (w & 127); } };
struct MapIn { const float* W;
    __device__ __forceinline__ const float* operator()(int n) const {
        const int pn = n >> 8, w = n & 255, bj = w >> 7, wc = (w >> 5) & 3, fq = (w >> 3) & 3, j = w & 7, dim = 16 * fq + 8 * bj + j;
        int base;
        if (pn == 0) base = CI_QA + 64 * wc;
        else if (pn == 1) { if (wc == 0) base = CI_KA; else if (wc == 1) base = CI_VA; else if (wc == 2) base = CI_KI; else { if (dim >= 8) return nullptr; base = CI_WI; } }
        else if (pn <= 3) base = CI_QI + 64 * (4 * (pn - 2) + wc);
        else if (pn == 4) base = CI_QB + 64 * wc;
        else if (pn == 5) base = CI_KB + 64 * wc;
        else if (pn == 6) base = CI_VB + 64 * wc;
        else if (pn <= 8) base = CI_QC + 64 * (4 * (pn - 7) + wc);
        else if (pn <= 10) base = CI_KC + 64 * (4 * (pn - 9) + wc);
        else base = CI_VC + 64 * (4 * (pn - 11) + wc);
        return W + base + dim;
    } };

template <bool G64, class Map> __device__ __forceinline__ void colmax_item(const Map& map, int ld, const float* gk, unsigned* cmax, int item, int nblk, int lane) {
    const int kb = item / nblk, nb = item % nblk, k0 = 64 * kb, n0 = 32 * nb;
    typedef const __attribute__((address_space(1))) float* gptr;
    const float* src0 = map(n0 + (lane & 31)); const bool valid = src0 != nullptr; const gptr src = (gptr)(uintptr_t)(valid ? src0 : map(0));
    float tv[32];
#pragma unroll
    for (int i = 0; i < 32; ++i) { const int kk = 2 * i + (lane >> 5); tv[i] = src[(size_t)(k0 + kk) * ld]; }
    float mx = 0.0f;
#pragma unroll
    for (int i = 0; i < 32; ++i) { const int kk = 2 * i + (lane >> 5); mx = fmaxf(mx, valid ? fabsf(tv[i] * gk[k0 + kk]) : 0.0f); }
    mx = fmaxf(mx, __shfl_xor(mx, 32));
    if (G64) { mx = wave_max_f(mx); if (lane == 0) atomicMax(cmax + (n0 >> 8) * 4 + ((n0 >> 5) & 3), __float_as_uint(mx)); }
    else if (lane < 32) atomicMax(cmax + n0 + lane, __float_as_uint(mx));
}
template <bool G64, class Map> __device__ __forceinline__ void conv_item_i8(const Map& map, int ld, int K, signed char* WT, const float* gk, const float* cmax, LAS float* scr, int item, int nblk, int lane) {
    const int kb = item / nblk, nb = item % nblk, k0 = 64 * kb, n0 = 32 * nb;
    typedef const __attribute__((address_space(1))) float* gptr;
    const float* src0 = map(n0 + (lane & 31)); const bool valid = src0 != nullptr; const gptr src = (gptr)(uintptr_t)(valid ? src0 : map(0));
    const float am = G64 ? cmax[(n0 >> 8) * 4 + ((n0 >> 5) & 3)] : cmax[n0 + (lane & 31)], qs = (valid && am > 0.0f) ? 127.0f / am : 0.0f;
    float tv[32];
#pragma unroll
    for (int i = 0; i < 32; ++i) { const int kk = 2 * i + (lane >> 5); tv[i] = src[(size_t)(k0 + kk) * ld]; }
#pragma unroll
    for (int i = 0; i < 32; ++i) { const int kk = 2 * i + (lane >> 5); scr[kk * 33 + (lane & 31)] = __builtin_rintf(tv[i] * gk[k0 + kk] * qs); }
    asm volatile("s_waitcnt lgkmcnt(0)" ::: "memory");
    const int c = lane & 7;
#pragma unroll
    for (int j = 0; j < 4; ++j) { const int n = (lane >> 3) + 8 * j; const LAS float* s = scr + (8 * c) * 33 + n;
        unsigned b[8];
#pragma unroll
        for (int k = 0; k < 8; ++k) b[k] = (unsigned)(int)s[k * 33] & 0xffu;
        u32x2 o; o.x = b[0] | (b[1] << 8) | (b[2] << 16) | (b[3] << 24); o.y = b[4] | (b[5] << 8) | (b[6] << 16) | (b[7] << 24);
        *(u32x2*)(WT + (size_t)(n0 + n) * K + k0 + 8 * c) = o; }
    asm volatile("s_waitcnt lgkmcnt(0)" ::: "memory");
}
template <int PASS> __device__ __forceinline__ void prologue_i8(const Ctx& c, LAS unsigned char* lds) {
    const int tid = fresh_tid(), lane = tid & 63, wave = __builtin_amdgcn_readfirstlane(tid >> 6);
    LAS float* scr = (LAS float*)(lds + wave * 16384);
    const int gw = blockIdx.x * NWAVES + wave, NGW = gridDim.x * NWAVES;
    constexpr int I_GU = 16 * 176, I_GT3 = 16 * 96, I_IN8 = 16 * 104, PER_LAYER = 2 * I_GU + I_GT3 + I_IN8;
    for (int it = gw; it < 2 * PER_LAYER; it += NGW) {
        const int layer = it / PER_LAYER; int r = it % PER_LAYER;
        bf16_t* WL = wlayer(c, layer);
        const float* ng = c.norm_g + (size_t)layer * 3 * D;
        float* cm = (float*)(c.ws + WS_CTL + CTL_CMAX) + (size_t)layer * CMAX_PER_LAYER;
        if (r < 2 * I_GU) { const int f = r / I_GU; r %= I_GU; const size_t wo = ((size_t)layer * 2 + f) * D * DFF; const MapGU map{c.w_gate + wo, c.w_up + wo};
            if (PASS == 0) colmax_item<false>(map, DFF, ng + (f ? 2 : 0) * D, (unsigned*)cm + f * 5632, r, 176, lane);
            else conv_item_i8<false>(map, DFF, D, (signed char*)(WL + WL_GU + (size_t)f * 5632 * 1024), ng + (f ? 2 : 0) * D, cm + f * 5632, scr, r, 176, lane);
            continue; }
        r -= 2 * I_GU;
        if (r < I_GT3) { const MapPlain map{c.w_in + (size_t)layer * D * NIN + CI_G};
          if (PASS == 0) colmax_item<false>(map, NIN, ng + D, (unsigned*)cm + 2 * 5632, r, 96, lane);
          else conv_item_i8<false>(map, NIN, D, (signed char*)(WL + WL_GT), ng + D, cm + 2 * 5632, scr, r, 96, lane);
          continue; }
        r -= I_GT3;
        { const MapIn map{c.w_in + (size_t)layer * D * NIN};
          if (PASS == 0) colmax_item<false>(map, NIN, ng + D, (unsigned*)cm + 2 * 5632 + 3072, r, 104, lane);
          else conv_item_i8<false>(map, NIN, D, (signed char*)(WL + WL_IN), ng + D, cm + 2 * 5632 + 3072, scr, r, 104, lane); }
    }
}

__device__ __forceinline__ void phase_prologue(const Ctx& c, LAS unsigned char* lds) {
    const int tid = fresh_tid(), lane = tid & 63, wave = __builtin_amdgcn_readfirstlane(tid >> 6);
    LAS float* scr = (LAS float*)(lds + wave * 16384);
    const int gw = blockIdx.x * NWAVES + wave, NGW = gridDim.x * NWAVES;
    constexpr int I_GU = 16 * 176, I_DN = 44 * 32, I_IN = 16 * 104, I_GT = 16 * 32, I_BA = 4 * 32, I_BC = 8 * 32, I_OUT = 16 * 32;
    constexpr int PER_LAYER = 2 * I_DN + 4 * I_BA + I_OUT;
    for (int it = gw; it < 2 * PER_LAYER; it += NGW) {
        const int layer = it / PER_LAYER; int r = it % PER_LAYER;
        bf16_t* WL = wlayer(c, layer);
        const float* ng = c.norm_g + (size_t)layer * 3 * D;
        if (r < 2 * I_DN) { const int f = r / I_DN; r %= I_DN; const size_t wo = ((size_t)layer * 2 + f) * D * DFF;
            conv_item(MapPlain{c.w_down + wo}, D, DFF, WL + WL_DN + (size_t)f * 1024 * 2816, nullptr, scr, r, 32, lane); continue; } r -= 2 * I_DN;
        if (r < 4 * I_BA) { const int i = r / I_BA; r %= I_BA; conv_item(MapPlain{c.w_branch + (size_t)layer * D * D + (size_t)i * 256 * D}, D, 256, WL + WL_BR + (size_t)i * 1024 * 256, nullptr, scr, r, 32, lane); continue; } r -= 4 * I_BA;
        conv_item(MapPlain{c.w_out + (size_t)layer * D * D}, D, D, WL + WL_OUT, nullptr, scr, r, 32, lane);
    }
    unsigned* rope = (unsigned*)(c.ws + WS_ROPE);
    for (int idx = blockIdx.x * NTHREADS + tid; idx < T * 8; idx += gridDim.x * NTHREADS) {
        const int tok = idx >> 3, i = idx & 7;
        const float inv = i == 0 ? 1.0f : i == 1 ? 0x1.8d275ep-3f : i == 2 ? 0x1.341190p-5f : i == 3 ? 0x1.ddee9cp-8f : i == 4 ? 0x1.72ba44p-10f : i == 5 ? 0x1.1f91f0p-12f : i == 6 ? 0x1.be2188p-15f : 0x1.5a0f4ep-17f;
        const float ang = (float)c.pos[tok] * inv;
        const double rev = (double)ang * 0.15915494309189535;
        const float fr_ = (float)(rev - __builtin_rint(rev));
        rope[(size_t)tok * 8 + i] = pk2(__builtin_amdgcn_cosf(fr_), __builtin_amdgcn_sinf(fr_));
    }
}

template <bool IN_BF16, bool OUT_BF, bool OUT_I8> __device__ __forceinline__ void phase_norm(const void* xin, bf16_t* h, signed char* h8, float* sa) {
    const int tid = fresh_tid(), lane = tid & 63, wave = tid >> 6;
    const int gw = blockIdx.x * NWAVES + wave, NGW = gridDim.x * NWAVES;
    constexpr int NR = 4;
    for (int row0 = gw; row0 < T; row0 += NR * NGW) {
        float v[NR][16];
#pragma unroll
        for (int k = 0; k < NR; ++k) {
            const int row = min(row0 + k * NGW, T - 1);
            if (IN_BF16) {
                const u32x4* xr = (const u32x4*)((const bf16_t*)xin + (size_t)row * D) + 2 * lane;
                const u32x4 a = xr[0], b = xr[1]; const unsigned w[8] = {a.x, a.y, a.z, a.w, b.x, b.y, b.z, b.w};
#pragma unroll
                for (int j = 0; j < 8; ++j) { v[k][2 * j] = __uint_as_float(w[j] << 16); v[k][2 * j + 1] = __uint_as_float(w[j] & 0xffff0000u); }
            } else {
                const f32x4* xr = (const f32x4*)((const float*)xin + (size_t)row * D) + lane;
#pragma unroll
                for (int j = 0; j < 4; ++j) { const f32x4 t = xr[64 * j]; v[k][4 * j] = t.x; v[k][4 * j + 1] = t.y; v[k][4 * j + 2] = t.z; v[k][4 * j + 3] = t.w; }
            }
        }
#pragma unroll
        for (int k = 0; k < NR; ++k) {
            const int row = row0 + k * NGW;
            if (row >= T) break;
            float s = 0.0f, am = 0.0f;
#pragma unroll
            for (int j = 0; j < 16; ++j) { s += v[k][j] * v[k][j]; am = fmaxf(am, fabsf(v[k][j])); }
            const float rstd = rsqrtf(wave_sum(s) * (1.0f / D) + EPS);
            if (OUT_BF) {
                if (IN_BF16) {
                    u32x4* o = (u32x4*)(h + (size_t)row * D) + 2 * lane;
                    u32x4 a, b; a.x = pk2(v[k][0] * rstd, v[k][1] * rstd); a.y = pk2(v[k][2] * rstd, v[k][3] * rstd); a.z = pk2(v[k][4] * rstd, v[k][5] * rstd); a.w = pk2(v[k][6] * rstd, v[k][7] * rstd);
                    b.x = pk2(v[k][8] * rstd, v[k][9] * rstd); b.y = pk2(v[k][10] * rstd, v[k][11] * rstd); b.z = pk2(v[k][12] * rstd, v[k][13] * rstd); b.w = pk2(v[k][14] * rstd, v[k][15] * rstd);
                    o[0] = a; o[1] = b;
                } else {
                    u32x2* o = (u32x2*)(h + (size_t)row * D) + lane;
#pragma unroll
                    for (int j = 0; j < 4; ++j) { u32x2 w; w.x = pk2(v[k][4 * j] * rstd, v[k][4 * j + 1] * rstd); w.y = pk2(v[k][4 * j + 2] * rstd, v[k][4 * j + 3] * rstd); o[64 * j] = w; }
                }
            }
            if (OUT_I8) {
                am = wave_max_f(am);
                const float qs = am > 0.0f ? 127.0f / am : 0.0f;
                unsigned b[16];
#pragma unroll
                for (int j = 0; j < 16; ++j) b[j] = (unsigned)(int)__builtin_rintf(v[k][j] * qs) & 0xffu;
                if (IN_BF16) { u32x4 w; w.x = b[0] | (b[1] << 8) | (b[2] << 16) | (b[3] << 24); w.y = b[4] | (b[5] << 8) | (b[6] << 16) | (b[7] << 24);
                               w.z = b[8] | (b[9] << 8) | (b[10] << 16) | (b[11] << 24); w.w = b[12] | (b[13] << 8) | (b[14] << 16) | (b[15] << 24);
                               *((u32x4*)(h8 + (size_t)row * D) + lane) = w; }
                else {
#pragma unroll
                    for (int j = 0; j < 4; ++j) *((unsigned*)(h8 + (size_t)row * D) + lane + 64 * j) = b[4 * j] | (b[4 * j + 1] << 8) | (b[4 * j + 2] << 16) | (b[4 * j + 3] << 24); }
                if (lane == 0) sa[row] = rstd * am * (1.0f / 127.0f);
            }
        }
    }
}

namespace att {
constexpr int KP = 144;
constexpr int KT_BYTES = 64 * KP;
constexpr float NEG = -INFINITY;
__device__ __forceinline__ int pi32(int m) { return (m & ~12) | ((m & 8) >> 1) | ((m & 4) << 1); }
__device__ __forceinline__ f32x16 mfma32(bf16x8 a, bf16x8 b, f32x16 c) { return __builtin_amdgcn_mfma_f32_32x32x16_bf16(a, b, c, 0, 0, 0); }

__device__ __forceinline__ void qk_tile(f32x16& p0, f32x16& p1, const LAS unsigned char* Kt, const bf16x8 (&qr)[4], int koff) {
    bf16x8 kf[2][2];
    kf[0][0] = *(const LAS bf16x8*)(Kt + koff); kf[0][1] = *(const LAS bf16x8*)(Kt + koff + 32 * KP);
    const f32x16 z = {0.f, 0.f, 0.f, 0.f, 0.f, 0.f, 0.f, 0.f, 0.f, 0.f, 0.f, 0.f, 0.f, 0.f, 0.f, 0.f};
#pragma unroll
    for (int d0 = 0; d0 < 4; ++d0) {
        if (d0 < 3) { kf[(d0 + 1) & 1][0] = *(const LAS bf16x8*)(Kt + koff + (d0 + 1) * 32); kf[(d0 + 1) & 1][1] = *(const LAS bf16x8*)(Kt + koff + 32 * KP + (d0 + 1) * 32); }
        if (d0 == 0) { p0 = mfma32(kf[0][0], qr[0], z); p1 = mfma32(kf[0][1], qr[0], z); }
        else { p0 = mfma32(kf[d0 & 1][0], qr[d0], p0); p1 = mfma32(kf[d0 & 1][1], qr[d0], p1); }
    }
}
struct SoftState { float mref, l; bool valid; };
constexpr float SM_THR = 6.0f;
template <int NDB, int PMASK> __device__ __forceinline__ void softmax_tile(const f32x16& p0, const f32x16& p1, SoftState& st, f32x16 (&o)[NDB], bf16x8 (&pb)[4], unsigned w0, unsigned w1) {
    float a = __builtin_fmaxf(__builtin_fmaxf(p0[0], p0[1]), p1[0]), b = __builtin_fmaxf(__builtin_fmaxf(p0[2], p0[3]), p1[1]);
    a = __builtin_fmaxf(__builtin_fmaxf(a, p1[2]), p1[3]);
#pragma unroll
    for (int r = 4; r < 16; r += 4) { a = __builtin_fmaxf(__builtin_fmaxf(a, p0[r]), p0[r + 1]); b = __builtin_fmaxf(__builtin_fmaxf(b, p0[r + 2]), p0[r + 3]);
                                      a = __builtin_fmaxf(__builtin_fmaxf(a, p1[r]), p1[r + 1]); b = __builtin_fmaxf(__builtin_fmaxf(b, p1[r + 2]), p1[r + 3]); }
    float rm = __builtin_fmaxf(a, b);
    { auto rr = __builtin_amdgcn_permlane32_swap(__float_as_uint(rm), __float_as_uint(rm), false, false); rm = __builtin_fmaxf(__uint_as_float(rr[0]), __uint_as_float(rr[1])); }
    const bool seen = rm > -1e30f;
    const bool need = (rm - st.mref > SM_THR) || (!st.valid && seen);
    st.valid = st.valid || seen;
    if (__ballot(need) != 0ull) {
        const float mnew = need ? rm : st.mref;
        const float f = fast_exp2(st.mref - mnew);
        st.mref = mnew;
        st.l *= f;
#pragma unroll
        for (int db = 0; db < NDB; ++db)
#pragma unroll
            for (int r = 0; r < 16; ++r) o[db][r] *= f;
    }
    float sum = 0.0f;
    const float mr = (PMASK == 2 && w0 == 0u) ? INFINITY : st.mref;
#pragma unroll
    for (int ks = 0; ks < 4; ++ks) {
        float e[8];
#pragma unroll
        for (int k = 0; k < 8; ++k) {
            const int r = 8 * (ks & 1) + k; const int bit = 16 * (r >> 3) + (r & 7);
            float v = fast_exp2((ks < 2 ? p0[r] : p1[r]) - mr);
            if (PMASK == 1) v = __uint_as_float(__float_as_uint(v) & (unsigned)__builtin_amdgcn_sbfe((int)(ks < 2 ? w0 : w1), bit, 1));
            e[k] = v; sum += v;
        }
        u32x4 w; w.x = pk2(e[0], e[1]); w.y = pk2(e[2], e[3]); w.z = pk2(e[4], e[5]); w.w = pk2(e[6], e[7]);
        pb[ks] = __builtin_bit_cast(bf16x8, w);
    }
    st.l += sum;
}
template <int NDB> __device__ __forceinline__ void pv_tile(f32x16 (&o)[NDB], const bf16x8 (&pb)[4], const LAS unsigned char* Vt, int voff) {
    constexpr int NS = 4 * NDB;
    bf16x8 vf[2][2];
#define VF_LD(s_) (*(const LAS bf16x8*)(Vt + voff + ((s_) % NDB) * 32 * KP + ((s_) / NDB) * 32))
    vf[0][0] = VF_LD(0); vf[0][1] = VF_LD(1);
#pragma unroll
    for (int s_ = 0; s_ < NS; s_ += 2) {
        const int cur = (s_ >> 1) & 1;
        if (s_ + 2 < NS) { vf[cur ^ 1][0] = VF_LD(s_ + 2); vf[cur ^ 1][1] = VF_LD(s_ + 3); }
        o[s_ % NDB] = mfma32(vf[cur][0], pb[s_ / NDB], o[s_ % NDB]);
        o[(s_ + 1) % NDB] = mfma32(vf[cur][1], pb[(s_ + 1) / NDB], o[(s_ + 1) % NDB]);
    }
#undef VF_LD
}
#define LDS_BAR() asm volatile("s_waitcnt lgkmcnt(0)\n\ts_barrier" ::: "memory")
template <int NK, int NV, int PMASK, class MaskF>
__device__ __forceinline__ void flash_run(LAS unsigned char* lds, const bf16_t* const (&ksrc)[NK], size_t ktile, const bf16_t* const (&vsrc)[NV], int NT, int nact, int ksel,
                                          const bf16x8 (&qr)[4], const MaskF& maskf, f32x16 (&o)[2 * NV], float& l_out, int tid, int r32, int hi) {
    constexpr int KB = NK * KT_BYTES, VB = NV * KT_BYTES, VBASE = 2 * KB;
    const int srow = tid >> 3, sch = tid & 7, sdst = srow * KP + sch * 16;
    const int koff = pi32(r32) * KP + hi * 16 + ksel * KT_BYTES, voff = r32 * KP + hi * 16;
    u32x4 kreg[2][NK], vreg[2][NV];
#pragma unroll
    for (int i = 0; i < NK; ++i) { kreg[0][i] = *(const u32x4*)ksrc[i]; *(LAS u32x4*)(lds + i * KT_BYTES + sdst) = kreg[0][i]; }
    if (NT > 1) {
#pragma unroll
        for (int i = 0; i < NK; ++i) { kreg[0][i] = *(const u32x4*)(ksrc[i] + ktile); *(LAS u32x4*)(lds + KB + i * KT_BYTES + sdst) = kreg[0][i]; } }
#pragma unroll
    for (int i = 0; i < NV; ++i) { vreg[0][i] = *(const u32x4*)vsrc[i]; *(LAS u32x4*)(lds + VBASE + i * KT_BYTES + sdst) = vreg[0][i]; }
    if (NT > 2) {
#pragma unroll
        for (int i = 0; i < NK; ++i) kreg[1][i] = *(const u32x4*)(ksrc[i] + 2 * ktile); }
    if (NT > 1) {
#pragma unroll
        for (int i = 0; i < NV; ++i) vreg[1][i] = *(const u32x4*)(vsrc[i] + 64); }
    LDS_BAR();
    SoftState st; st.mref = 0.0f; st.l = 0.0f; st.valid = false;
    f32x16 s0, s1, u0, u1;
    if (nact > 0) { qk_tile(s0, s1, lds, qr, koff); maskf.pre(s0, s1, 0); }
#define FLASH_STEP(t, LD, ST, C0, C1, N0, N1) do { \
        if ((t) + 3 < NT) { _Pragma("unroll") for (int i = 0; i < NK; ++i) kreg[LD][i] = *(const u32x4*)(ksrc[i] + (size_t)((t) + 3) * ktile); } \
        if ((t) + 2 < NT) { _Pragma("unroll") for (int i = 0; i < NV; ++i) vreg[LD][i] = *(const u32x4*)(vsrc[i] + ((t) + 2) * 64); } \
        if ((t) < nact) { \
            bf16x8 pb[4]; unsigned w0 = 0u, w1 = 0u; \
            if (PMASK) maskf.pbits((t), w0, w1); \
            softmax_tile<2 * NV, PMASK>(C0, C1, st, o, pb, w0, w1); \
            if ((t) + 1 < nact) { qk_tile(N0, N1, lds + (((t) + 1) & 1) * KB, qr, koff); maskf.pre(N0, N1, (t) + 1); } \
            pv_tile<2 * NV>(o, pb, lds + VBASE + ((t) & 1) * VB, voff); \
        } \
        if ((t) + 2 < NT) { _Pragma("unroll") for (int i = 0; i < NK; ++i) *(LAS u32x4*)(lds + ((t) & 1) * KB + i * KT_BYTES + sdst) = kreg[ST][i]; } \
        if ((t) + 1 < NT) { _Pragma("unroll") for (int i = 0; i < NV; ++i) *(LAS u32x4*)(lds + VBASE + (((t) + 1) & 1) * VB + i * KT_BYTES + sdst) = vreg[ST][i]; } \
        LDS_BAR(); \
    } while (0)
    int t = 0;
    for (; t + 1 < NT; t += 2) { FLASH_STEP(t, 0, 1, s0, s1, u0, u1); FLASH_STEP(t + 1, 1, 0, u0, u1, s0, s1); }
    if (t < NT) FLASH_STEP(t, 0, 1, s0, s1, u0, u1);
#undef FLASH_STEP
    asm volatile("s_waitcnt vmcnt(0)" ::: "memory");
    l_out = st.l;
}
__device__ __forceinline__ void causal_mask(f32x16& p0, f32x16& p1, int kb, int q, int hi) {
#pragma unroll
    for (int r = 0; r < 16; ++r) { const int key = kb + 16 * (r >> 3) + 8 * hi + (r & 7); if (key > q) p0[r] = NEG; if (key + 32 > q) p1[r] = NEG; }
}
__device__ __forceinline__ void store_pair16(bf16_t* dst, u32x2 a, u32x2 b, int hi) {
    { auto r = __builtin_amdgcn_permlane32_swap(a.x, b.x, false, false); a.x = r[0]; b.x = r[1]; }
    { auto r = __builtin_amdgcn_permlane32_swap(a.y, b.y, false, false); a.y = r[0]; b.y = r[1]; }
    u32x4 w; w.x = a.x; w.y = a.y; w.z = b.x; w.w = b.y;
    *(u32x4*)(dst + 8 * hi) = w;
}
template <int NDB> __device__ __forceinline__ void store_o(const f32x16 (&o)[NDB], float inv, bf16_t* dst, int hi) {
#pragma unroll
    for (int db = 0; db < NDB; ++db)
#pragma unroll
        for (int g = 0; g < 4; g += 2) {
            u32x2 a, b;
            a.x = pk2(o[db][4 * g] * inv, o[db][4 * g + 1] * inv); a.y = pk2(o[db][4 * g + 2] * inv, o[db][4 * g + 3] * inv);
            b.x = pk2(o[db][4 * g + 4] * inv, o[db][4 * g + 5] * inv); b.y = pk2(o[db][4 * g + 6] * inv, o[db][4 * g + 7] * inv);
            store_pair16(dst + 32 * db + 8 * g, a, b, hi);
        }
}

__device__ __forceinline__ void moba_unit(const bf16_t* QB, const bf16_t* KB, const bf16_t* VBT, const float* kmean, bf16_t* OB, LAS unsigned char* lds, int b, int h, int j) {
    const int tid = fresh_tid(), lane = tid & 63, r32 = lane & 31, hi = lane >> 5, wid = __builtin_amdgcn_readfirstlane(tid >> 6);
    const size_t tok0 = (size_t)b * SEQ;
    const int q = 256 * j + 32 * wid + r32;
    bf16x8 qr[4];
    { const bf16_t* qp = QB + (tok0 + q) * 256 + h * 64 + hi * 8;
#pragma unroll
      for (int d0 = 0; d0 < 4; ++d0) qr[d0] = *(const bf16x8*)(qp + d0 * 16); }
    unsigned sel = 0u;
    if (j > 0) {
        if (j <= 3) sel = (1u << j) - 1u;
        else {
            float gate[7];
#pragma unroll
            for (int n = 0; n < 7; ++n) {
                gate[n] = NEG;
                if (n < j) {
                    const float* km = kmean + ((size_t)(b * 4 + h) * 8 + n) * 128 + hi * 8; float s = 0.0f;
#pragma unroll
                    for (int d0 = 0; d0 < 4; ++d0) { const f32x4 a = *(const f32x4*)(km + d0 * 16) + *(const f32x4*)(km + 64 + d0 * 16), c = *(const f32x4*)(km + d0 * 16 + 4) + *(const f32x4*)(km + 64 + d0 * 16 + 4);
#pragma unroll
                        for (int e = 0; e < 4; ++e) { s += bf2f((unsigned short)qr[d0][e]) * a[e]; s += bf2f((unsigned short)qr[d0][4 + e]) * c[e]; } }
                    s += __shfl_xor(s, 32); gate[n] = s;
                }
            }
#pragma unroll
            for (int it = 0; it < 3; ++it) { float best = 0.0f; int bi = -1;
#pragma unroll
                for (int n = 0; n < 7; ++n) { if (n < j && !((sel >> n) & 1u) && (bi < 0 || gate[n] > best)) { best = gate[n]; bi = n; } }
                sel |= 1u << bi; }
        }
    }
    const int NT = 4 * (j + 1);
    const int srow = tid >> 3, sch = tid & 7;
    const bf16_t* const ksrc[1] = {KB + (tok0 + srow) * 256 + h * 64 + sch * 8};
    const bf16_t* const vsrc[1] = {VBT + ((size_t)(b * 4 + h) * 64 + srow) * SEQ + sch * 8};
    f32x16 o[2]; float l = 0.0f;
#pragma unroll
    for (int db = 0; db < 2; ++db)
#pragma unroll
        for (int r = 0; r < 16; ++r) o[db][r] = 0.0f;
    const int qmin = 256 * j + 32 * wid;
    struct MaskMoba { unsigned sel; int j, qmin, q, hi;
        __device__ __forceinline__ void pre(f32x16& p0, f32x16& p1, int t) const { const int kb = 64 * t; if ((t >> 2) >= j && kb + 63 > qmin) causal_mask(p0, p1, kb, q, hi); }
        __device__ __forceinline__ void pbits(int t, unsigned& w0, unsigned& w1) const { const int blk = t >> 2; const unsigned m_ = (blk >= j || ((sel >> blk) & 1u)) ? 0xffffffffu : 0u; w0 = m_; w1 = m_; } };
    const MaskMoba maskf{sel, j, qmin, q, hi};
    flash_run<1, 1, 2>(lds, ksrc, (size_t)64 * 256, vsrc, NT, (qmin + 31) / 64 + 1, 0, qr, maskf, o, l, tid, r32, hi);
    l += __shfl_xor(l, 32);
    store_o<2>(o, 1.0f / l, OB + (tok0 + q) * 256 + h * 64, hi);
}

__device__ __forceinline__ void diff_unit(const bf16_t* QC, const bf16_t* KC, const bf16_t* VCT, bf16_t* OC, LAS unsigned char* lds, int b, int h, int qblk, float lam, float outscale, const float* subg) {
    const int tid = fresh_tid(), lane = tid & 63, r32 = lane & 31, hi = lane >> 5, wid = __builtin_amdgcn_readfirstlane(tid >> 6);
    const int cmp = wid & 1, sub = wid >> 1;
    const size_t tok0 = (size_t)b * SEQ;
    const int q = 128 * qblk + 32 * sub + r32;
    bf16x8 qr[4];
    { const bf16_t* qp = QC + (tok0 + q) * 512 + (2 * h + cmp) * 64 + hi * 8;
#pragma unroll
      for (int d0 = 0; d0 < 4; ++d0) qr[d0] = *(const bf16x8*)(qp + d0 * 16); }
    const int NT = 2 * (qblk + 1);
    const int srow = tid >> 3, sch = tid & 7;
    const bf16_t* const k0p = KC + (tok0 + srow) * 512 + (2 * h) * 64 + sch * 8;
    const bf16_t* const v0p = VCT + ((size_t)(b * 4 + h) * 128 + srow) * SEQ + sch * 8;
    const bf16_t* const ksrc[2] = {k0p, k0p + 64};
    const bf16_t* const vsrc[2] = {v0p, v0p + (size_t)64 * SEQ};
    f32x16 o[4]; float l = 0.0f;
#pragma unroll
    for (int db = 0; db < 4; ++db)
#pragma unroll
        for (int r = 0; r < 16; ++r) o[db][r] = 0.0f;
    const int qmin = 128 * qblk + 32 * sub;
    struct MaskCausal { int qmin, q, hi;
        __device__ __forceinline__ void pre(f32x16& p0, f32x16& p1, int t) const { const int kb = 64 * t; if (kb + 63 > qmin) causal_mask(p0, p1, kb, q, hi); }
        __device__ __forceinline__ void pbits(int, unsigned&, unsigned&) const {} };
    const MaskCausal maskf{qmin, q, hi};
    for (int repd = 0; repd < 1 + (DIFF_REP & 1); ++repd) {
        if (repd) {
#pragma unroll
            for (int db = 0; db < 4; ++db)
#pragma unroll
                for (int r = 0; r < 16; ++r) o[db][r] = 0.0f; }
        flash_run<2, 2, 0>(lds, ksrc, (size_t)64 * 512, vsrc, NT, (qmin + 31) / 64 + 1, cmp, qr, maskf, o, l, tid, r32, hi);
    }
    l += __shfl_xor(l, 32);
    const float inv = 1.0f / l;
    LAS float* xch = (LAS float*)lds + (size_t)sub * 64 * 64 + lane;
    if (cmp == 1) {
#pragma unroll
        for (int db = 0; db < 4; ++db)
#pragma unroll
            for (int r = 0; r < 16; ++r) xch[(db * 16 + r) * 64] = o[db][r] * inv;
    }
    __syncthreads();
    if (cmp == 0) {
        float ss = 0.0f;
#pragma unroll
        for (int db = 0; db < 4; ++db)
#pragma unroll
            for (int r = 0; r < 16; ++r) { const float v = o[db][r] * inv - lam * xch[(db * 16 + r) * 64]; o[db][r] = v; ss += v * v; }
        ss += __shfl_xor(ss, 32);
        const float rstd = rsqrtf(ss * (1.0f / 128.0f) + EPS) * outscale;
        bf16_t* dst = OC + (size_t)(h >> 1) * T * 256 + (tok0 + q) * 256 + (h & 1) * 128;
#pragma unroll
        for (int db = 0; db < 4; ++db)
#pragma unroll
            for (int g = 0; g < 4; g += 2) { const int d = 32 * db + 8 * g + 4 * hi; const f32x4 sg = *(const f32x4*)(subg + d), sh = *(const f32x4*)(subg + d + 8);
                u32x2 a, b; a.x = pk2(o[db][4 * g] * rstd * sg[0], o[db][4 * g + 1] * rstd * sg[1]); a.y = pk2(o[db][4 * g + 2] * rstd * sg[2], o[db][4 * g + 3] * rstd * sg[3]);
                b.x = pk2(o[db][4 * g + 4] * rstd * sh[0], o[db][4 * g + 5] * rstd * sh[1]); b.y = pk2(o[db][4 * g + 6] * rstd * sh[2], o[db][4 * g + 7] * rstd * sh[3]);
                store_pair16(dst + 32 * db + 8 * g, a, b, hi); }
    }
    __syncthreads();
}

__device__ __forceinline__ unsigned f2key(float v) { unsigned b = __float_as_uint(v); if ((b << 1) == 0u) b = 0u; return (b & 0x80000000u) ? ~b : (b | 0x80000000u); }
__device__ __forceinline__ float key2f(unsigned k) { return (k & 0x80000000u) ? __uint_as_float(k & 0x7fffffffu) : __uint_as_float(~k); }
#define ROR_(v, n) ((unsigned)__builtin_amdgcn_update_dpp(0, (int)(v), 0x120 + (n), 0xf, 0xf, false))
__device__ __forceinline__ unsigned wave_max_u32(unsigned v) {
    v = max(v, ROR_(v, 1)); v = max(v, ROR_(v, 2)); v = max(v, ROR_(v, 4)); v = max(v, ROR_(v, 8));
    { auto r = __builtin_amdgcn_permlane16_swap(v, v, false, false); v = max((unsigned)r[0], (unsigned)r[1]); }
    { auto r = __builtin_amdgcn_permlane32_swap(v, v, false, false); v = max((unsigned)r[0], (unsigned)r[1]); }
    return v;
}
__device__ __forceinline__ unsigned wave_min_u32(unsigned v) { return ~wave_max_u32(~v); }
__device__ __forceinline__ unsigned wave_add_u32(unsigned v) {
    v += ROR_(v, 1); v += ROR_(v, 2); v += ROR_(v, 4); v += ROR_(v, 8);
    { auto r = __builtin_amdgcn_permlane16_swap(v, v, false, false); v = (unsigned)r[0] + (unsigned)r[1]; }
    { auto r = __builtin_amdgcn_permlane32_swap(v, v, false, false); v = (unsigned)r[0] + (unsigned)r[1]; }
    return v;
}
__device__ __forceinline__ int count_ge(const unsigned (&u)[32], unsigned thr, int ng) {
    int c = 0;
#pragma unroll
    for (int g = 0; g < 4; ++g) if (g < ng) {
        unsigned long long m0, m1, m2, m3, m4, m5, m6, m7;
        asm("v_cmp_ge_u32_e64 %0, %8, %16\n\tv_cmp_ge_u32_e64 %1, %9, %16\n\tv_cmp_ge_u32_e64 %2, %10, %16\n\tv_cmp_ge_u32_e64 %3, %11, %16\n\t"
            "v_cmp_ge_u32_e64 %4, %12, %16\n\tv_cmp_ge_u32_e64 %5, %13, %16\n\tv_cmp_ge_u32_e64 %6, %14, %16\n\tv_cmp_ge_u32_e64 %7, %15, %16"
            : "=&s"(m0), "=&s"(m1), "=&s"(m2), "=&s"(m3), "=&s"(m4), "=&s"(m5), "=&s"(m6), "=&s"(m7)
            : "v"(u[8 * g]), "v"(u[8 * g + 1]), "v"(u[8 * g + 2]), "v"(u[8 * g + 3]), "v"(u[8 * g + 4]), "v"(u[8 * g + 5]), "v"(u[8 * g + 6]), "v"(u[8 * g + 7]), "v"(thr));
        c += (__popcll(m0) + __popcll(m1)) + (__popcll(m2) + __popcll(m3)) + (__popcll(m4) + __popcll(m5)) + (__popcll(m6) + __popcll(m7));
    }
    return c;
}
__device__ __forceinline__ unsigned pick_mid(unsigned lo, unsigned hi, int clo, int chi, int it) {
    const unsigned span = hi - lo;
    const float flo = key2f(lo << 16), fhi = key2f(((hi - 1u) << 16) | 0xffffu);
    const float fr = (it & 1) ? 0.5f : ((float)(clo - 256) - 0.5f) * fast_rcp((float)(clo - chi));
    unsigned mid = f2key(flo + fr * (fhi - flo)) >> 16;
    if ((it & 1) && it >= 8) mid = lo + (span >> 1);
    if (mid <= lo || mid >= hi) mid = lo + (span >> 1);
    return mid;
}
#define WRITELANE2(lo_, hi_, bal_, i_) asm("s_nop 1\n\tv_writelane_b32 %0, %2, %4\n\tv_writelane_b32 %1, %3, %4" : "+v"(lo_), "+v"(hi_) : "s"((unsigned)(bal_)), "s"((unsigned)((bal_) >> 32)), "n"(i_))
__device__ __forceinline__ void write_mask_row(const unsigned (&u)[32], unsigned thr, int clo, int ng, LAS unsigned* bm, int lane) {
    int wlo = 0, whi = 0;
    if (clo == 256) {
#pragma unroll
        for (int i = 0; i < 32; ++i) { const unsigned long long bal = __ballot(u[i] >= thr); WRITELANE2(wlo, whi, bal, i); }
    } else {
        const int need = 256 - count_ge(u, thr + 1u, ng);
        int run = 0; const unsigned long long below = (1ull << lane) - 1ull;
#pragma unroll
        for (int i = 0; i < 32; ++i) {
            const unsigned long long eq = __ballot(u[i] == thr); const int rank = run + __popcll(eq & below);
            const unsigned long long bal = __ballot(u[i] > thr || (u[i] == thr && rank < need)); run += __popcll(eq);
            WRITELANE2(wlo, whi, bal, i);
        }
    }
    if (lane < 32) { u32x2 w; w.x = (unsigned)wlo; w.y = (unsigned)whi; *(LAS u32x2*)(bm + 2 * lane) = w; }
}
__device__ __forceinline__ void compact_row(const unsigned (&u)[32], unsigned lo, unsigned hi, int ng, LAS unsigned* scr, int lane, unsigned& c0, unsigned& c1) {
    int base = 0;
#pragma unroll
    for (int g = 0; g < 4; ++g) if (g < ng) {
#pragma unroll
        for (int i = 8 * g; i < 8 * g + 8; ++i) {
            const bool inb = u[i] >= lo && u[i] < hi;
            const unsigned long long bal = __ballot(inb);
            const int pos = base + (int)__builtin_amdgcn_mbcnt_hi((unsigned)(bal >> 32), __builtin_amdgcn_mbcnt_lo((unsigned)bal, 0u));
            if (inb) scr[pos] = u[i];
            base += __popcll(bal);
        }
    }
    asm volatile("s_waitcnt lgkmcnt(0)" ::: "memory");
    c0 = lane < base ? scr[lane] : 0u; c1 = 64 + lane < base ? scr[64 + lane] : 0u;
}
__device__ __forceinline__ void select_rows2(const unsigned (&va)[32], const unsigned (&vb)[32], int ta, int tb, LAS unsigned* bma, LAS unsigned* bmb, LAS unsigned* scr, int lane) {
    const int na = ta + 1, nb = tb + 1;
    if (nb <= 256) {
        const int ca = na - 32 * lane, cb = nb - 32 * lane;
        bma[lane] = ca >= 32 ? 0xffffffffu : (ca <= 0 ? 0u : ((1u << ca) - 1u)); bmb[lane] = cb >= 32 ? 0xffffffffu : (cb <= 0 ? 0u : ((1u << cb) - 1u)); return; }
    const int ng = (nb + 511) >> 9;
    unsigned ua[32], ub[32];
    unsigned mxa = 0u, mna = 0xffffffffu, mxb = 0u, mnb = 0xffffffffu;
#pragma unroll
    for (int i = 0; i < 32; ++i) { const bool oka = 64 * i + lane <= ta, okb = 64 * i + lane <= tb; ua[i] = oka ? va[i] : 0u; ub[i] = okb ? vb[i] : 0u;
        mxa = max(mxa, ua[i]); mna = min(mna, oka ? va[i] : 0xffffffffu); mxb = max(mxb, ub[i]); mnb = min(mnb, okb ? vb[i] : 0xffffffffu); }
    mxa = (unsigned)__builtin_amdgcn_readfirstlane((int)wave_max_u32(mxa)); mna = (unsigned)__builtin_amdgcn_readfirstlane((int)wave_min_u32(mna));
    mxb = (unsigned)__builtin_amdgcn_readfirstlane((int)wave_max_u32(mxb)); mnb = (unsigned)__builtin_amdgcn_readfirstlane((int)wave_min_u32(mnb));
    unsigned loa = mna, hia = mxa + 1u, lob = mnb, hib = mxb + 1u;
    int cloa = na, chia = 0, clob = nb, chib = 0;
    bool acta = na > 256, actb = true;
    int it = 0;
    for (; it < 96 && ((acta && cloa - chia > 128) || (actb && clob - chib > 128)); ++it) {
        const unsigned mida = acta ? pick_mid(loa, hia, cloa, chia, it) : loa, midb = actb ? pick_mid(lob, hib, clob, chib, it) : lob;
        int ca = 0, cb = 0;
#pragma unroll
        for (int g = 0; g < 4; ++g) if (g < ng) {
            unsigned long long m0, m1, m2, m3, m4, m5, m6, m7, q0, q1, q2, q3, q4, q5, q6, q7;
            asm("v_cmp_ge_u32_e64 %0, %8, %16\n\tv_cmp_ge_u32_e64 %1, %9, %16\n\tv_cmp_ge_u32_e64 %2, %10, %16\n\tv_cmp_ge_u32_e64 %3, %11, %16\n\t"
                "v_cmp_ge_u32_e64 %4, %12, %16\n\tv_cmp_ge_u32_e64 %5, %13, %16\n\tv_cmp_ge_u32_e64 %6, %14, %16\n\tv_cmp_ge_u32_e64 %7, %15, %16"
                : "=&s"(m0), "=&s"(m1), "=&s"(m2), "=&s"(m3), "=&s"(m4), "=&s"(m5), "=&s"(m6), "=&s"(m7)
                : "v"(ua[8 * g]), "v"(ua[8 * g + 1]), "v"(ua[8 * g + 2]), "v"(ua[8 * g + 3]), "v"(ua[8 * g + 4]), "v"(ua[8 * g + 5]), "v"(ua[8 * g + 6]), "v"(ua[8 * g + 7]), "v"(mida));
            asm("v_cmp_ge_u32_e64 %0, %8, %16\n\tv_cmp_ge_u32_e64 %1, %9, %16\n\tv_cmp_ge_u32_e64 %2, %10, %16\n\tv_cmp_ge_u32_e64 %3, %11, %16\n\t"
                "v_cmp_ge_u32_e64 %4, %12, %16\n\tv_cmp_ge_u32_e64 %5, %13, %16\n\tv_cmp_ge_u32_e64 %6, %14, %16\n\tv_cmp_ge_u32_e64 %7, %15, %16"
                : "=&s"(q0), "=&s"(q1), "=&s"(q2), "=&s"(q3), "=&s"(q4), "=&s"(q5), "=&s"(q6), "=&s"(q7)
                : "v"(ub[8 * g]), "v"(ub[8 * g + 1]), "v"(ub[8 * g + 2]), "v"(ub[8 * g + 3]), "v"(ub[8 * g + 4]), "v"(ub[8 * g + 5]), "v"(ub[8 * g + 6]), "v"(ub[8 * g + 7]), "v"(midb));
            ca += (__popcll(m0) + __popcll(m1)) + (__popcll(m2) + __popcll(m3)) + (__popcll(m4) + __popcll(m5)) + (__popcll(m6) + __popcll(m7));
            cb += (__popcll(q0) + __popcll(q1)) + (__popcll(q2) + __popcll(q3)) + (__popcll(q4) + __popcll(q5)) + (__popcll(q6) + __popcll(q7));
        }
        if (acta) { if (ca >= 256) { loa = mida; cloa = ca; } else { hia = mida; chia = ca; } acta = ca != 256 && hia - loa > 1u; }
        if (actb) { if (cb >= 256) { lob = midb; clob = cb; } else { hib = midb; chib = cb; } actb = cb != 256 && hib - lob > 1u; }
    }
    if (acta || actb) {
        unsigned a0 = 0u, a1 = 0u, b0 = 0u, b1 = 0u;
        const int basea = chia, baseb = chib;
        if (acta) compact_row(ua, loa, hia, ng, scr, lane, a0, a1);
        if (actb) compact_row(ub, lob, hib, ng, scr + 128, lane, b0, b1);
        for (; it < 200 && (acta || actb); ++it) {
            const unsigned mida = acta ? pick_mid(loa, hia, cloa, chia, it) : loa, midb = actb ? pick_mid(lob, hib, clob, chib, it) : lob;
            const int ca = basea + __popcll(__ballot(a0 >= mida)) + __popcll(__ballot(a1 >= mida));
            const int cb = baseb + __popcll(__ballot(b0 >= midb)) + __popcll(__ballot(b1 >= midb));
            if (acta) { if (ca >= 256) { loa = mida; cloa = ca; } else { hia = mida; chia = ca; } acta = ca != 256 && hia - loa > 1u; }
            if (actb) { if (cb >= 256) { lob = midb; clob = cb; } else { hib = midb; chib = cb; } actb = cb != 256 && hib - lob > 1u; }
        }
    }
    if (na <= 256) { const int c = na - 32 * lane; bma[lane] = c >= 32 ? 0xffffffffu : (c <= 0 ? 0u : ((1u << c) - 1u)); }
    else write_mask_row(ua, loa, cloa, ng, bma, lane);
    write_mask_row(ub, lob, clob, ng, bmb, lane);
}

__device__ __forceinline__ void dsa_unit(const bf16_t* QA, const bf16_t* KA, const bf16_t* VAT, const bf16_t* QI, const bf16_t* KI, const float* WI, float* strip, bf16_t* OA,
                                         LAS unsigned char* lds, int b, int qblk) {
    const int tid = fresh_tid(), lane = tid & 63, r32 = lane & 31, hi = lane >> 5, wid = __builtin_amdgcn_readfirstlane(tid >> 6);
    const size_t tok0 = (size_t)b * SEQ;
    constexpr int BM_OFF = 4 * KT_BYTES;
    constexpr int QI_OFF = BM_OFF + 64 * 256, QI_PITCH = 1040, WI_OFF = QI_OFF + 32 * QI_PITCH, SCR_OFF = WI_OFF + 1024;
    LAS unsigned* bm = (LAS unsigned*)(lds + BM_OFF);
    constexpr int SR1_OFF = 0, SR2_OFF = SCR_OFF + 8192, SR_PITCH = 1032;
    static_assert(32 * SR_PITCH <= 4 * KT_BYTES && SR2_OFF + 32 * SR_PITCH <= 131072, "LDS strip segments");
    for (int s = 0; s < 2; ++s) {
        const int qt = 2 * qblk + s;
        {
            { const int row = tid >> 4, ch = tid & 15;
              const u32x4* src = (const u32x4*)(QI + (tok0 + 32 * qt + row) * 512 + ch * 32);
              LAS u32x4* dq = (LAS u32x4*)(lds + QI_OFF + row * QI_PITCH + ch * 64);
              const u32x4 a0 = src[0], a1 = src[1], a2 = src[2], a3 = src[3]; dq[0] = a0; dq[1] = a1; dq[2] = a2; dq[3] = a3; }
            if (tid < 256) { const int row = tid >> 3, hh = tid & 7; ((LAS float*)(lds + WI_OFF))[row * 8 + hh] = WI[(tok0 + 32 * qt + row) * 8 + hh]; }
            __syncthreads();
            const LAS unsigned char* qb = lds + QI_OFF + r32 * QI_PITCH + hi * 16;
            const LAS float* wl = (const LAS float*)(lds + WI_OFF) + r32 * 8;
            for (int rep1 = 0; rep1 < 1 + (DSA_REP & 1); ++rep1) {
            bf16x8 kfn[4];
            if (wid <= qt) {
#pragma unroll
                for (int d0 = 0; d0 < 4; ++d0) kfn[d0] = *(const bf16x8*)(KI + (tok0 + 32 * wid + r32) * 64 + d0 * 16 + hi * 8); }
            for (int kt = wid; kt <= qt; kt += NWAVES) {
                bf16x8 kf[4];
#pragma unroll
                for (int d0 = 0; d0 < 4; ++d0) kf[d0] = kfn[d0];
                if (kt + NWAVES <= qt) {
#pragma unroll
                    for (int d0 = 0; d0 < 4; ++d0) kfn[d0] = *(const bf16x8*)(KI + (tok0 + 32 * (kt + NWAVES) + r32) * 64 + d0 * 16 + hi * 8); }
                f32x16 isc;
#pragma unroll
                for (int r = 0; r < 16; ++r) isc[r] = 0.0f;
#pragma unroll 1
                for (int hh = 0; hh < 8; ++hh) {
                    f32x16 lg;
#pragma unroll
                    for (int r = 0; r < 16; ++r) lg[r] = 0.0f;
#pragma unroll
                    for (int d0 = 0; d0 < 4; ++d0) { const bf16x8 qf = *(const LAS bf16x8*)(qb + hh * 128 + d0 * 32); lg = mfma32(kf[d0], qf, lg); }
                    const float w = wl[hh];
#pragma unroll
                    for (int r = 0; r < 16; ++r) isc[r] += __int_as_float(max(__float_as_int(lg[r]), 0)) * w;
                }
                unsigned short* sp = (unsigned short*)strip + (size_t)r32 * SEQ + 32 * kt + 4 * hi;
                LAS unsigned char* sl = lds + (kt < 16 ? SR1_OFF : SR2_OFF) + r32 * SR_PITCH + (32 * (kt & 15) + 4 * hi) * 2;
#pragma unroll
                for (int g = 0; g < 4; ++g) { u32x2 w;
                    w.x = (f2key(isc[4 * g]) >> 16) | (f2key(isc[4 * g + 1]) & 0xffff0000u); w.y = (f2key(isc[4 * g + 2]) >> 16) | (f2key(isc[4 * g + 3]) & 0xffff0000u);
                    if (kt < 32) *(LAS u32x2*)(sl + 16 * g) = w; else *(u32x2*)(sp + 8 * g) = w; }
            }
            }
        }
        asm volatile("s_waitcnt vmcnt(0)" ::: "memory");
        __syncthreads();
        for (int rep2 = 0; rep2 < 1 + ((DSA_REP >> 1) & 1); ++rep2) {
#pragma unroll 1
            for (int rp = 0; rp < 2; ++rp) {
                unsigned v2[2][32];
#pragma unroll
                for (int rr = 0; rr < 2; ++rr) {
                    const int row = wid + 8 * (2 * rp + rr);
                    const LAS unsigned short* l1 = (const LAS unsigned short*)(lds + SR1_OFF + row * SR_PITCH) + lane;
                    const LAS unsigned short* l2 = (const LAS unsigned short*)(lds + SR2_OFF + row * SR_PITCH) + lane;
                    const unsigned short* gp = (const unsigned short*)strip + (size_t)row * SEQ + lane;
#pragma unroll
                    for (int i = 0; i < 8; ++i) { v2[rr][i] = l1[64 * i]; v2[rr][8 + i] = l2[64 * i]; }
#pragma unroll
                    for (int i = 16; i < 24; ++i) v2[rr][i] = qt >= 32 ? (unsigned)gp[64 * i] : 0u;
#pragma unroll
                    for (int i = 24; i < 32; ++i) v2[rr][i] = qt >= 48 ? (unsigned)gp[64 * i] : 0u;
                }
                { const int ra = wid + 16 * rp, rb = ra + 8; select_rows2(v2[0], v2[1], 32 * qt + ra, 32 * qt + rb, bm + (32 * s + ra) * 64, bm + (32 * s + rb) * 64, (LAS unsigned*)(lds + SCR_OFF) + wid * 256, lane); }
            }
        }
        __syncthreads();
    }
    const int head = wid & 3, sub = wid >> 2;
    const int q = 64 * qblk + 32 * sub + r32;
    bf16x8 qr[4];
    { const bf16_t* qp = QA + (tok0 + q) * 256 + head * 64 + hi * 8;
#pragma unroll
      for (int d0 = 0; d0 < 4; ++d0) qr[d0] = *(const bf16x8*)(qp + d0 * 16); }
    const int NT = qblk + 1;
    const int srow = tid >> 3, sch = tid & 7;
    const bf16_t* const ksrc[1] = {KA + (tok0 + srow) * 64 + sch * 8};
    const bf16_t* const vsrc[1] = {VAT + ((size_t)b * 64 + srow) * SEQ + sch * 8};
    for (int rep3 = 0; rep3 < 1 + ((DSA_REP >> 2) & 1); ++rep3) {
    f32x16 o[2]; float l = 0.0f;
#pragma unroll
    for (int db = 0; db < 2; ++db)
#pragma unroll
        for (int r = 0; r < 16; ++r) o[db][r] = 0.0f;
    const LAS unsigned* bmq = bm + (32 * sub + r32) * 64;
    struct MaskBits { const LAS unsigned* bmq; int hi;
        __device__ __forceinline__ void pre(f32x16&, f32x16&, int) const {}
        __device__ __forceinline__ void pbits(int t, unsigned& w0, unsigned& w1) const { w0 = bmq[2 * t] >> (8 * hi); w1 = bmq[2 * t + 1] >> (8 * hi); } };
    const MaskBits maskf{bmq, hi};
    flash_run<1, 1, 1>(lds, ksrc, (size_t)64 * 64, vsrc, NT, NT, 0, qr, maskf, o, l, tid, r32, hi);
    l += __shfl_xor(l, 32);
    store_o<2>(o, 1.0f / l, OA + (tok0 + q) * 256 + head * 64, hi);
    }
}
}

__device__ __forceinline__ void phase_attention(const Ctx& c, LAS unsigned char* lds, int layer) {
    unsigned char* A = c.ws + WS_A;
    const bf16_t *QA = (const bf16_t*)(A + A_QA), *KA = (const bf16_t*)(A + A_KA), *VAT = (const bf16_t*)(A + A_VAT), *QI = (const bf16_t*)(A + A_QI), *KI = (const bf16_t*)(A + A_KI);
    const float* WI = (const float*)(A + A_WI);
    const bf16_t *QB = (const bf16_t*)(A + A_QB), *KB = (const bf16_t*)(A + A_KB), *VBT = (const bf16_t*)(A + A_VBT), *QC = (const bf16_t*)(A + A_QC), *KC = (const bf16_t*)(A + A_KC), *VCT = (const bf16_t*)(A + A_VCT);
    bf16_t *OA = (bf16_t*)((unsigned char*)c.out + DO_O), *OB = OA + (size_t)T * 256, *OC = OB + (size_t)T * 256;
    const float* kmean = (const float*)(c.ws + WS_CTL + CTL_KMEAN) + (size_t)layer * (16 * 4 * 8 * 2 * 64);
    float* strip = (float*)(c.ws + WS_G) + (size_t)blockIdx.x * 32 * SEQ;
    const int GW = gridDim.x, vcu = (GW % 8 == 0) ? ((int)blockIdx.x % 8) * (GW / 8) + (int)blockIdx.x / 8 : (int)blockIdx.x;

    if (ATT_MASK & 1) for (int rep = 0; rep < 1 + (ATT_REP & 1); ++rep) for (int w = vcu; w < 256; w += GW) {
        const int b = w >> 4, p = w & 15;
        for (int k = 0; k < 2; ++k) att::dsa_unit(QA, KA, VAT, QI, KI, WI, strip, OA, lds, b, k ? 31 - p : p);
    }
    if (ATT_MASK & 2) for (int rep = 0; rep < 1 + ((ATT_REP >> 1) & 1); ++rep) for (int w = vcu; w < 256; w += GW) {
        const int b = w >> 4, h = (w >> 2) & 3, jp = w & 3;
        for (int k = 0; k < 2; ++k) att::moba_unit(QB, KB, VBT, kmean, OB, lds, b, h, k ? 7 - jp : jp);
    }
    if (ATT_MASK & 4) {
        const float* lp = c.lam_p + (size_t)layer * 4 * 64; const int lane = fresh_tid() & 63;
        const float s1 = wave_sum(lp[lane] * lp[64 + lane]), s2 = wave_sum(lp[128 + lane] * lp[192 + lane]);
        const float lam_init = 0.8f - 0.6f * expf(-0.3f * (float)layer);
        const float lam = expf(s1) - expf(s2) + lam_init;
        const float* subg = c.subln_g + (size_t)layer * 128;
        for (int rep = 0; rep < 1 + ((ATT_REP >> 2) & 1); ++rep) for (int w = vcu; w < 512; w += GW) {
            const int b = w >> 5, h = (w >> 3) & 3, qp = w & 7;
            for (int k = 0; k < 2; ++k) att::diff_unit(QC, KC, VCT, OC, lds, b, h, k ? 15 - qp : qp, lam, 1.0f - lam_init, subg);
        }
    }
}

constexpr int RING_BYTES = 131072, MISC_OFF = RING_BYTES, GAIN_LDS_OFF = MISC_OFF + 1024, LDS_BYTES = 147456;
struct Args { const void* in[12]; float* out; unsigned char* ws; int ph_lo, ph_hi; };
static_assert(sizeof(Args) == 12 * 8 + 8 + 8 + 8, "Args has no padding");

__global__ void __launch_bounds__(NTHREADS, 2) hybrid_fwd(Args args) {
    extern __shared__ __attribute__((aligned(16))) unsigned char lds_raw[];
    LAS unsigned char* lds = (LAS unsigned char*)lds_raw;
    volatile LAS unsigned* MISC = (volatile LAS unsigned*)(lds + MISC_OFF);
    const int tid = threadIdx.x;
    if (tid < 64) MISC[tid] = 0u;
    __syncthreads();
    Ctx c;
    c.x_in = (const float*)args.in[0]; c.pos = (const int*)args.in[1]; c.norm_g = (const float*)args.in[2]; c.w_in = (const float*)args.in[3]; c.qk_g = (const float*)args.in[4];
    c.lam_p = (const float*)args.in[5]; c.subln_g = (const float*)args.in[6]; c.w_branch = (const float*)args.in[7]; c.w_out = (const float*)args.in[8];
    c.w_gate = (const float*)args.in[9]; c.w_up = (const float*)args.in[10]; c.w_down = (const float*)args.in[11];
    c.out = args.out; c.ws = args.ws;
    const int lo = args.ph_lo, hi = args.ph_hi;
    unsigned* ctl = (unsigned*)(c.ws + WS_CTL);
    XcdBarrier bar; bar.bar = ctl + CW_BAR; bar.x = 0u; bar.st = MISC + 8;
    if (hi - lo > 1) bar = xcd_barrier_post(ctl + CW_BAR, MISC + 8);
#ifndef PH_MASK
#define PH_MASK 0xffu
#endif
#define PHE(id) ((PH_MASK >> (id)) & 1u)
#ifndef REP_MASK
#define REP_MASK 0u
#endif
#define REPN(id) (1 + (int)((REP_MASK >> (id)) & 1u))
#define IN(k) (lo <= (k) && (k) < hi)
#define SEAM(k) do { if (lo <= (k) && (k) + 1 < hi) xcd_barrier(bar); } while (0)
    const int G = gridDim.x, cb = blockIdx.x;
#define LYR() ({ int l_ = layer; asm volatile("" : "+s"(l_)); l_; })
#define WSL() ({ __attribute__((address_space(1))) unsigned char* p_ = (__attribute__((address_space(1))) unsigned char*)c.ws; asm volatile("" : "+s"(p_)); (unsigned char*)p_; })
#define OUTL() ({ __attribute__((address_space(1))) unsigned char* p_ = (__attribute__((address_space(1))) unsigned char*)c.out; asm volatile("" : "+s"(p_)); (unsigned char*)p_; })
#define H8 ((signed char*)(WSL() + WS_H8))
#define SA ((float*)(WSL() + WS_CTL + CTL_SA))
#define XB ((bf16_t*)(WSL() + WS_XB))
#define ACT ((bf16_t*)(WSL() + WS_A))
#define MRG ((bf16_t*)(WSL() + WS_A))
#define GB (WSL() + WS_G)
#define OA ((bf16_t*)(OUTL() + DO_O))
#define H ((bf16_t*)(OUTL() + DO_H))

    if (IN(0) && PHE(0)) for (int rep = 0; rep < REPN(0); ++rep) { phase_prologue(c, lds); prologue_i8<0>(c, lds); }
    SEAM(0);
    for (int layer = 0; layer < 2; ++layer) {
        const int base = 1 + 11 * layer;
        bf16_t* WL = wlayer(c, layer);
        if (IN(base + 0) && PHE(1)) for (int rep = 0; rep < REPN(1); ++rep) { if (LYR() == 0) { prologue_i8<1>(c, lds); phase_norm<false, false, true>(c.x_in, H, H8, SA); } else phase_norm<true, false, true>(XB, H, H8, SA); }
        SEAM(base + 0);
        if (IN(base + 1) && PHE(2)) for (int rep = 0; rep < REPN(2); ++rep) { pg8::Gemm g{(const bf16_t*)H8, WL + WL_GU, T, 5632, D / 2}; pg8::StaticOrder S; S.init(T, 5632, G, cb);
            EpiSwigluI8 E{ACT, SA, (const float*)(c.ws + WS_CTL + CTL_CMAX) + (size_t)layer * CMAX_PER_LAYER};
            pg8::gemm_phase<EpiSwigluI8, pg8::StaticOrder, true, true, true>(lds, g, S, E); }
        SEAM(base + 1);
        if (IN(base + 2) && PHE(3)) { pg8::Gemm g{ACT, WL + WL_DN, T, D, DFF}; RevOrder S; S.init(T, D, G, cb);
            if (LYR() == 0) { EpiResid<false, true> E{c.x_in, XB, 0.5f}; pg8::gemm_phase<EpiResid<false, true>, RevOrder, true, true>(lds, g, S, E); }
            else { EpiResid<true, true> E{XB, XB, 0.5f}; pg8::gemm_phase<EpiResid<true, true>, RevOrder, true, true>(lds, g, S, E); } }
        SEAM(base + 2);
        if (IN(base + 3) && PHE(1)) for (int rep = 0; rep < REPN(1); ++rep) phase_norm<true, false, true>(XB, H, H8, SA);
        SEAM(base + 3);
        if (IN(base + 4) && PHE(4)) for (int rep = 0; rep < REPN(4); ++rep) { pg8::Gemm g{(const bf16_t*)H8, WL + WL_IN, T, NINP, D / 2}; pg8::StaticOrder S; S.init(T, NINP, G, cb);
            { const int t_ = fresh_tid(); if (t_ < 384) ((LAS float*)(lds + GAIN_LDS_OFF))[t_] = c.qk_g[(size_t)layer * 6 * 64 + t_];
              const float* cm_ = (const float*)(WSL() + WS_CTL + CTL_CMAX) + (size_t)layer * CMAX_PER_LAYER + 2 * 5632 + 3072;
              for (int i_ = t_; i_ < NINP; i_ += NTHREADS) ((LAS float*)(lds + GAIN_LDS_OFF + 1536))[i_] = cm_[i_] * (1.0f / 127.0f);
              __syncthreads(); }
            EpiInProjT<true> E{c.ws, lds + GAIN_LDS_OFF, layer};
            pg8::gemm_phase<EpiInProjT<true>, pg8::StaticOrder, true, true, true>(lds, g, S, E); }
        SEAM(base + 4);
        if (IN(base + 5) && PHE(5)) phase_attention(c, lds, layer);
        SEAM(base + 5);
        if (IN(base + 6) && PHE(6)) for (int rep = 0; rep < REPN(6); ++rep) {
            for (int rg = 0; rg < REPN(8); ++rg) { pg8::Gemm g{(const bf16_t*)H8, WL + WL_GT, T, 3 * D, D / 2}; GateOrder S; S.base.init(T, D, G, cb);
              EpiGateI8 E{GB, SA, (const float*)(c.ws + WS_CTL + CTL_CMAX) + (size_t)layer * CMAX_PER_LAYER + 2 * 5632};
              pg8::gemm_phase<EpiGateI8, GateOrder, true, true, true>(lds, g, S, E); }
            for (int rs = 0; rs < REPN(9); ++rs) { pg8::Gemm g{OA, WL + WL_BR, T, D, 256, (size_t)T * 256 * 2, (size_t)1024 * 256 * 2}; SegOrder S; S.base.init(T, D, G, cb); EpiMergeSeg E{GB, MRG};
              pg8::gemm_phase<EpiMergeSeg, SegOrder, true, true>(lds, g, S, E); }
        }
        SEAM(base + 6);
        if (IN(base + 7) && PHE(7)) { pg8::Gemm g{MRG, WL + WL_OUT, T, D, D}; pg8::StaticOrder S; S.init(T, D, G, cb); EpiResid<true, true> E{XB, XB, 1.0f};
            pg8::gemm_phase<EpiResid<true, true>, pg8::StaticOrder, true, true>(lds, g, S, E); }
        SEAM(base + 7);
        if (IN(base + 8) && PHE(1)) for (int rep = 0; rep < REPN(1); ++rep) phase_norm<true, false, true>(XB, H, H8, SA);
        SEAM(base + 8);
        if (IN(base + 9) && PHE(2)) for (int rep = 0; rep < REPN(2); ++rep) { pg8::Gemm g{(const bf16_t*)H8, WL + WL_GU + (size_t)5632 * 1024, T, 5632, D / 2}; pg8::StaticOrder S; S.init(T, 5632, G, cb);
            EpiSwigluI8 E{ACT, SA, (const float*)(c.ws + WS_CTL + CTL_CMAX) + (size_t)layer * CMAX_PER_LAYER + 5632};
            pg8::gemm_phase<EpiSwigluI8, pg8::StaticOrder, true, true, true>(lds, g, S, E); }
        SEAM(base + 9);
        if (IN(base + 10) && PHE(3)) { pg8::Gemm g{ACT, WL + WL_DN + (size_t)1024 * 2816, T, D, DFF}; RevOrder S; S.init(T, D, G, cb);
            if (LYR() == 1) { EpiResid<true, false> E{XB, c.out, 0.5f}; pg8::gemm_phase<EpiResid<true, false>, RevOrder, true, true>(lds, g, S, E); }
            else { EpiResid<true, true> E{XB, XB, 0.5f}; pg8::gemm_phase<EpiResid<true, true>, RevOrder, true, true>(lds, g, S, E); } }
        SEAM(base + 10);
    }
#undef IN
#undef SEAM
#undef WSL
#undef LYR
#undef OUTL
#undef H8
#undef SA
#undef XB
#undef ACT
#undef MRG
#undef GB
#undef OA
#undef H
}
#define MK_AFTER_PHASE(p) do {} while (0)

extern "C" void kernel_launch(void* const* d_in, const int* in_sizes, int n_in, void* d_out, int out_size, void* d_ws, size_t ws_size, hipStream_t stream) {
    static int grid = 0;
    if (grid == 0) {
        if (n_in != 12 || in_sizes[0] != T * D || out_size != T * D || ws_size < WS_END) {
            fprintf(stderr, "kernel_launch: unexpected shapes (n_in %d, in0 %d, out %d, ws %zu < %zu); nothing launched\n", n_in, n_in > 0 ? in_sizes[0] : -1, out_size, ws_size, (size_t)WS_END); grid = -1; return; }
        int dev = 0, cus = 0, per_cu = 0;
        if (hipGetDevice(&dev) != hipSuccess || hipDeviceGetAttribute(&cus, hipDeviceAttributeMultiprocessorCount, dev) != hipSuccess) { grid = -1; return; }
        if (hipFuncSetAttribute((const void*)hybrid_fwd, hipFuncAttributeMaxDynamicSharedMemorySize, LDS_BYTES) != hipSuccess) { fprintf(stderr, "kernel_launch: hipFuncSetAttribute failed\n"); grid = -1; return; }
        if (hipOccupancyMaxActiveBlocksPerMultiprocessor(&per_cu, (const void*)hybrid_fwd, NTHREADS, LDS_BYTES) != hipSuccess || per_cu < 1)
            fprintf(stderr, "kernel_launch: occupancy query reports %d workgroups per CU\n", per_cu);
        (void)hipGetLastError();
        grid = cus > 0 ? cus : 256;
        if (grid > 256) grid = 256;
    }
    if (grid < 0) return;
    (void)hipMemsetAsync((char*)d_ws + WS_CTL, 0, CTL_BYTES, stream);
    Args a{};
    for (int i = 0; i < 12; ++i) a.in[i] = d_in[i];
    a.out = (float*)d_out; a.ws = (unsigned char*)d_ws;
#if MK_N_LAUNCHES == 1
    a.ph_lo = 0; a.ph_hi = NPHASE;
    hipLaunchKernelGGL(hybrid_fwd, dim3(grid), dim3(NTHREADS), LDS_BYTES, stream, a);
#else
    for (int p = 0; p < NPHASE; ++p) {
        a.ph_lo = p; a.ph_hi = p + 1;
        hipLaunchKernelGGL(hybrid_fwd, dim3(grid), dim3(NTHREADS), LDS_BYTES, stream, a);
        MK_AFTER_PHASE(p);
    }
#endif
}
```

```cpp
#include <hip/hip_runtime.h>
#include <cstdio>
#include <cstdint>
#ifndef MK_N_LAUNCHES
#define MK_N_LAUNCHES 1
#endif
#ifndef MK_CHECKS
#define MK_CHECKS 0
#endif
__device__ __forceinline__ int fresh_tid() { int t = threadIdx.x; asm volatile("" : "+v"(t)); return t; }
#ifndef ATT_MASK
#define ATT_MASK 7
#endif
#ifndef ATT_REP
#define ATT_REP 0
#endif
#ifndef DSA_REP
#define DSA_REP 0
#endif
#ifndef DIFF_REP
#define DIFF_REP 0
#endif
namespace pg8 {
#define PG8_LAS __attribute__((address_space(3)))
typedef unsigned short bf16_t;
typedef short bf16x8 __attribute__((ext_vector_type(8)));
typedef float f32x4 __attribute__((ext_vector_type(4)));
typedef unsigned u32x4 __attribute__((ext_vector_type(4)));
constexpr int BM = 256, BK = 64, HALF = 128, HTB = HALF * BK * 2  , STAGE_BYTES = 8 * HTB, NXCD = 8, WGM = 8;

__host__ __device__ __forceinline__ int lds_byte(int r, int c) { const int st = (r >> 4) * 2 + (c >> 5), rr = r & 15, cc = c & 31, ob = rr * 64 + cc * 2; return st * 1024 + (ob ^ (((ob >> 9) & 1) << 5)); }
__host__ __device__ __forceinline__ void stage_rc(int b, int& R, int& C) { const int st = b / 1024, sb = b % 1024, swz = sb ^ (((sb >> 9) & 1) << 5); R = (st >> 1) * 16 + swz / 64; C = (st & 1) * 32 + (swz % 64) / 2; }
__host__ __device__ __forceinline__ int perm32(int rho) { const int n = rho >> 4, i = rho & 15; return 8 * (i >> 2) + 4 * n + (i & 3); }

struct Unit { int pm, pn, seg; };
struct Gemm { const bf16_t* A; const bf16_t* Bt; int M, N, K; size_t segA = 0, segB = 0; };

struct StaticOrder {
    int nM, nN, nwg, G, c, wgm;
    __host__ __device__ void init(int M, int N, int G_, int c_, int wgm_ = WGM) { nM = M / BM; nN = N / BM; nwg = nM * nN; G = G_; c = c_; wgm = wgm_; }
    __host__ __device__ bool next(int i, Unit& u) const {
        const long L = (long)i * G + c; if (L >= nwg) return false;
        int wgid = (int)L; { const int q = nwg / NXCD, r = nwg % NXCD, xcd = wgid % NXCD, off = wgid / NXCD; wgid = (xcd < r ? xcd * (q + 1) : r * (q + 1) + (xcd - r) * q) + off; }
        const int nig = wgm * nN, gid = wgid / nig, fm = gid * wgm, gsz = (nM - fm) < wgm ? (nM - fm) : wgm;
        u.pm = fm + ((wgid % nig) % gsz); u.pn = (wgid % nig) / gsz; u.seg = 0; return true;
    }
    __device__ __forceinline__ void a_ready(const Unit&) const {}
    __device__ __forceinline__ void done(const Unit&) const {}
};

__device__ __forceinline__ unsigned cvt_pk_bf16(float lo, float hi) { unsigned r; asm volatile("v_cvt_pk_bf16_f32 %0, %1, %2" : "=v"(r) : "v"(lo), "v"(hi)); return r; }
typedef float f32x2 __attribute__((ext_vector_type(2)));
typedef int i32x4 __attribute__((ext_vector_type(4)));
template <bool I8> struct MmaOp;
template <> struct MmaOp<false> { typedef f32x4 acc_t; static __device__ __forceinline__ f32x4 mma(bf16x8 b, bf16x8 a, f32x4 c) { return __builtin_amdgcn_mfma_f32_16x16x32_bf16(b, a, c, 0, 0, 0); } };
template <> struct MmaOp<true>  { typedef i32x4 acc_t; static __device__ __forceinline__ i32x4 mma(bf16x8 b, bf16x8 a, i32x4 c) { return __builtin_amdgcn_mfma_i32_16x16x64_i8(__builtin_bit_cast(i32x4, b), __builtin_bit_cast(i32x4, a), c, 0, 0, 0); } };
template <class Epi> __device__ __forceinline__ auto epi_noepi(const Epi& E, const Unit& u, int) -> decltype(E.noepi(u)) { return E.noepi(u); }
template <class Epi> __device__ __forceinline__ bool epi_noepi(const Epi&, const Unit&, long) { return false; }
template <class Epi, class Sched, bool ALIGN_EPI = false, bool SP2 = false, bool I8 = false>
__device__ __forceinline__ void gemm_phase(PG8_LAS unsigned char* lds, const Gemm g, const Sched& S, const Epi& E) {
    const int tid = fresh_tid(), wid = __builtin_amdgcn_readfirstlane(tid >> 6), lane = tid & 63, wr = wid >> 2, wc = wid & 3, fr = lane & 15, fq = lane >> 4;
    const int K = g.K, nt = K / BK;
    unsigned voffA[2], voffB[2];
#pragma unroll
    for (int i = 0; i < 2; ++i) { int R, C; stage_rc(tid * 16 + i * 8192, R, C); const int Rb = Epi::PERM ? ((R & ~31) + perm32(R & 31)) : R;
        voffA[i] = (unsigned)(R * K + C) * 2u; voffB[i] = (unsigned)(Rb * K + C) * 2u; }
    const size_t kstep = (size_t)(BK * 2);
    const size_t hstep = (size_t)HALF * K * 2;
    const size_t tstep = 2 * hstep;
    const unsigned ldsw = (unsigned)wid * 1024u;
    const int aoff = lds_byte(wr * 64 + fr, fq * 8), boff = lds_byte(wc * 32 + fr, fq * 8);
#define PG8_SA(b, h) (((b) * 2 + (h)) * HTB)
#define PG8_SB(b, h) ((4 + (b) * 2 + (h)) * HTB)
#define PG8_STAGE(bufoff, gbase, voff) do { _Pragma("unroll") for (int _i = 0; _i < 2; ++_i) \
        __builtin_amdgcn_global_load_lds((const unsigned*)((const char*)(gbase) + (voff)[_i]), (PG8_LAS unsigned*)(lds + (bufoff) + ldsw + _i * 8192), 16, 0, 0); } while (0)
#define PG8_LDA(dst, b, h) do { _Pragma("unroll") for (int m = 0; m < 4; ++m) _Pragma("unroll") for (int k = 0; k < 2; ++k) dst[m][k] = *(const PG8_LAS bf16x8*)(lds + PG8_SA(b, h) + aoff + m * 2048 + k * 1024); } while (0)
#define PG8_LDB(dst, b, h) do { _Pragma("unroll") for (int n = 0; n < 2; ++n) _Pragma("unroll") for (int k = 0; k < 2; ++k) dst[n][k] = *(const PG8_LAS bf16x8*)(lds + PG8_SB(b, h) + boff + n * 2048 + k * 1024); } while (0)
#define PG8_MMA(ai, bj, At, Bt) do { __builtin_amdgcn_s_setprio(1); _Pragma("unroll") for (int m = 0; m < 4; ++m) _Pragma("unroll") for (int n = 0; n < 2; ++n) _Pragma("unroll") for (int k = 0; k < 2; ++k) \
        acc[ai][bj][m][n] = MmaOp<I8>::mma(Bt[n][k], At[m][k], acc[ai][bj][m][n]); __builtin_amdgcn_s_setprio(0); } while (0)
#define PG8_WAIT_V(n) asm volatile("s_waitcnt vmcnt(" #n ")" ::: "memory")
#define PG8_WAIT_L(n) asm volatile("s_waitcnt lgkmcnt(" #n ")" ::: "memory")
#define PG8_BAR __builtin_amdgcn_s_barrier()
#define PG8_SCHED __builtin_amdgcn_sched_barrier(0)
    Unit cur, nxt; int ui = 0;
    if (!S.next(0, cur)) return;
    typedef typename MmaOp<I8>::acc_t acc_t;
    acc_t acc[2][2][4][2];
#pragma unroll
    for (int a = 0; a < 2; ++a)
#pragma unroll
        for (int b = 0; b < 2; ++b)
#pragma unroll
            for (int m = 0; m < 4; ++m)
#pragma unroll
                for (int n = 0; n < 2; ++n) acc[a][b][m][n] = acc_t{};
    bf16x8 At[4][2], B0[2][2], B1[2][2];
    const char* cA = (const char*)g.A + (size_t)cur.pm * tstep + (size_t)cur.seg * g.segA; const char* cB = (const char*)g.Bt + (size_t)cur.pn * tstep + (size_t)cur.seg * g.segB;
    S.a_ready(cur);
    if constexpr (SP2) {
        PG8_STAGE(PG8_SB(0, 0), cB, voffB); PG8_STAGE(PG8_SB(0, 1), cB + hstep, voffB); PG8_STAGE(PG8_SA(0, 0), cA, voffA); PG8_STAGE(PG8_SA(0, 1), cA + hstep, voffA);
        if (wr == 1) PG8_BAR;
        PG8_WAIT_V(2); PG8_BAR;
        PG8_STAGE(PG8_SB(1, 0), cB + kstep, voffB); PG8_STAGE(PG8_SA(1, 0), cA + kstep, voffA); PG8_STAGE(PG8_SB(1, 1), cB + hstep + kstep, voffB);
        PG8_WAIT_V(6); PG8_BAR;
    } else {
        PG8_STAGE(PG8_SB(0, 0), cB, voffB); PG8_STAGE(PG8_SA(0, 0), cA, voffA); PG8_STAGE(PG8_SB(0, 1), cB + hstep, voffB); PG8_STAGE(PG8_SA(0, 1), cA + hstep, voffA);
        if (wr == 1) PG8_BAR;
        PG8_WAIT_V(4); PG8_BAR;
        PG8_STAGE(PG8_SB(1, 0), cB + kstep, voffB); PG8_STAGE(PG8_SA(1, 0), cA + kstep, voffA); PG8_STAGE(PG8_SB(1, 1), cB + hstep + kstep, voffB);
        PG8_WAIT_V(6); PG8_BAR;
    }
    for (;;) {
        const bool has_next = S.next(ui + 1, nxt);
        const char* nA = has_next ? (const char*)g.A + (size_t)nxt.pm * tstep + (size_t)nxt.seg * g.segA : cA; const char* nB = has_next ? (const char*)g.Bt + (size_t)nxt.pn * tstep + (size_t)nxt.seg * g.segB : cB;
        for (int t = 0; t < nt; t += 2) {
            const bool last = (t == nt - 2);
            const char* a1 = cA + (size_t)(t + 1) * kstep;
            const char* a2 = last ? nA : cA + (size_t)(t + 2) * kstep; const char* b2 = last ? nB : cB + (size_t)(t + 2) * kstep;
            const char* a3 = a2 + kstep; const char* b3 = b2 + kstep;
            if (last && has_next) S.a_ready(nxt);
            if constexpr (SP2) {
            PG8_LDB(B0, 0, 0); PG8_LDB(B1, 0, 1); PG8_SCHED; PG8_LDA(At, 0, 0); PG8_STAGE(PG8_SA(1, 1), a1 + hstep, voffA);
            PG8_WAIT_V(8); PG8_WAIT_L(0); PG8_BAR; PG8_MMA(0, 0, At, B0); PG8_MMA(0, 1, At, B1); PG8_BAR; PG8_SCHED;
            PG8_LDA(At, 0, 1); PG8_STAGE(PG8_SB(0, 0), b2, voffB); PG8_STAGE(PG8_SB(0, 1), b2 + hstep, voffB); PG8_STAGE(PG8_SA(0, 0), a2, voffA);
            PG8_WAIT_V(8); PG8_WAIT_L(0); PG8_BAR; PG8_MMA(1, 0, At, B0); PG8_MMA(1, 1, At, B1); PG8_BAR; PG8_SCHED;
            PG8_LDB(B0, 1, 0); PG8_LDB(B1, 1, 1); PG8_SCHED; PG8_LDA(At, 1, 0); PG8_STAGE(PG8_SA(0, 1), a2 + hstep, voffA);
            PG8_WAIT_V(8); PG8_WAIT_L(0); PG8_BAR; PG8_MMA(0, 0, At, B0); PG8_MMA(0, 1, At, B1); PG8_BAR; PG8_SCHED;
            PG8_LDA(At, 1, 1); PG8_STAGE(PG8_SB(1, 0), b3, voffB); PG8_STAGE(PG8_SB(1, 1), b3 + hstep, voffB); PG8_STAGE(PG8_SA(1, 0), a3, voffA);
            PG8_WAIT_V(8); PG8_WAIT_L(0); PG8_BAR; PG8_MMA(1, 0, At, B0); PG8_MMA(1, 1, At, B1); PG8_BAR; PG8_SCHED;
            } else {
            PG8_LDB(B0, 0, 0); PG8_SCHED; PG8_LDA(At, 0, 0); PG8_STAGE(PG8_SA(1, 1), a1 + hstep, voffA);
            PG8_WAIT_L(8); PG8_BAR; PG8_WAIT_L(0); PG8_MMA(0, 0, At, B0); PG8_BAR; PG8_SCHED;
            PG8_LDB(B1, 0, 1); PG8_STAGE(PG8_SB(0, 0), b2, voffB);
            PG8_BAR; PG8_WAIT_L(0); PG8_MMA(0, 1, At, B1); PG8_BAR;
            PG8_LDA(At, 0, 1); PG8_STAGE(PG8_SA(0, 0), a2, voffA);
            PG8_BAR; PG8_WAIT_L(0); PG8_MMA(1, 0, At, B0); PG8_BAR; PG8_SCHED;
            PG8_STAGE(PG8_SB(0, 1), b2 + hstep, voffB);
            PG8_WAIT_V(6); PG8_BAR; PG8_MMA(1, 1, At, B1); PG8_BAR;
            PG8_LDB(B0, 1, 0); PG8_SCHED; PG8_LDA(At, 1, 0); PG8_STAGE(PG8_SA(0, 1), a2 + hstep, voffA);
            PG8_WAIT_L(8); PG8_BAR; PG8_WAIT_L(0); PG8_MMA(0, 0, At, B0); PG8_BAR; PG8_SCHED;
            PG8_LDB(B1, 1, 1); PG8_STAGE(PG8_SB(1, 0), b3, voffB);
            PG8_BAR; PG8_WAIT_L(0); PG8_MMA(0, 1, At, B1); PG8_BAR;
            PG8_LDA(At, 1, 1); PG8_STAGE(PG8_SA(1, 0), a3, voffA);
            PG8_BAR; PG8_WAIT_L(0); PG8_MMA(1, 0, At, B0); PG8_BAR; PG8_SCHED;
            PG8_STAGE(PG8_SB(1, 1), b3 + hstep, voffB);
            PG8_WAIT_V(6); PG8_BAR; PG8_MMA(1, 1, At, B1); PG8_BAR;
            }
        }
        const bool noepi = epi_noepi(E, cur, 0);
        if constexpr (ALIGN_EPI) { if (wr == 0 && !noepi) PG8_BAR; }
        if constexpr (!Epi::AFTER_DRAIN) { if (!noepi) E(acc, cur, wr, wc, fr, fq); S.done(cur); }
        if (!has_next) break;
        if (!E.keep(cur)) {
#pragma unroll
        for (int a = 0; a < 2; ++a)
#pragma unroll
            for (int b = 0; b < 2; ++b)
#pragma unroll
                for (int m = 0; m < 4; ++m)
#pragma unroll
                    for (int n = 0; n < 2; ++n) acc[a][b][m][n] = acc_t{};
        }
        cur = nxt; cA = nA; cB = nB; ++ui;
        if constexpr (ALIGN_EPI) { if (wr == 1 && !noepi) PG8_BAR; }
    }
    PG8_WAIT_V(0);
    if constexpr (!ALIGN_EPI) { if (wr == 0) PG8_BAR; }
    PG8_BAR;
    if constexpr (Epi::AFTER_DRAIN) { E.fused(acc, cur, wr, wc, fr, fq, lds, wid, lane); S.done(cur); }
#undef PG8_SA
#undef PG8_SB
#undef PG8_STAGE
#undef PG8_LDA
#undef PG8_LDB
#undef PG8_MMA
#undef PG8_WAIT_V
#undef PG8_WAIT_L
#undef PG8_BAR
#undef PG8_SCHED
}
}

#define LAS __attribute__((address_space(3)))
typedef unsigned short bf16_t;
typedef short bf16x8 __attribute__((ext_vector_type(8)));
typedef float f32x4 __attribute__((ext_vector_type(4)));
typedef float f32x16 __attribute__((ext_vector_type(16)));
typedef unsigned u32x4 __attribute__((ext_vector_type(4)));
typedef unsigned u32x2 __attribute__((ext_vector_type(2)));

constexpr int NB = 16, SEQ = 2048, T = NB * SEQ, D = 1024, DFF = 2816, NIN = 6344, NINP = 3328;
constexpr float EPS = 1e-6f;
constexpr float C2 = 0.125f * 1.4426950408889634f;
constexpr int NWAVES = 8, NTHREADS = 512;
constexpr int NPHASE = 23;

constexpr int CI_QA = 0, CI_KA = 256, CI_VA = 320, CI_QI = 384, CI_KI = 896, CI_WI = 960, CI_QB = 968, CI_KB = 1224, CI_VB = 1480, CI_QC = 1736, CI_KC = 2248, CI_VC = 2760, CI_G = 3272;

constexpr size_t MiB = 1u << 20;
constexpr size_t WS_CTL = 0, CTL_BYTES = 1 * MiB;
constexpr int CW_BAR = 4096;
constexpr size_t CTL_KMEAN = 65536;
constexpr size_t CTL_DIAG = 655360;
constexpr size_t CTL_CMAX = 720896;
constexpr int CMAX_PER_LAYER = 2 * 5632 + 3072 + 3328;
constexpr size_t CTL_SA = 901120;
constexpr size_t WS_ROPE = 1 * MiB;
constexpr size_t WS_W = 3 * MiB;
constexpr size_t WL_GU = 0, WL_DN = 2 * (size_t)5632 * 1024, WL_IN = WL_DN + 2 * (size_t)1024 * 2816, WL_GT = WL_IN + (size_t)NINP * 1024,
                 WL_BR = WL_GT + 3 * (size_t)1024 * 1024, WL_OUT = WL_BR + (size_t)1024 * 1024, WL_END = WL_OUT + (size_t)1024 * 1024;
static_assert(WL_END * 2 * 2 <= 99 * MiB, "weights");
constexpr size_t WS_XB = 102 * MiB;
constexpr size_t DO_H = 0, DO_O = 64 * MiB;
constexpr size_t WS_G = 166 * MiB;
constexpr size_t WS_A = 262 * MiB;
constexpr size_t A_QA = 0, A_KA = 16 * MiB, A_VAT = 20 * MiB, A_QI = 24 * MiB, A_KI = 56 * MiB, A_WI = 60 * MiB, A_QB = 61 * MiB, A_KB = 77 * MiB, A_VBT = 93 * MiB,
                 A_QC = 109 * MiB, A_KC = 141 * MiB, A_VCT = 173 * MiB, A_END = 205 * MiB;
constexpr size_t WS_H8 = WS_A + A_END;
constexpr size_t WS_END = WS_H8 + 32 * MiB;
static_assert(WS_END <= 512 * MiB && CTL_CMAX + 2 * CMAX_PER_LAYER * 4 <= CTL_SA && CTL_SA + (size_t)T * 4 <= CTL_BYTES, "workspace");

#define XB_TMO      128
#define XB_XCNT(j)  (256  + 64 * (j))
#define XB_XSUB(j)  (1280 + 64 * (j))
#define XB_XGEN(j)  (2304 + 64 * (j))
#define XB_TOP      3328
#define XB_TOPGEN   3392
#define XCD_BAR_WORDS 3456
#define XB_SPIN_CAP (1u << 18)
__device__ __forceinline__ unsigned xb_ld(unsigned* p)              { return __hip_atomic_load(p, __ATOMIC_RELAXED, __HIP_MEMORY_SCOPE_AGENT); }
__device__ __forceinline__ unsigned xb_add(unsigned* p, unsigned v) { return __hip_atomic_fetch_add(p, v, __ATOMIC_RELAXED, __HIP_MEMORY_SCOPE_AGENT); }
__device__ __forceinline__ unsigned xb_xcc_id() { return (unsigned)__builtin_amdgcn_s_getreg((3 << 11) | 20) & 0xFu; }
#define XB_SPIN(cond, bar) do { unsigned _sp = 0; while (cond) { __builtin_amdgcn_s_sleep(1); \
    if ((++_sp & 255u) == 0u) { if (xb_ld(&(bar)[XB_TMO])) break; if (_sp > XB_SPIN_CAP) { atomicAdd(&(bar)[XB_TMO], 1u); break; } } } } while (0)
struct XcdBarrier { unsigned* bar; unsigned x; volatile LAS unsigned* st; };
__device__ __forceinline__ XcdBarrier xcd_barrier_post(unsigned* bar, volatile LAS unsigned* st) {
    XcdBarrier b; b.bar = bar; b.x = xb_xcc_id(); b.st = st;
    if (threadIdx.x == 0) (void)xb_add(&bar[XB_XCNT(b.x)], 1u);
    return b;
}
__device__ __forceinline__ void xcd_barrier_complete(unsigned* bar, unsigned x, unsigned& nloc, unsigned& nx) {
    const unsigned G = gridDim.x * gridDim.y * gridDim.z;
    unsigned sum, cnt, mine, sp = 0u;
    for (;;) {
        sum = 0u; cnt = 0u; mine = 0u;
#pragma unroll
        for (unsigned j = 0; j < 16; ++j) { const unsigned c = xb_ld(&bar[XB_XCNT(j)]); sum += c; cnt += (c > 0u) ? 1u : 0u; mine = (j == x) ? c : mine; }
        if (sum == G) break;
        __builtin_amdgcn_s_sleep(1);
        if ((++sp & 255u) == 0u) { if (xb_ld(&bar[XB_TMO])) break; if (sp > XB_SPIN_CAP) { atomicAdd(&bar[XB_TMO], 1u); break; } }
    }
    nloc = mine > 0u ? mine : 1u; nx = cnt > 0u ? cnt : 1u;
}
__device__ __forceinline__ void xcd_barrier(const XcdBarrier& b) {
    asm volatile("s_waitcnt vmcnt(0)" ::: "memory");
    __syncthreads();
    if (threadIdx.x == 0) {
        unsigned* bar = b.bar;
        __builtin_amdgcn_s_waitcnt(0);
        unsigned nloc = b.st[0], nx = b.st[1];
        if (nloc == 0u) { xcd_barrier_complete(bar, b.x, nloc, nx); b.st[0] = nloc; b.st[1] = nx; }
        const unsigned old = xb_add(&bar[XB_XSUB(b.x)], 1u);
        const unsigned gen = old / nloc;
        if (old + 1u == (gen + 1u) * nloc) {
            __builtin_amdgcn_fence(__ATOMIC_RELEASE, "agent");
            asm volatile("s_waitcnt vmcnt(0)" ::: "memory");
            const unsigned og = xb_add(&bar[XB_TOP], 1u);
            const unsigned tg = og / nx;
            if (og + 1u == (tg + 1u) * nx) xb_add(&bar[XB_TOPGEN], 1u);
            else XB_SPIN(xb_ld(&bar[XB_TOPGEN]) == tg, bar);
            __builtin_amdgcn_fence(__ATOMIC_ACQUIRE, "agent");
            xb_add(&bar[XB_XGEN(b.x)], 1u);
            asm volatile("s_waitcnt vmcnt(0)" ::: "memory");
        } else {
            XB_SPIN(xb_ld(&bar[XB_XGEN(b.x)]) == gen, bar);
            __builtin_amdgcn_fence(__ATOMIC_ACQUIRE, "agent");
            asm volatile("s_waitcnt vmcnt(0)" ::: "memory");
        }
    }
    __syncthreads();
}

typedef float f32x2_t __attribute__((ext_vector_type(2))); typedef __bf16 bf16x2_t __attribute__((ext_vector_type(2)));
__device__ __forceinline__ unsigned pk2(float lo, float hi) { f32x2_t v = {lo, hi}; bf16x2_t b = __builtin_convertvector(v, bf16x2_t); return __builtin_bit_cast(unsigned, b); }
__device__ __forceinline__ float bf2f(unsigned short h) { return __uint_as_float((unsigned)h << 16); }
#define RORF_(v, n) __uint_as_float((unsigned)__builtin_amdgcn_update_dpp(0, (int)__float_as_uint(v), 0x120 + (n), 0xf, 0xf, false))
__device__ __forceinline__ float wave_sum(float v) {
    v += RORF_(v, 1); v += RORF_(v, 2); v += RORF_(v, 4); v += RORF_(v, 8);
    { auto r = __builtin_amdgcn_permlane16_swap(__float_as_uint(v), __float_as_uint(v), false, false); v = __uint_as_float(r[0]) + __uint_as_float(r[1]); }
    { auto r = __builtin_amdgcn_permlane32_swap(__float_as_uint(v), __float_as_uint(v), false, false); v = __uint_as_float(r[0]) + __uint_as_float(r[1]); }
    return v;
}
__device__ __forceinline__ float wave_max_f(float v) {
    v = fmaxf(v, RORF_(v, 1)); v = fmaxf(v, RORF_(v, 2)); v = fmaxf(v, RORF_(v, 4)); v = fmaxf(v, RORF_(v, 8));
    { auto r = __builtin_amdgcn_permlane16_swap(__float_as_uint(v), __float_as_uint(v), false, false); v = fmaxf(__uint_as_float(r[0]), __uint_as_float(r[1])); }
    { auto r = __builtin_amdgcn_permlane32_swap(__float_as_uint(v), __float_as_uint(v), false, false); v = fmaxf(__uint_as_float(r[0]), __uint_as_float(r[1])); }
    return v;
}
__device__ __forceinline__ float fast_exp2(float x) { return __builtin_amdgcn_exp2f(x); }
__device__ __forceinline__ float fast_rcp(float x) { return __builtin_amdgcn_rcpf(x); }
__device__ __forceinline__ float sigmoidf_(float x) { return fast_rcp(1.0f + fast_exp2(-1.4426950408889634f * x)); }

struct Ctx {
    const float* x_in; const int* pos; const float* norm_g; const float* w_in; const float* qk_g; const float* lam_p; const float* subln_g;
    const float* w_branch; const float* w_out; const float* w_gate; const float* w_up; const float* w_down;
    float* out; unsigned char* ws;
};
__device__ __forceinline__ bf16_t* wsb(const Ctx& c, size_t off) { return (bf16_t*)(c.ws + off); }
__device__ __forceinline__ bf16_t* wlayer(const Ctx& c, int layer) { return (bf16_t*)(c.ws + WS_W) + (size_t)layer * WL_END; }

struct EpiSwiglu {
    static constexpr bool PERM = true, AFTER_DRAIN = false;
    __device__ __forceinline__ bool keep(const pg8::Unit&) const { return false; }
    bf16_t* O;
    __device__ __forceinline__ void operator()(const f32x4 (&acc)[2][2][4][2], const pg8::Unit& u, int wr, int wc, int fr_in, int fq_in) const {
        int fr = fr_in, fq = fq_in; asm volatile("" : "+v"(fr), "+v"(fq));
        const int row0 = u.pm * 256 + wr * 64 + fr, col = u.pn * 128 + wc * 32 + 8 * fq;
#pragma unroll
        for (int ai = 0; ai < 2; ++ai)
#pragma unroll
            for (int m = 0; m < 4; ++m) {
                float a[8];
#pragma unroll
                for (int n = 0; n < 2; ++n)
#pragma unroll
                    for (int e = 0; e < 4; ++e) { const float g = acc[ai][0][m][n][e], up = acc[ai][1][m][n][e]; a[4 * n + e] = g * sigmoidf_(g) * up; }
                u32x4 w; w.x = pk2(a[0], a[1]); w.y = pk2(a[2], a[3]); w.z = pk2(a[4], a[5]); w.w = pk2(a[6], a[7]);
                *(u32x4*)(O + (size_t)(row0 + ai * 128 + m * 16) * DFF + col) = w;
            }
    }
};
typedef int i32x4 __attribute__((ext_vector_type(4)));
struct EpiSwigluI8 {
    static constexpr bool PERM = true, AFTER_DRAIN = false;
    __device__ __forceinline__ bool keep(const pg8::Unit&) const { return false; }
    bf16_t* O; const float* sa; const float* cmax;
    __device__ __forceinline__ void operator()(const i32x4 (&acc)[2][2][4][2], const pg8::Unit& u, int wr, int wc, int fr_in, int fq_in) const {
        int fr = fr_in, fq = fq_in; asm volatile("" : "+v"(fr), "+v"(fq));
        const int row0 = u.pm * 256 + wr * 64 + fr, col = u.pn * 128 + wc * 32 + 8 * fq, bcol = u.pn * 256 + wc * 32 + 8 * fq;
        float sg[8], su[8];
        { const f32x4 g0 = *(const f32x4*)(cmax + bcol), g1 = *(const f32x4*)(cmax + bcol + 4), u0 = *(const f32x4*)(cmax + bcol + 128), u1 = *(const f32x4*)(cmax + bcol + 132);
#pragma unroll
          for (int k = 0; k < 4; ++k) { sg[k] = g0[k] * (1.0f / 127.0f); sg[4 + k] = g1[k] * (1.0f / 127.0f); su[k] = u0[k] * (1.0f / 127.0f); su[4 + k] = u1[k] * (1.0f / 127.0f); } }
        float sr[8];
#pragma unroll
        for (int s_ = 0; s_ < 8; ++s_) sr[s_] = sa[row0 + (s_ >> 2) * 128 + (s_ & 3) * 16];
#pragma unroll
        for (int ai = 0; ai < 2; ++ai)
#pragma unroll
            for (int m = 0; m < 4; ++m) {
                const float s = sr[ai * 4 + m];
                float a[8];
#pragma unroll
                for (int n = 0; n < 2; ++n)
#pragma unroll
                    for (int e = 0; e < 4; ++e) { const float g = (float)acc[ai][0][m][n][e] * (s * sg[4 * n + e]), up = (float)acc[ai][1][m][n][e] * (s * su[4 * n + e]); a[4 * n + e] = g * sigmoidf_(g) * up; }
                u32x4 w; w.x = pk2(a[0], a[1]); w.y = pk2(a[2], a[3]); w.z = pk2(a[4], a[5]); w.w = pk2(a[6], a[7]);
                *(u32x4*)(O + (size_t)(row0 + ai * 128 + m * 16) * DFF + col) = w;
            }
    }
};
struct EpiGateI8 {
    static constexpr bool PERM = true, AFTER_DRAIN = false;
    __device__ __forceinline__ bool keep(const pg8::Unit&) const { return false; }
    unsigned char* G; const float* sa; const float* cmax;
    __device__ __forceinline__ void operator()(const i32x4 (&acc)[2][2][4][2], const pg8::Unit& u, int wr, int wc, int fr_in, int fq_in) const {
        int fr = fr_in, fq = fq_in; asm volatile("" : "+v"(fr), "+v"(fq));
        const int row0 = u.pm * 256 + wr * 64 + fr, col0 = u.pn * 256 + wc * 32 + 8 * fq;
        float sc[2][8];
#pragma unroll
        for (int bj = 0; bj < 2; ++bj) { const f32x4 c0 = *(const f32x4*)(cmax + col0 + bj * 128), c1 = *(const f32x4*)(cmax + col0 + bj * 128 + 4);
#pragma unroll
            for (int k = 0; k < 4; ++k) { sc[bj][k] = c0[k] * (1.0f / 127.0f); sc[bj][4 + k] = c1[k] * (1.0f / 127.0f); } }
        float sr[8];
#pragma unroll
        for (int s_ = 0; s_ < 8; ++s_) sr[s_] = sa[row0 + (s_ >> 2) * 128 + (s_ & 3) * 16];
#pragma unroll
        for (int ai = 0; ai < 2; ++ai)
#pragma unroll
            for (int m = 0; m < 4; ++m)
#pragma unroll
                for (int bj = 0; bj < 2; ++bj) {
                    const float s = sr[ai * 4 + m];
                    unsigned q[8];
#pragma unroll
                    for (int k = 0; k < 8; ++k) q[k] = (unsigned)__builtin_fmaxf(__builtin_rintf(255.0f * sigmoidf_((float)acc[ai][bj][m][k >> 2][k & 3] * (s * sc[bj][k]))), 1.0f);
                    u32x2 w; w.x = q[0] | (q[1] << 8) | (q[2] << 16) | (q[3] << 24); w.y = q[4] | (q[5] << 8) | (q[6] << 16) | (q[7] << 24);
                    *(u32x2*)(G + (size_t)(row0 + ai * 128 + m * 16) * 3072 + col0 + bj * 128) = w;
                }
    }
};

template <bool IN_BF16, bool OUT_BF16> struct EpiResid {
    static constexpr bool PERM = true, AFTER_DRAIN = false;
    __device__ __forceinline__ bool keep(const pg8::Unit&) const { return false; }
    const void* in; void* out; float alpha;
    __device__ __forceinline__ void operator()(const f32x4 (&acc)[2][2][4][2], const pg8::Unit& u, int wr, int wc, int fr_in, int fq_in) const {
        int fr = fr_in, fq = fq_in; asm volatile("" : "+v"(fr), "+v"(fq));
        const int row0 = u.pm * 256 + wr * 64 + fr, col0 = u.pn * 256 + wc * 32 + 8 * fq;
        constexpr int DEPTH = 4;
#define RS_OFF(s_, bj_) ((size_t)(row0 + ((s_) >> 2) * 128 + ((s_) & 3) * 16) * D + col0 + (bj_) * 128)
        f32x4 bufa[DEPTH][2], bufb[DEPTH][2];
#define RS_LOAD(s_, d_) do { _Pragma("unroll") for (int bj = 0; bj < 2; ++bj) { \
            if (IN_BF16) { bufa[d_][bj] = __builtin_bit_cast(f32x4, *(const u32x4*)((const bf16_t*)in + RS_OFF(s_, bj))); } \
            else { bufa[d_][bj] = *(const f32x4*)((const float*)in + RS_OFF(s_, bj)); bufb[d_][bj] = *(const f32x4*)((const float*)in + RS_OFF(s_, bj) + 4); } } } while (0)
#pragma unroll
        for (int s_ = 0; s_ < DEPTH; ++s_) RS_LOAD(s_, s_);
        asm volatile("" ::: "memory");
#pragma unroll
        for (int s_ = 0; s_ < 8; ++s_) {
            const int ai = s_ >> 2, m = s_ & 3;
#pragma unroll
            for (int bj = 0; bj < 2; ++bj) {
                f32x4 x0, x1;
                if (IN_BF16) { const u32x4 w = __builtin_bit_cast(u32x4, bufa[s_ % DEPTH][bj]);
                    x0 = (f32x4){__uint_as_float(w.x << 16), __uint_as_float(w.x & 0xffff0000u), __uint_as_float(w.y << 16), __uint_as_float(w.y & 0xffff0000u)};
                    x1 = (f32x4){__uint_as_float(w.z << 16), __uint_as_float(w.z & 0xffff0000u), __uint_as_float(w.w << 16), __uint_as_float(w.w & 0xffff0000u)}; }
                else { x0 = bufa[s_ % DEPTH][bj]; x1 = bufb[s_ % DEPTH][bj]; }
                x0 = x0 + alpha * acc[ai][bj][m][0]; x1 = x1 + alpha * acc[ai][bj][m][1];
                if (OUT_BF16) { u32x4 w; w.x = pk2(x0[0], x0[1]); w.y = pk2(x0[2], x0[3]); w.z = pk2(x1[0], x1[1]); w.w = pk2(x1[2], x1[3]); *(u32x4*)((bf16_t*)out + RS_OFF(s_, bj)) = w; }
                else { *(f32x4*)((float*)out + RS_OFF(s_, bj)) = x0; *(f32x4*)((float*)out + RS_OFF(s_, bj) + 4) = x1; }
            }
            asm volatile("" ::: "memory");
            if (s_ + DEPTH < 8) { RS_LOAD(s_ + DEPTH, s_ % DEPTH); asm volatile("" ::: "memory"); }
        }
#undef RS_LOAD
#undef RS_OFF
    }
};
struct EpiGate {
    static constexpr bool PERM = true, AFTER_DRAIN = false;
    __device__ __forceinline__ bool keep(const pg8::Unit&) const { return false; }
    unsigned char* G;
    __device__ __forceinline__ void operator()(const f32x4 (&acc)[2][2][4][2], const pg8::Unit& u, int wr, int wc, int fr_in, int fq_in) const {
        int fr = fr_in, fq = fq_in; asm volatile("" : "+v"(fr), "+v"(fq));
        const int row0 = u.pm * 256 + wr * 64 + fr, col0 = u.pn * 256 + wc * 32 + 8 * fq;
#pragma unroll
        for (int ai = 0; ai < 2; ++ai)
#pragma unroll
            for (int m = 0; m < 4; ++m)
#pragma unroll
                for (int bj = 0; bj < 2; ++bj) {
                    unsigned q[8];
#pragma unroll
                    for (int k = 0; k < 8; ++k) q[k] = (unsigned)__builtin_fmaxf(__builtin_rintf(255.0f * sigmoidf_(acc[ai][bj][m][k >> 2][k & 3])), 1.0f);
                    u32x2 w; w.x = q[0] | (q[1] << 8) | (q[2] << 16) | (q[3] << 24); w.y = q[4] | (q[5] << 8) | (q[6] << 16) | (q[7] << 24);
                    *(u32x2*)(G + (size_t)(row0 + ai * 128 + m * 16) * 3072 + col0 + bj * 128) = w;
                }
    }
};
struct EpiMerge {
    static constexpr bool PERM = true, AFTER_DRAIN = false;
    __device__ __forceinline__ bool keep(const pg8::Unit&) const { return false; }
    const unsigned char* G; bf16_t* Mg; int first;
    __device__ __forceinline__ void operator()(const f32x4 (&acc)[2][2][4][2], const pg8::Unit& u, int wr, int wc, int fr_in, int fq_in) const {
        int fr = fr_in, fq = fq_in; asm volatile("" : "+v"(fr), "+v"(fq));
        const int row0 = u.pm * 256 + wr * 64 + fr, col0 = u.pn * 256 + wc * 32 + 8 * fq;
        constexpr int DEPTH = 4;
        u32x2 gb[DEPTH][2]; u32x4 mb[DEPTH][2];
#define MS_OFF(s_, bj_) ((size_t)(row0 + ((s_) >> 2) * 128 + ((s_) & 3) * 16) * D + col0 + (bj_) * 128)
#define GS_OFF(s_, bj_) ((size_t)(row0 + ((s_) >> 2) * 128 + ((s_) & 3) * 16) * 3072 + col0 + (bj_) * 128)
#pragma unroll
        for (int s_ = 0; s_ < DEPTH; ++s_)
#pragma unroll
            for (int bj = 0; bj < 2; ++bj) { gb[s_][bj] = *(const u32x2*)(G + GS_OFF(s_, bj)); mb[s_][bj] = (u32x4){0u, 0u, 0u, 0u}; if (!first) mb[s_][bj] = *(const u32x4*)(Mg + MS_OFF(s_, bj)); }
        asm volatile("" ::: "memory");
#pragma unroll
        for (int s_ = 0; s_ < 8; ++s_) {
            const int ai = s_ >> 2, m = s_ & 3;
#pragma unroll
            for (int bj = 0; bj < 2; ++bj) {
                const u32x2 g = gb[s_ % DEPTH][bj]; const u32x4 pm_ = mb[s_ % DEPTH][bj];
                float r[8];
#pragma unroll
                for (int k = 0; k < 4; ++k) {
                    const unsigned mw = pm_[k], gw = g[k >> 1] >> (16 * (k & 1));
                    const float a0 = acc[ai][bj][m][k >> 1][(k & 1) * 2], a1 = acc[ai][bj][m][k >> 1][(k & 1) * 2 + 1];
                    r[2 * k] = __uint_as_float(mw << 16) + (float)(gw & 0xffu) * (1.0f / 255.0f) * a0;
                    r[2 * k + 1] = __uint_as_float(mw & 0xffff0000u) + (float)((gw >> 8) & 0xffu) * (1.0f / 255.0f) * a1;
                }
                u32x4 w; w.x = pk2(r[0], r[1]); w.y = pk2(r[2], r[3]); w.z = pk2(r[4], r[5]); w.w = pk2(r[6], r[7]);
                *(u32x4*)(Mg + MS_OFF(s_, bj)) = w;
            }
            asm volatile("" ::: "memory");
            if (s_ + DEPTH < 8) {
#pragma unroll
                for (int bj = 0; bj < 2; ++bj) { gb[s_ % DEPTH][bj] = *(const u32x2*)(G + GS_OFF(s_ + DEPTH, bj)); if (!first) mb[s_ % DEPTH][bj] = *(const u32x4*)(Mg + MS_OFF(s_ + DEPTH, bj)); }
                asm volatile("" ::: "memory");
            }
        }
#undef MS_OFF
#undef GS_OFF
    }
};

struct EpiMergeSeg {
    static constexpr bool PERM = true, AFTER_DRAIN = false;
    const unsigned char* G3; bf16_t* Mg;
    __device__ __forceinline__ bool keep(const pg8::Unit& u) const { return u.seg != 3; }
    __device__ __forceinline__ bool noepi(const pg8::Unit& u) const { return u.seg == 2; }
    __device__ __forceinline__ void operator()(f32x4 (&acc)[2][2][4][2], const pg8::Unit& u, int wr, int wc, int fr_in, int fq_in) const {
        if (u.seg == 2) return;
        int fr = fr_in, fq = fq_in; asm volatile("" : "+v"(fr), "+v"(fq));
        const int row0 = u.pm * 256 + wr * 64 + fr, col0 = u.pn * 256 + wc * 32 + 8 * fq;
        const bool last = u.seg == 3;
        const unsigned char* Gn = G3 + (last ? 2 : u.seg) * 1024;
        const unsigned char* Gd = G3 + (u.seg + 1) * 1024;
        constexpr int DEPTH = 4;
        u32x2 nb[DEPTH][2], db[DEPTH][2];
#define GS_OFF(s_, bj_) ((size_t)(row0 + ((s_) >> 2) * 128 + ((s_) & 3) * 16) * 3072 + col0 + (bj_) * 128)
#define MS_OFF(s_, bj_) ((size_t)(row0 + ((s_) >> 2) * 128 + ((s_) & 3) * 16) * D + col0 + (bj_) * 128)
#pragma unroll
        for (int s_ = 0; s_ < DEPTH; ++s_)
#pragma unroll
            for (int bj = 0; bj < 2; ++bj) { nb[s_][bj] = *(const u32x2*)(Gn + GS_OFF(s_, bj)); db[s_][bj] = (u32x2){0x01010101u, 0x01010101u}; if (!last) db[s_][bj] = *(const u32x2*)(Gd + GS_OFF(s_, bj)); }
        asm volatile("" ::: "memory");
#pragma unroll
        for (int s_ = 0; s_ < 8; ++s_) {
            const int ai = s_ >> 2, m = s_ & 3;
#pragma unroll
            for (int bj = 0; bj < 2; ++bj) {
                const u32x2 gn = nb[s_ % DEPTH][bj], gd = db[s_ % DEPTH][bj];
                float r[8];
#pragma unroll
                for (int k = 0; k < 8; ++k) {
                    const float fn = (float)((gn[k >> 2] >> (8 * (k & 3))) & 0xffu), fd = last ? 255.0f : (float)((gd[k >> 2] >> (8 * (k & 3))) & 0xffu);
                    r[k] = acc[ai][bj][m][k >> 2][k & 3] * (fn * fast_rcp(fd));
                    acc[ai][bj][m][k >> 2][k & 3] = r[k];
                }
                if (last) { u32x4 w; w.x = pk2(r[0], r[1]); w.y = pk2(r[2], r[3]); w.z = pk2(r[4], r[5]); w.w = pk2(r[6], r[7]); *(u32x4*)(Mg + MS_OFF(s_, bj)) = w; }
            }
            asm volatile("" ::: "memory");
            if (s_ + DEPTH < 8) {
#pragma unroll
                for (int bj = 0; bj < 2; ++bj) { nb[s_ % DEPTH][bj] = *(const u32x2*)(Gn + GS_OFF(s_ + DEPTH, bj)); if (!last) db[s_ % DEPTH][bj] = *(const u32x2*)(Gd + GS_OFF(s_ + DEPTH, bj)); }
                asm volatile("" ::: "memory");
            }
        }
#undef GS_OFF
#undef MS_OFF
    }
};
struct SegOrder {
    pg8::StaticOrder base;
    __device__ __forceinline__ bool next(int i, pg8::Unit& u) const { if (!base.next(i >> 2, u)) return false; u.seg = i & 3; return true; }
    __device__ __forceinline__ void a_ready(const pg8::Unit&) const {}
    __device__ __forceinline__ void done(const pg8::Unit&) const {}
};

struct RevOrder {
    pg8::StaticOrder base; int rounds;
    __device__ __forceinline__ void init(int M, int N, int G_, int c_) { base.init(M, N, G_, c_); rounds = (base.nwg - c_ + G_ - 1) / G_; }
    __device__ __forceinline__ bool next(int i, pg8::Unit& u) const { return i < rounds && base.next(rounds - 1 - i, u); }
    __device__ __forceinline__ void a_ready(const pg8::Unit&) const {}
    __device__ __forceinline__ void done(const pg8::Unit&) const {}
};

struct GateOrder {
    pg8::StaticOrder base;
    __device__ __forceinline__ bool next(int i, pg8::Unit& u) const { if (!base.next(i / 3, u)) return false; u.pn += 4 * (i % 3); return true; }
    __device__ __forceinline__ void a_ready(const pg8::Unit&) const {}
    __device__ __forceinline__ void done(const pg8::Unit&) const {}
};

template <bool I8> struct EpiInProjT {
    typedef typename pg8::MmaOp<I8>::acc_t acc_t;
    static constexpr bool PERM = true, AFTER_DRAIN = false;
    __device__ __forceinline__ bool keep(const pg8::Unit&) const { return false; }
    unsigned char* ws;
    const LAS unsigned char* gains_lds;
    int layer;
    __device__ __forceinline__ void operator()(const acc_t (&acc)[2][2][4][2], const pg8::Unit& u, int wr, int wc, int fr_in, int fq_in) const {
        int fr = fr_in, fq = fq_in; asm volatile("" : "+v"(fr), "+v"(fq));
        const int pn = u.pn;
        unsigned char* A = ws + WS_A; const float* rope = (const float*)(ws + WS_ROPE);
        float* kmean = (float*)(ws + WS_CTL + CTL_KMEAN) + (size_t)layer * (16 * 4 * 8 * 2 * 64);
        int kind = 0;
        int ng = -1;
        bool do_rope = false; float scale = 1.0f; bool do_kmean = false;
        bf16_t* dst = nullptr; int pitch = 0, coloff = 0; int vdims = 0, vdimoff = 0;
        if (pn == 0)      { dst = (bf16_t*)(A + A_QA); pitch = 256; coloff = 64 * wc; ng = 0; do_rope = true; scale = C2; }
        else if (pn == 1) {
            if (wc == 0)      { dst = (bf16_t*)(A + A_KA); pitch = 64; coloff = 0; ng = 1; do_rope = true; }
            else if (wc == 1) { kind = 1; dst = (bf16_t*)(A + A_VAT); vdims = 64; vdimoff = 0; }
            else if (wc == 2) { dst = (bf16_t*)(A + A_KI); pitch = 64; coloff = 0; do_rope = true; }
            else              { kind = 2; }
        }
        else if (pn <= 3) { dst = (bf16_t*)(A + A_QI); pitch = 512; coloff = 64 * (4 * (pn - 2) + wc); do_rope = true; }
        else if (pn == 4) { dst = (bf16_t*)(A + A_QB); pitch = 256; coloff = 64 * wc; ng = 2; do_rope = true; scale = C2; }
        else if (pn == 5) { dst = (bf16_t*)(A + A_KB); pitch = 256; coloff = 64 * wc; ng = 3; do_rope = true; do_kmean = true; }
        else if (pn == 6) { kind = 1; dst = (bf16_t*)(A + A_VBT); vdims = 256; vdimoff = 64 * wc; }
        else if (pn <= 8) { dst = (bf16_t*)(A + A_QC); pitch = 512; coloff = 64 * (4 * (pn - 7) + wc); ng = 4; do_rope = true; scale = C2; }
        else if (pn <= 10){ dst = (bf16_t*)(A + A_KC); pitch = 512; coloff = 64 * (4 * (pn - 9) + wc); ng = 5; do_rope = true; }
        else              { kind = 1; dst = (bf16_t*)(A + A_VCT); vdims = 512; vdimoff = 64 * (4 * (pn - 11) + wc); }
        const int row0 = u.pm * 256 + wr * 64 + fr;
        const float* sa = (const float*)(ws + WS_CTL + CTL_SA);
        const LAS float* scp = (const LAS float*)(gains_lds + 1536) + u.pn * 256 + wc * 32 + 8 * fq;
#define IPS(ai_, m_) (sa[row0 + (ai_) * 128 + (m_) * 16])
#define IPSC() float sc_[16]; if (I8) { const LAS float* q_ = scp; asm volatile("" : "+v"(q_)); const f32x4 a_ = *(const LAS f32x4*)q_, b_ = *(const LAS f32x4*)(q_ + 4), c_ = *(const LAS f32x4*)(q_ + 128), d_ = *(const LAS f32x4*)(q_ + 132); \
        _Pragma("unroll") for (int k_ = 0; k_ < 4; ++k_) { sc_[k_] = a_[k_]; sc_[4 + k_] = b_[k_]; sc_[8 + k_] = c_[k_]; sc_[12 + k_] = d_[k_]; } }
#define IPV(ai_, bj_, m_, n_, e_) (I8 ? (float)acc[ai_][bj_][m_][n_][e_] * (rs_ * sc_[8 * (bj_) + 4 * (n_) + (e_)]) : (float)acc[ai_][bj_][m_][n_][e_])
        if (kind == 2) {
            if (fq == 0) {
                float* WI = (float*)(A + A_WI);
#pragma unroll
                for (int ai = 0; ai < 2; ++ai)
#pragma unroll
                    for (int m = 0; m < 4; ++m) { const size_t tok = (size_t)(row0 + ai * 128 + m * 16); const float rs_ = I8 ? IPS(ai, m) : 1.0f; IPSC();
                        *(f32x4*)(WI + tok * 8) = (f32x4){IPV(ai, 0, m, 0, 0), IPV(ai, 0, m, 0, 1), IPV(ai, 0, m, 0, 2), IPV(ai, 0, m, 0, 3)} * 0.04419417382415922f;
                        *(f32x4*)(WI + tok * 8 + 4) = (f32x4){IPV(ai, 0, m, 1, 0), IPV(ai, 0, m, 1, 1), IPV(ai, 0, m, 1, 2), IPV(ai, 0, m, 1, 3)} * 0.04419417382415922f; }
            }
            return;
        }
        if (kind == 1) {
            const int b = u.pm >> 3;
#pragma unroll
            for (int ai = 0; ai < 2; ++ai)
#pragma unroll
                for (int m = 0; m < 4; ++m) {
                    const float rs_ = I8 ? IPS(ai, m) : 1.0f; IPSC();
                    const int s = (row0 + ai * 128 + m * 16) & (SEQ - 1);
                    bf16_t* base = dst + ((size_t)b * vdims + vdimoff + 16 * fq) * SEQ + s;
#pragma unroll
                    for (int bj = 0; bj < 2; ++bj)
#pragma unroll
                        for (int n = 0; n < 2; ++n)
#pragma unroll
                            for (int e = 0; e < 4; e += 2) { const unsigned w = pk2(IPV(ai, bj, m, n, e), IPV(ai, bj, m, n, e + 1));
                                base[(size_t)(8 * bj + 4 * n + e) * SEQ] = (bf16_t)(w & 0xffffu); base[(size_t)(8 * bj + 4 * n + e + 1) * SEQ] = (bf16_t)(w >> 16); }
                }
            return;
        }
        const LAS float* gp = (const LAS float*)gains_lds + (ng >= 0 ? ng : 0) * 64 + 16 * fq;
        float ksum[16];
#pragma unroll
        for (int k = 0; k < 16; ++k) ksum[k] = 0.0f;
        const bool roper = do_rope && fq == 0;
        const unsigned* ropeu = (const unsigned*)rope;
        float rs_n = I8 ? IPS(0, 0) : 1.0f;
        u32x4 rt_n[2];
        if (roper) { const unsigned* rp = ropeu + (size_t)row0 * 8; rt_n[0] = *(const u32x4*)rp; rt_n[1] = *(const u32x4*)(rp + 4); }
#pragma unroll
        for (int sl = 0; sl < 8; ++sl) {
                const int ai = sl >> 2, m = sl & 3;
                const size_t tok = (size_t)(row0 + ai * 128 + m * 16);
                const float rs_ = rs_n;
                const u32x4 t0 = rt_n[0], t1 = rt_n[1];
                if (sl < 7) {
                    const int ai1 = (sl + 1) >> 2, m1 = (sl + 1) & 3;
                    if (I8) rs_n = IPS(ai1, m1);
                    if (roper) { const unsigned* rp = ropeu + (size_t)(row0 + ai1 * 128 + m1 * 16) * 8; rt_n[0] = *(const u32x4*)rp; rt_n[1] = *(const u32x4*)(rp + 4); }
                }
                float v[16];
                if (I8 && ng >= 0) {
                    IPSC();
#pragma unroll
                    for (int bj = 0; bj < 2; ++bj)
#pragma unroll
                        for (int n = 0; n < 2; ++n)
#pragma unroll
                            for (int e = 0; e < 4; ++e) v[8 * bj + 4 * n + e] = (float)acc[ai][bj][m][n][e] * sc_[8 * bj + 4 * n + e];
                } else { IPSC();
#pragma unroll
                for (int bj = 0; bj < 2; ++bj)
#pragma unroll
                    for (int n = 0; n < 2; ++n)
#pragma unroll
                        for (int e = 0; e < 4; ++e) v[8 * bj + 4 * n + e] = IPV(ai, bj, m, n, e); }
                if (ng >= 0) {
                    float ss = 0.0f;
#pragma unroll
                    for (int k = 0; k < 16; ++k) ss += v[k] * v[k];
                    ss += __shfl_xor(ss, 16); ss += __shfl_xor(ss, 32);
                    const float rsq = I8 ? rs_ * rs_ : 1.0f;
                    const float rstd = rsqrtf(ss * rsq * (1.0f / 64.0f) + EPS) * (I8 ? rs_ : 1.0f);
                    const f32x4 g0 = *(const LAS f32x4*)gp, g1 = *(const LAS f32x4*)(gp + 4), g2 = *(const LAS f32x4*)(gp + 8), g3 = *(const LAS f32x4*)(gp + 12);
#pragma unroll
                    for (int k = 0; k < 4; ++k) { v[k] = v[k] * rstd * g0[k]; v[4 + k] = v[4 + k] * rstd * g1[k]; v[8 + k] = v[8 + k] * rstd * g2[k]; v[12 + k] = v[12 + k] * rstd * g3[k]; }
                }
                if (roper) {
#pragma unroll
                    for (int i = 0; i < 8; ++i) { const unsigned cs_ = i < 4 ? t0[i & 3] : t1[i & 3]; const float c = __uint_as_float(cs_ << 16), s = __uint_as_float(cs_ & 0xffff0000u);
                        const float x1 = v[i], x2 = v[8 + i]; v[i] = x1 * c - x2 * s; v[8 + i] = x2 * c + x1 * s; }
                }
                if (do_kmean) {
#pragma unroll
                    for (int k = 0; k < 16; ++k) ksum[k] += v[k];
                }
                bf16_t* p = dst + tok * pitch + coloff + 16 * fq;
                u32x4 w0, w1; w0.x = pk2(v[0], v[1]); w0.y = pk2(v[2], v[3]); w0.z = pk2(v[4], v[5]); w0.w = pk2(v[6], v[7]);
                w1.x = pk2(v[8], v[9]); w1.y = pk2(v[10], v[11]); w1.z = pk2(v[12], v[13]); w1.w = pk2(v[14], v[15]);
                *(u32x4*)p = w0; *(u32x4*)(p + 8) = w1;
            }
        if (do_kmean) {
#pragma unroll
            for (int k = 0; k < 16; ++k) { float s = ksum[k]; s += __shfl_xor(s, 1); s += __shfl_xor(s, 2); s += __shfl_xor(s, 4); s += __shfl_xor(s, 8); ksum[k] = s; }
            if (fr == 0) {
                float* km = kmean + (((size_t)((u.pm >> 3) * 4 + wc) * 8 + (u.pm & 7)) * 2 + wr) * 64 + 16 * fq;
#pragma unroll
                for (int k = 0; k < 16; k += 4) *(f32x4*)(km + k) = (f32x4){ksum[k], ksum[k + 1], ksum[k + 2], ksum[k + 3]};
            }
        }
    }
};
#undef IPV
#undef IPS
#undef IPSC

template <class Map> __device__ __forceinline__ void conv_item(const Map& map, int ld, int K, bf16_t* WT, const float* gk, LAS float* scr, int item, int nblk, int lane) {
    const int kb = item / nblk, nb = item % nblk, k0 = 64 * kb, n0 = 32 * nb;
    typedef const __attribute__((address_space(1))) float* gptr;
    typedef const __attribute__((address_space(1))) f32x4* gptr4;
    const int cg = lane & 7, r8 = lane >> 3;
    const float* src0 = map(n0 + 4 * cg); const bool valid = src0 != nullptr; const gptr src = (gptr)(uintptr_t)(valid ? src0 : map(0));
    f32x4 tv[8];
#pragma unroll
    for (int i = 0; i < 8; ++i) tv[i] = *(gptr4)(src + (size_t)(k0 + r8 + 8 * i) * ld);
#pragma unroll
    for (int i = 0; i < 8; ++i) { const int kk = r8 + 8 * i; f32x4 v = valid ? tv[i] : (f32x4){0.0f, 0.0f, 0.0f, 0.0f}; if (gk) v = v * gk[k0 + kk];
#pragma unroll
        for (int e = 0; e < 4; ++e) scr[kk * 33 + 4 * cg + e] = v[e]; }
    asm volatile("s_waitcnt lgkmcnt(0)" ::: "memory");
    const int c = lane & 7;
#pragma unroll
    for (int j = 0; j < 4; ++j) { const int n = (lane >> 3) + 8 * j; const LAS float* s = scr + (8 * c) * 33 + n;
        u32x4 o; o.x = pk2(s[0 * 33], s[1 * 33]); o.y = pk2(s[2 * 33], s[3 * 33]); o.z = pk2(s[4 * 33], s[5 * 33]); o.w = pk2(s[6 * 33], s[7 * 33]);
        *(u32x4*)(WT + (size_t)(n0 + n) * K + k0 + 8 * c) = o; }
    asm volatile("s_waitcnt lgkmcnt(0)" ::: "memory");
}
struct MapPlain { const float* W; __device__ __forceinline__ const float* operator()(int n) const { return W + n; } };
struct MapGU { const float* Wg; const float* Wu; __device__ __forceinline__ const float* operator()(int n) const { const int t = n >> 8, w = n & 255;
    const uintptr_t a = (uintptr_t)Wg, d = (uintptr_t)Wu - (uintptr_t)Wg; return (const float*)(a + d * (uintptr_t)(w >> 7)) + t * 128 + (w & 127); } };
struct MapIn { const float* W;
    __device__ __forceinline__ const float* operator()(int n) const {
        const int pn = n >> 8, w = n & 255, bj = w >> 7, wc = (w >> 5) & 3, fq = (w >> 3) & 3, j = w & 7, dim = 16 * fq + 8 * bj + j;
        int base;
        if (pn == 0) base = CI_QA + 64 * wc;
        else if (pn == 1) { if (wc == 0) base = CI_KA; else if (wc == 1) base = CI_VA; else if (wc == 2) base = CI_KI; else { if (dim >= 8) return nullptr; base = CI_WI; } }
        else if (pn <= 3) base = CI_QI + 64 * (4 * (pn - 2) + wc);
        else if (pn == 4) base = CI_QB + 64 * wc;
        else if (pn == 5) base = CI_KB + 64 * wc;
        else if (pn == 6) base = CI_VB + 64 * wc;
        else if (pn <= 8) base = CI_QC + 64 * (4 * (pn - 7) + wc);
        else if (pn <= 10) base = CI_KC + 64 * (4 * (pn - 9) + wc);
        else base = CI_VC + 64 * (4 * (pn - 11) + wc);
        return W + base + dim;
    } };

template <bool G64, class Map> __device__ __forceinline__ void colmax_item(const Map& map, int ld, const float* gk, unsigned* cmax, int item, int nblk, int lane) {
    const int kb = item / nblk, nb = item % nblk, k0 = 64 * kb, n0 = 32 * nb;
    typedef const __attribute__((address_space(1))) float* gptr;
    const float* src0 = map(n0 + (lane & 31)); const bool valid = src0 != nullptr; const gptr src = (gptr)(uintptr_t)(valid ? src0 : map(0));
    float tv[32];
#pragma unroll
    for (int i = 0; i < 32; ++i) { const int kk = 2 * i + (lane >> 5); tv[i] = src[(size_t)(k0 + kk) * ld]; }
    float mx = 0.0f;
#pragma unroll
    for (int i = 0; i < 32; ++i) { const int kk = 2 * i + (lane >> 5); mx = fmaxf(mx, valid ? fabsf(tv[i] * gk[k0 + kk]) : 0.0f); }
    mx = fmaxf(mx, __shfl_xor(mx, 32));
    if (G64) { mx = wave_max_f(mx); if (lane == 0) atomicMax(cmax + (n0 >> 8) * 4 + ((n0 >> 5) & 3), __float_as_uint(mx)); }
    else if (lane < 32) atomicMax(cmax + n0 + lane, __float_as_uint(mx));
}
template <bool G64, class Map> __device__ __forceinline__ void conv_item_i8(const Map& map, int ld, int K, signed char* WT, const float* gk, const float* cmax, LAS float* scr, int item, int nblk, int lane) {
    const int kb = item / nblk, nb = item % nblk, k0 = 64 * kb, n0 = 32 * nb;
    typedef const __attribute__((address_space(1))) float* gptr;
    const float* src0 = map(n0 + (lane & 31)); const bool valid = src0 != nullptr; const gptr src = (gptr)(uintptr_t)(valid ? src0 : map(0));
    const float am = G64 ? cmax[(n0 >> 8) * 4 + ((n0 >> 5) & 3)] : cmax[n0 + (lane & 31)], qs = (valid && am > 0.0f) ? 127.0f / am : 0.0f;
    float tv[32];
#pragma unroll
    for (int i = 0; i < 32; ++i) { const int kk = 2 * i + (lane >> 5); tv[i] = src[(size_t)(k0 + kk) * ld]; }
#pragma unroll
    for (int i = 0; i < 32; ++i) { const int kk = 2 * i + (lane >> 5); scr[kk * 33 + (lane & 31)] = __builtin_rintf(tv[i] * gk[k0 + kk] * qs); }
    asm volatile("s_waitcnt lgkmcnt(0)" ::: "memory");
    const int c = lane & 7;
#pragma unroll
    for (int j = 0; j < 4; ++j) { const int n = (lane >> 3) + 8 * j; const LAS float* s = scr + (8 * c) * 33 + n;
        unsigned b[8];
#pragma unroll
        for (int k = 0; k < 8; ++k) b[k] = (unsigned)(int)s[k * 33] & 0xffu;
        u32x2 o; o.x = b[0] | (b[1] << 8) | (b[2] << 16) | (b[3] << 24); o.y = b[4] | (b[5] << 8) | (b[6] << 16) | (b[7] << 24);
        *(u32x2*)(WT + (size_t)(n0 + n) * K + k0 + 8 * c) = o; }
    asm volatile("s_waitcnt lgkmcnt(0)" ::: "memory");
}
template <int PASS> __device__ __forceinline__ void prologue_i8(const Ctx& c, LAS unsigned char* lds) {
    const int tid = fresh_tid(), lane = tid & 63, wave = __builtin_amdgcn_readfirstlane(tid >> 6);
    LAS float* scr = (LAS float*)(lds + wave * 16384);
    const int gw = blockIdx.x * NWAVES + wave, NGW = gridDim.x * NWAVES;
    constexpr int I_GU = 16 * 176, I_GT3 = 16 * 96, I_IN8 = 16 * 104, PER_LAYER = 2 * I_GU + I_GT3 + I_IN8;
    for (int it = gw; it < 2 * PER_LAYER; it += NGW) {
        const int layer = it / PER_LAYER; int r = it % PER_LAYER;
        bf16_t* WL = wlayer(c, layer);
        const float* ng = c.norm_g + (size_t)layer * 3 * D;
        float* cm = (float*)(c.ws + WS_CTL + CTL_CMAX) + (size_t)layer * CMAX_PER_LAYER;
        if (r < 2 * I_GU) { const int f = r / I_GU; r %= I_GU; const size_t wo = ((size_t)layer * 2 + f) * D * DFF; const MapGU map{c.w_gate + wo, c.w_up + wo};
            if (PASS == 0) colmax_item<false>(map, DFF, ng + (f ? 2 : 0) * D, (unsigned*)cm + f * 5632, r, 176, lane);
            else conv_item_i8<false>(map, DFF, D, (signed char*)(WL + WL_GU + (size_t)f * 5632 * 1024), ng + (f ? 2 : 0) * D, cm + f * 5632, scr, r, 176, lane);
            continue; }
        r -= 2 * I_GU;
        if (r < I_GT3) { const MapPlain map{c.w_in + (size_t)layer * D * NIN + CI_G};
          if (PASS == 0) colmax_item<false>(map, NIN, ng + D, (unsigned*)cm + 2 * 5632, r, 96, lane);
          else conv_item_i8<false>(map, NIN, D, (signed char*)(WL + WL_GT), ng + D, cm + 2 * 5632, scr, r, 96, lane);
          continue; }
        r -= I_GT3;
        { const MapIn map{c.w_in + (size_t)layer * D * NIN};
          if (PASS == 0) colmax_item<false>(map, NIN, ng + D, (unsigned*)cm + 2 * 5632 + 3072, r, 104, lane);
          else conv_item_i8<false>(map, NIN, D, (signed char*)(WL + WL_IN), ng + D, cm + 2 * 5632 + 3072, scr, r, 104, lane); }
    }
}

template <class Map> __device__ __forceinline__ void strip_item_i8(const Map& map, int ld, signed char* WT, const float* gk, float* cmax, LAS unsigned char* lds, int n0, int tid) {
    typedef const __attribute__((address_space(1))) float* gptr;
    typedef const __attribute__((address_space(1))) f32x4* gptr4;
    const int cg = tid & 7, sub = tid >> 3, lane = tid & 63, wave = tid >> 6;
    const float* src0 = map(n0 + 4 * cg); const bool valid = src0 != nullptr; const gptr src = (gptr)(uintptr_t)(valid ? src0 : map(0));
    const gptr gkp = (gptr)(uintptr_t)gk;
    f32x4 v[4][4]; float g[4][4];
#pragma unroll
    for (int i = 0; i < 4; ++i)
#pragma unroll
        for (int j = 0; j < 4; ++j) { const int row = 4 * (sub + 64 * i) + j; v[i][j] = *(gptr4)(src + (size_t)row * ld); g[i][j] = gkp[row]; }
    float mx[4] = {0.0f, 0.0f, 0.0f, 0.0f};
#pragma unroll
    for (int i = 0; i < 4; ++i)
#pragma unroll
        for (int j = 0; j < 4; ++j)
#pragma unroll
            for (int e = 0; e < 4; ++e) { const float x = valid ? v[i][j][e] * g[i][j] : 0.0f; v[i][j][e] = x; mx[e] = fmaxf(mx[e], fabsf(x)); }
    LAS float* red = (LAS float*)lds;
    LAS unsigned* tile = (LAS unsigned*)(lds + 1024);
#pragma unroll
    for (int e = 0; e < 4; ++e) { float m = mx[e]; m = fmaxf(m, __shfl_xor(m, 8)); m = fmaxf(m, __shfl_xor(m, 16)); m = fmaxf(m, __shfl_xor(m, 32)); if (lane < 8) red[wave * 32 + 4 * lane + e] = m; }
    __syncthreads();
    float qs[4];
#pragma unroll
    for (int e = 0; e < 4; ++e) { float am = 0.0f;
#pragma unroll
        for (int w = 0; w < 8; ++w) am = fmaxf(am, red[w * 32 + 4 * cg + e]);
        if (tid < 8) cmax[n0 + 4 * cg + e] = am;
        qs[e] = (valid && am > 0.0f) ? 127.0f / am : 0.0f; }
#pragma unroll
    for (int i = 0; i < 4; ++i)
#pragma unroll
        for (int e = 0; e < 4; ++e) { unsigned b = 0u;
#pragma unroll
            for (int j = 0; j < 4; ++j) b |= ((unsigned)(int)__builtin_rintf(v[i][j][e] * qs[e]) & 0xffu) << (8 * j);
            tile[(4 * cg + e) * 260 + sub + 64 * i] = b; }
    __syncthreads();
    { const int col = tid >> 4, chunk = tid & 15;
#pragma unroll
      for (int m = 0; m < 4; ++m) { const u32x4 w = *(const LAS u32x4*)(tile + col * 260 + 16 * chunk + 4 * m); *(u32x4*)(WT + (size_t)(n0 + col) * 1024 + 64 * chunk + 16 * m) = w; } }
    __syncthreads();
}
__device__ __forceinline__ void prologue_i8_strips(const Ctx& c, LAS unsigned char* lds) {
    const int tid = fresh_tid();
    constexpr int S_GU = 176, S_GT = 96, S_IN = 104, PER_LAYER = 2 * S_GU + S_GT + S_IN;
    for (int it = blockIdx.x; it < 2 * PER_LAYER; it += gridDim.x) {
        const int layer = it / PER_LAYER; int r = it % PER_LAYER;
        bf16_t* WL = wlayer(c, layer);
        const float* ng = c.norm_g + (size_t)layer * 3 * D;
        float* cm = (float*)(c.ws + WS_CTL + CTL_CMAX) + (size_t)layer * CMAX_PER_LAYER;
        if (r < 2 * S_GU) { const int f = r / S_GU; r %= S_GU; const size_t wo = ((size_t)layer * 2 + f) * D * DFF; const MapGU map{c.w_gate + wo, c.w_up + wo};
            strip_item_i8(map, DFF, (signed char*)(WL + WL_GU + (size_t)f * 5632 * 1024), ng + (f ? 2 : 0) * D, cm + f * 5632, lds, 32 * r, tid); continue; }
        r -= 2 * S_GU;
        if (r < S_GT) { const MapPlain map{c.w_in + (size_t)layer * D * NIN + CI_G};
            strip_item_i8(map, NIN, (signed char*)(WL + WL_GT), ng + D, cm + 2 * 5632, lds, 32 * r, tid); continue; }
        r -= S_GT;
        { const MapIn map{c.w_in + (size_t)layer * D * NIN};
          strip_item_i8(map, NIN, (signed char*)(WL + WL_IN), ng + D, cm + 2 * 5632 + 3072, lds, 32 * r, tid); }
    }
}

__device__ __forceinline__ void phase_prologue(const Ctx& c, LAS unsigned char* lds) {
    const int tid = fresh_tid(), lane = tid & 63, wave = __builtin_amdgcn_readfirstlane(tid >> 6);
    LAS float* scr = (LAS float*)(lds + wave * 16384);
    const int gw = blockIdx.x * NWAVES + wave, NGW = gridDim.x * NWAVES;
    constexpr int I_GU = 16 * 176, I_DN = 44 * 32, I_IN = 16 * 104, I_GT = 16 * 32, I_BA = 4 * 32, I_BC = 8 * 32, I_OUT = 16 * 32;
    constexpr int PER_LAYER = 2 * I_DN + 4 * I_BA + I_OUT;
    static_assert(2 * PER_LAYER == 80 * 19 + 176 * 35, "bf16 item deal");
    const bool bal = gridDim.x == 256;
    const int bi_ = (int)blockIdx.x, i0 = bal ? (bi_ < 80 ? 19 * bi_ : 1520 + 35 * (bi_ - 80)) + wave : gw, i1 = bal ? (bi_ < 80 ? 19 * (bi_ + 1) : 1520 + 35 * (bi_ - 79)) : 2 * PER_LAYER, istep = bal ? NWAVES : NGW;
    for (int it = i0; it < i1; it += istep) {
        const int layer = it / PER_LAYER; int r = it % PER_LAYER;
        bf16_t* WL = wlayer(c, layer);
        const float* ng = c.norm_g + (size_t)layer * 3 * D;
        if (r < 2 * I_DN) { const int f = r / I_DN; r %= I_DN; const size_t wo = ((size_t)layer * 2 + f) * D * DFF;
            conv_item(MapPlain{c.w_down + wo}, D, DFF, WL + WL_DN + (size_t)f * 1024 * 2816, nullptr, scr, r, 32, lane); continue; } r -= 2 * I_DN;
        if (r < 4 * I_BA) { const int i = r / I_BA; r %= I_BA; conv_item(MapPlain{c.w_branch + (size_t)layer * D * D + (size_t)i * 256 * D}, D, 256, WL + WL_BR + (size_t)i * 1024 * 256, nullptr, scr, r, 32, lane); continue; } r -= 4 * I_BA;
        conv_item(MapPlain{c.w_out + (size_t)layer * D * D}, D, D, WL + WL_OUT, nullptr, scr, r, 32, lane);
    }
    unsigned* rope = (unsigned*)(c.ws + WS_ROPE);
    for (int idx = blockIdx.x * NTHREADS + tid; idx < T * 8; idx += gridDim.x * NTHREADS) {
        const int tok = idx >> 3, i = idx & 7;
        const float inv = i == 0 ? 1.0f : i == 1 ? 0x1.8d275ep-3f : i == 2 ? 0x1.341190p-5f : i == 3 ? 0x1.ddee9cp-8f : i == 4 ? 0x1.72ba44p-10f : i == 5 ? 0x1.1f91f0p-12f : i == 6 ? 0x1.be2188p-15f : 0x1.5a0f4ep-17f;
        const float ang = (float)c.pos[tok] * inv;
        const double rev = (double)ang * 0.15915494309189535;
        const float fr_ = (float)(rev - __builtin_rint(rev));
        rope[(size_t)tok * 8 + i] = pk2(__builtin_amdgcn_cosf(fr_), __builtin_amdgcn_sinf(fr_));
    }
}

template <bool IN_BF16, bool OUT_BF, bool OUT_I8> __device__ __forceinline__ void phase_norm(const void* xin, bf16_t* h, signed char* h8, float* sa) {
    const int tid = fresh_tid(), lane = tid & 63, wave = tid >> 6;
    const int gw = blockIdx.x * NWAVES + wave, NGW = gridDim.x * NWAVES;
    constexpr int NR = 4;
    for (int row0 = gw; row0 < T; row0 += NR * NGW) {
        float v[NR][16];
#pragma unroll
        for (int k = 0; k < NR; ++k) {
            const int row = min(row0 + k * NGW, T - 1);
            if (IN_BF16) {
                const u32x4* xr = (const u32x4*)((const bf16_t*)xin + (size_t)row * D) + 2 * lane;
                const u32x4 a = xr[0], b = xr[1]; const unsigned w[8] = {a.x, a.y, a.z, a.w, b.x, b.y, b.z, b.w};
#pragma unroll
                for (int j = 0; j < 8; ++j) { v[k][2 * j] = __uint_as_float(w[j] << 16); v[k][2 * j + 1] = __uint_as_float(w[j] & 0xffff0000u); }
            } else {
                const f32x4* xr = (const f32x4*)((const float*)xin + (size_t)row * D) + lane;
#pragma unroll
                for (int j = 0; j < 4; ++j) { const f32x4 t = xr[64 * j]; v[k][4 * j] = t.x; v[k][4 * j + 1] = t.y; v[k][4 * j + 2] = t.z; v[k][4 * j + 3] = t.w; }
            }
        }
#pragma unroll
        for (int k = 0; k < NR; ++k) {
            const int row = row0 + k * NGW;
            if (row >= T) break;
            float s = 0.0f, am = 0.0f;
#pragma unroll
            for (int j = 0; j < 16; ++j) { s += v[k][j] * v[k][j]; am = fmaxf(am, fabsf(v[k][j])); }
            const float rstd = rsqrtf(wave_sum(s) * (1.0f / D) + EPS);
            if (OUT_BF) {
                if (IN_BF16) {
                    u32x4* o = (u32x4*)(h + (size_t)row * D) + 2 * lane;
                    u32x4 a, b; a.x = pk2(v[k][0] * rstd, v[k][1] * rstd); a.y = pk2(v[k][2] * rstd, v[k][3] * rstd); a.z = pk2(v[k][4] * rstd, v[k][5] * rstd); a.w = pk2(v[k][6] * rstd, v[k][7] * rstd);
                    b.x = pk2(v[k][8] * rstd, v[k][9] * rstd); b.y = pk2(v[k][10] * rstd, v[k][11] * rstd); b.z = pk2(v[k][12] * rstd, v[k][13] * rstd); b.w = pk2(v[k][14] * rstd, v[k][15] * rstd);
                    o[0] = a; o[1] = b;
                } else {
                    u32x2* o = (u32x2*)(h + (size_t)row * D) + lane;
#pragma unroll
                    for (int j = 0; j < 4; ++j) { u32x2 w; w.x = pk2(v[k][4 * j] * rstd, v[k][4 * j + 1] * rstd); w.y = pk2(v[k][4 * j + 2] * rstd, v[k][4 * j + 3] * rstd); o[64 * j] = w; }
                }
            }
            if (OUT_I8) {
                am = wave_max_f(am);
                const float qs = am > 0.0f ? 127.0f / am : 0.0f;
                unsigned b[16];
#pragma unroll
                for (int j = 0; j < 16; ++j) b[j] = (unsigned)(int)__builtin_rintf(v[k][j] * qs) & 0xffu;
                if (IN_BF16) { u32x4 w; w.x = b[0] | (b[1] << 8) | (b[2] << 16) | (b[3] << 24); w.y = b[4] | (b[5] << 8) | (b[6] << 16) | (b[7] << 24);
                               w.z = b[8] | (b[9] << 8) | (b[10] << 16) | (b[11] << 24); w.w = b[12] | (b[13] << 8) | (b[14] << 16) | (b[15] << 24);
                               *((u32x4*)(h8 + (size_t)row * D) + lane) = w; }
                else {
#pragma unroll
                    for (int j = 0; j < 4; ++j) *((unsigned*)(h8 + (size_t)row * D) + lane + 64 * j) = b[4 * j] | (b[4 * j + 1] << 8) | (b[4 * j + 2] << 16) | (b[4 * j + 3] << 24); }
                if (lane == 0) sa[row] = rstd * am * (1.0f / 127.0f);
            }
        }
    }
}

namespace att {
constexpr int KP = 144;
constexpr int KT_BYTES = 64 * KP;
constexpr float NEG = -INFINITY;
__device__ __forceinline__ int pi32(int m) { return (m & ~12) | ((m & 8) >> 1) | ((m & 4) << 1); }
__device__ __forceinline__ f32x16 mfma32(bf16x8 a, bf16x8 b, f32x16 c) { return __builtin_amdgcn_mfma_f32_32x32x16_bf16(a, b, c, 0, 0, 0); }

__device__ __forceinline__ void qk_tile(f32x16& p0, f32x16& p1, const LAS unsigned char* Kt, const bf16x8 (&qr)[4], int koff) {
    bf16x8 kf[2][2];
    kf[0][0] = *(const LAS bf16x8*)(Kt + koff); kf[0][1] = *(const LAS bf16x8*)(Kt + koff + 32 * KP);
    const f32x16 z = {0.f, 0.f, 0.f, 0.f, 0.f, 0.f, 0.f, 0.f, 0.f, 0.f, 0.f, 0.f, 0.f, 0.f, 0.f, 0.f};
#pragma unroll
    for (int d0 = 0; d0 < 4; ++d0) {
        if (d0 < 3) { kf[(d0 + 1) & 1][0] = *(const LAS bf16x8*)(Kt + koff + (d0 + 1) * 32); kf[(d0 + 1) & 1][1] = *(const LAS bf16x8*)(Kt + koff + 32 * KP + (d0 + 1) * 32); }
        if (d0 == 0) { p0 = mfma32(kf[0][0], qr[0], z); p1 = mfma32(kf[0][1], qr[0], z); }
        else { p0 = mfma32(kf[d0 & 1][0], qr[d0], p0); p1 = mfma32(kf[d0 & 1][1], qr[d0], p1); }
    }
}
struct SoftState { float mref, l; bool valid; };
constexpr float SM_THR = 6.0f;
template <int NDB, int PMASK> __device__ __forceinline__ void softmax_tile(const f32x16& p0, const f32x16& p1, SoftState& st, f32x16 (&o)[NDB], bf16x8 (&pb)[4], unsigned w0, unsigned w1) {
    float a = __builtin_fmaxf(__builtin_fmaxf(p0[0], p0[1]), p1[0]), b = __builtin_fmaxf(__builtin_fmaxf(p0[2], p0[3]), p1[1]);
    a = __builtin_fmaxf(__builtin_fmaxf(a, p1[2]), p1[3]);
#pragma unroll
    for (int r = 4; r < 16; r += 4) { a = __builtin_fmaxf(__builtin_fmaxf(a, p0[r]), p0[r + 1]); b = __builtin_fmaxf(__builtin_fmaxf(b, p0[r + 2]), p0[r + 3]);
                                      a = __builtin_fmaxf(__builtin_fmaxf(a, p1[r]), p1[r + 1]); b = __builtin_fmaxf(__builtin_fmaxf(b, p1[r + 2]), p1[r + 3]); }
    float rm = __builtin_fmaxf(a, b);
    { auto rr = __builtin_amdgcn_permlane32_swap(__float_as_uint(rm), __float_as_uint(rm), false, false); rm = __builtin_fmaxf(__uint_as_float(rr[0]), __uint_as_float(rr[1])); }
    const bool seen = rm > -1e30f;
    const bool need = (rm - st.mref > SM_THR) || (!st.valid && seen);
    st.valid = st.valid || seen;
    if (__ballot(need) != 0ull) {
        const float mnew = need ? rm : st.mref;
        const float f = fast_exp2(st.mref - mnew);
        st.mref = mnew;
        st.l *= f;
#pragma unroll
        for (int db = 0; db < NDB; ++db)
#pragma unroll
            for (int r = 0; r < 16; ++r) o[db][r] *= f;
    }
    float sum = 0.0f;
    const float mr = (PMASK == 2 && w0 == 0u) ? INFINITY : st.mref;
#pragma unroll
    for (int ks = 0; ks < 4; ++ks) {
        float e[8];
#pragma unroll
        for (int k = 0; k < 8; ++k) {
            const int r = 8 * (ks & 1) + k; const int bit = 16 * (r >> 3) + (r & 7);
            float v = fast_exp2((ks < 2 ? p0[r] : p1[r]) - mr);
            if (PMASK == 1) v = __uint_as_float(__float_as_uint(v) & (unsigned)__builtin_amdgcn_sbfe((int)(ks < 2 ? w0 : w1), bit, 1));
            e[k] = v; sum += v;
        }
        u32x4 w; w.x = pk2(e[0], e[1]); w.y = pk2(e[2], e[3]); w.z = pk2(e[4], e[5]); w.w = pk2(e[6], e[7]);
        pb[ks] = __builtin_bit_cast(bf16x8, w);
    }
    st.l += sum;
}
template <int NDB> __device__ __forceinline__ void pv_tile(f32x16 (&o)[NDB], const bf16x8 (&pb)[4], const LAS unsigned char* Vt, int voff) {
    constexpr int NS = 4 * NDB;
    bf16x8 vf[2][2];
#define VF_LD(s_) (*(const LAS bf16x8*)(Vt + voff + ((s_) % NDB) * 32 * KP + ((s_) / NDB) * 32))
    vf[0][0] = VF_LD(0); vf[0][1] = VF_LD(1);
#pragma unroll
    for (int s_ = 0; s_ < NS; s_ += 2) {
        const int cur = (s_ >> 1) & 1;
        if (s_ + 2 < NS) { vf[cur ^ 1][0] = VF_LD(s_ + 2); vf[cur ^ 1][1] = VF_LD(s_ + 3); }
        o[s_ % NDB] = mfma32(vf[cur][0], pb[s_ / NDB], o[s_ % NDB]);
        o[(s_ + 1) % NDB] = mfma32(vf[cur][1], pb[(s_ + 1) / NDB], o[(s_ + 1) % NDB]);
    }
#undef VF_LD
}
#define LDS_BAR() asm volatile("s_waitcnt lgkmcnt(0)\n\ts_barrier" ::: "memory")
template <int NK, int NV, int PMASK, class MaskF>
__device__ __forceinline__ void flash_run(LAS unsigned char* lds, const bf16_t* const (&ksrc)[NK], size_t ktile, const bf16_t* const (&vsrc)[NV], int NT, int nact, int ksel,
                                          const bf16x8 (&qr)[4], const MaskF& maskf, f32x16 (&o)[2 * NV], float& l_out, int tid, int r32, int hi) {
    constexpr int KB = NK * KT_BYTES, VB = NV * KT_BYTES, VBASE = 2 * KB;
    const int srow = tid >> 3, sch = tid & 7, sdst = srow * KP + sch * 16;
    const int koff = pi32(r32) * KP + hi * 16 + ksel * KT_BYTES, voff = r32 * KP + hi * 16;
    u32x4 kreg[2][NK], vreg[2][NV];
#pragma unroll
    for (int i = 0; i < NK; ++i) { kreg[0][i] = *(const u32x4*)ksrc[i]; *(LAS u32x4*)(lds + i * KT_BYTES + sdst) = kreg[0][i]; }
    if (NT > 1) {
#pragma unroll
        for (int i = 0; i < NK; ++i) { kreg[0][i] = *(const u32x4*)(ksrc[i] + ktile); *(LAS u32x4*)(lds + KB + i * KT_BYTES + sdst) = kreg[0][i]; } }
#pragma unroll
    for (int i = 0; i < NV; ++i) { vreg[0][i] = *(const u32x4*)vsrc[i]; *(LAS u32x4*)(lds + VBASE + i * KT_BYTES + sdst) = vreg[0][i]; }
    if (NT > 2) {
#pragma unroll
        for (int i = 0; i < NK; ++i) kreg[1][i] = *(const u32x4*)(ksrc[i] + 2 * ktile); }
    if (NT > 1) {
#pragma unroll
        for (int i = 0; i < NV; ++i) vreg[1][i] = *(const u32x4*)(vsrc[i] + 64); }
    LDS_BAR();
    SoftState st; st.mref = 0.0f; st.l = 0.0f; st.valid = false;
    f32x16 s0, s1, u0, u1;
    if (nact > 0) { qk_tile(s0, s1, lds, qr, koff); maskf.pre(s0, s1, 0); }
#define FLASH_STEP(t, LD, ST, C0, C1, N0, N1) do { \
        if ((t) + 3 < NT) { _Pragma("unroll") for (int i = 0; i < NK; ++i) kreg[LD][i] = *(const u32x4*)(ksrc[i] + (size_t)((t) + 3) * ktile); } \
        if ((t) + 2 < NT) { _Pragma("unroll") for (int i = 0; i < NV; ++i) vreg[LD][i] = *(const u32x4*)(vsrc[i] + ((t) + 2) * 64); } \
        if ((t) < nact) { \
            bf16x8 pb[4]; unsigned w0 = 0u, w1 = 0u; \
            if (PMASK) maskf.pbits((t), w0, w1); \
            softmax_tile<2 * NV, PMASK>(C0, C1, st, o, pb, w0, w1); \
            if ((t) + 1 < nact) { qk_tile(N0, N1, lds + (((t) + 1) & 1) * KB, qr, koff); maskf.pre(N0, N1, (t) + 1); } \
            pv_tile<2 * NV>(o, pb, lds + VBASE + ((t) & 1) * VB, voff); \
        } \
        if ((t) + 2 < NT) { _Pragma("unroll") for (int i = 0; i < NK; ++i) *(LAS u32x4*)(lds + ((t) & 1) * KB + i * KT_BYTES + sdst) = kreg[ST][i]; } \
        if ((t) + 1 < NT) { _Pragma("unroll") for (int i = 0; i < NV; ++i) *(LAS u32x4*)(lds + VBASE + (((t) + 1) & 1) * VB + i * KT_BYTES + sdst) = vreg[ST][i]; } \
        LDS_BAR(); \
    } while (0)
    int t = 0;
    for (; t + 1 < NT; t += 2) { FLASH_STEP(t, 0, 1, s0, s1, u0, u1); FLASH_STEP(t + 1, 1, 0, u0, u1, s0, s1); }
    if (t < NT) FLASH_STEP(t, 0, 1, s0, s1, u0, u1);
#undef FLASH_STEP
    asm volatile("s_waitcnt vmcnt(0)" ::: "memory");
    l_out = st.l;
}
__device__ __forceinline__ void causal_mask(f32x16& p0, f32x16& p1, int kb, int q, int hi) {
#pragma unroll
    for (int r = 0; r < 16; ++r) { const int key = kb + 16 * (r >> 3) + 8 * hi + (r & 7); if (key > q) p0[r] = NEG; if (key + 32 > q) p1[r] = NEG; }
}
__device__ __forceinline__ void store_pair16(bf16_t* dst, u32x2 a, u32x2 b, int hi) {
    { auto r = __builtin_amdgcn_permlane32_swap(a.x, b.x, false, false); a.x = r[0]; b.x = r[1]; }
    { auto r = __builtin_amdgcn_permlane32_swap(a.y, b.y, false, false); a.y = r[0]; b.y = r[1]; }
    u32x4 w; w.x = a.x; w.y = a.y; w.z = b.x; w.w = b.y;
    *(u32x4*)(dst + 8 * hi) = w;
}
template <int NDB> __device__ __forceinline__ void store_o(const f32x16 (&o)[NDB], float inv, bf16_t* dst, int hi) {
#pragma unroll
    for (int db = 0; db < NDB; ++db)
#pragma unroll
        for (int g = 0; g < 4; g += 2) {
            u32x2 a, b;
            a.x = pk2(o[db][4 * g] * inv, o[db][4 * g + 1] * inv); a.y = pk2(o[db][4 * g + 2] * inv, o[db][4 * g + 3] * inv);
            b.x = pk2(o[db][4 * g + 4] * inv, o[db][4 * g + 5] * inv); b.y = pk2(o[db][4 * g + 6] * inv, o[db][4 * g + 7] * inv);
            store_pair16(dst + 32 * db + 8 * g, a, b, hi);
        }
}

__device__ __forceinline__ void moba_unit(const bf16_t* QB, const bf16_t* KB, const bf16_t* VBT, const float* kmean, bf16_t* OB, LAS unsigned char* lds, int b, int h, int j) {
    const int tid = fresh_tid(), lane = tid & 63, r32 = lane & 31, hi = lane >> 5, wid = __builtin_amdgcn_readfirstlane(tid >> 6);
    const size_t tok0 = (size_t)b * SEQ;
    const int q = 256 * j + 32 * wid + r32;
    bf16x8 qr[4];
    { const bf16_t* qp = QB + (tok0 + q) * 256 + h * 64 + hi * 8;
#pragma unroll
      for (int d0 = 0; d0 < 4; ++d0) qr[d0] = *(const bf16x8*)(qp + d0 * 16); }
    unsigned sel = 0u;
    if (j > 0) {
        if (j <= 3) sel = (1u << j) - 1u;
        else {
            float gate[7];
#pragma unroll
            for (int n = 0; n < 7; ++n) {
                gate[n] = NEG;
                if (n < j) {
                    const float* km = kmean + ((size_t)(b * 4 + h) * 8 + n) * 128 + hi * 8; float s = 0.0f;
#pragma unroll
                    for (int d0 = 0; d0 < 4; ++d0) { const f32x4 a = *(const f32x4*)(km + d0 * 16) + *(const f32x4*)(km + 64 + d0 * 16), c = *(const f32x4*)(km + d0 * 16 + 4) + *(const f32x4*)(km + 64 + d0 * 16 + 4);
#pragma unroll
                        for (int e = 0; e < 4; ++e) { s += bf2f((unsigned short)qr[d0][e]) * a[e]; s += bf2f((unsigned short)qr[d0][4 + e]) * c[e]; } }
                    s += __shfl_xor(s, 32); gate[n] = s;
                }
            }
#pragma unroll
            for (int it = 0; it < 3; ++it) { float best = 0.0f; int bi = -1;
#pragma unroll
                for (int n = 0; n < 7; ++n) { if (n < j && !((sel >> n) & 1u) && (bi < 0 || gate[n] > best)) { best = gate[n]; bi = n; } }
                sel |= 1u << bi; }
        }
    }
    const int NT = 4 * (j + 1);
    const int srow = tid >> 3, sch = tid & 7;
    const bf16_t* const ksrc[1] = {KB + (tok0 + srow) * 256 + h * 64 + sch * 8};
    const bf16_t* const vsrc[1] = {VBT + ((size_t)(b * 4 + h) * 64 + srow) * SEQ + sch * 8};
    f32x16 o[2]; float l = 0.0f;
#pragma unroll
    for (int db = 0; db < 2; ++db)
#pragma unroll
        for (int r = 0; r < 16; ++r) o[db][r] = 0.0f;
    const int qmin = 256 * j + 32 * wid;
    struct MaskMoba { unsigned sel; int j, qmin, q, hi;
        __device__ __forceinline__ void pre(f32x16& p0, f32x16& p1, int t) const { const int kb = 64 * t; if ((t >> 2) >= j && kb + 63 > qmin) causal_mask(p0, p1, kb, q, hi); }
        __device__ __forceinline__ void pbits(int t, unsigned& w0, unsigned& w1) const { const int blk = t >> 2; const unsigned m_ = (blk >= j || ((sel >> blk) & 1u)) ? 0xffffffffu : 0u; w0 = m_; w1 = m_; } };
    const MaskMoba maskf{sel, j, qmin, q, hi};
    flash_run<1, 1, 2>(lds, ksrc, (size_t)64 * 256, vsrc, NT, (qmin + 31) / 64 + 1, 0, qr, maskf, o, l, tid, r32, hi);
    l += __shfl_xor(l, 32);
    store_o<2>(o, 1.0f / l, OB + (tok0 + q) * 256 + h * 64, hi);
}

__device__ __forceinline__ void diff_unit(const bf16_t* QC, const bf16_t* KC, const bf16_t* VCT, bf16_t* OC, LAS unsigned char* lds, int b, int h, int qblk, float lam, float outscale, const float* subg) {
    const int tid = fresh_tid(), lane = tid & 63, r32 = lane & 31, hi = lane >> 5, wid = __builtin_amdgcn_readfirstlane(tid >> 6);
    const int cmp = wid & 1, sub = wid >> 1;
    const size_t tok0 = (size_t)b * SEQ;
    const int q = 128 * qblk + 32 * sub + r32;
    bf16x8 qr[4];
    { const bf16_t* qp = QC + (tok0 + q) * 512 + (2 * h + cmp) * 64 + hi * 8;
#pragma unroll
      for (int d0 = 0; d0 < 4; ++d0) qr[d0] = *(const bf16x8*)(qp + d0 * 16); }
    const int NT = 2 * (qblk + 1);
    const int srow = tid >> 3, sch = tid & 7;
    const bf16_t* const k0p = KC + (tok0 + srow) * 512 + (2 * h) * 64 + sch * 8;
    const bf16_t* const v0p = VCT + ((size_t)(b * 4 + h) * 128 + srow) * SEQ + sch * 8;
    const bf16_t* const ksrc[2] = {k0p, k0p + 64};
    const bf16_t* const vsrc[2] = {v0p, v0p + (size_t)64 * SEQ};
    f32x16 o[4]; float l = 0.0f;
#pragma unroll
    for (int db = 0; db < 4; ++db)
#pragma unroll
        for (int r = 0; r < 16; ++r) o[db][r] = 0.0f;
    const int qmin = 128 * qblk + 32 * sub;
    struct MaskCausal { int qmin, q, hi;
        __device__ __forceinline__ void pre(f32x16& p0, f32x16& p1, int t) const { const int kb = 64 * t; if (kb + 63 > qmin) causal_mask(p0, p1, kb, q, hi); }
        __device__ __forceinline__ void pbits(int, unsigned&, unsigned&) const {} };
    const MaskCausal maskf{qmin, q, hi};
    for (int repd = 0; repd < 1 + (DIFF_REP & 1); ++repd) {
        if (repd) {
#pragma unroll
            for (int db = 0; db < 4; ++db)
#pragma unroll
                for (int r = 0; r < 16; ++r) o[db][r] = 0.0f; }
        flash_run<2, 2, 0>(lds, ksrc, (size_t)64 * 512, vsrc, NT, (qmin + 31) / 64 + 1, cmp, qr, maskf, o, l, tid, r32, hi);
    }
    l += __shfl_xor(l, 32);
    const float inv = 1.0f / l;
    LAS float* xch = (LAS float*)lds + (size_t)sub * 64 * 64 + lane;
    if (cmp == 1) {
#pragma unroll
        for (int db = 0; db < 4; ++db)
#pragma unroll
            for (int r = 0; r < 16; ++r) xch[(db * 16 + r) * 64] = o[db][r] * inv;
    }
    __syncthreads();
    if (cmp == 0) {
        float ss = 0.0f;
#pragma unroll
        for (int db = 0; db < 4; ++db)
#pragma unroll
            for (int r = 0; r < 16; ++r) { const float v = o[db][r] * inv - lam * xch[(db * 16 + r) * 64]; o[db][r] = v; ss += v * v; }
        ss += __shfl_xor(ss, 32);
        const float rstd = rsqrtf(ss * (1.0f / 128.0f) + EPS) * outscale;
        bf16_t* dst = OC + (size_t)(h >> 1) * T * 256 + (tok0 + q) * 256 + (h & 1) * 128;
#pragma unroll
        for (int db = 0; db < 4; ++db)
#pragma unroll
            for (int g = 0; g < 4; g += 2) { const int d = 32 * db + 8 * g + 4 * hi; const f32x4 sg = *(const f32x4*)(subg + d), sh = *(const f32x4*)(subg + d + 8);
                u32x2 a, b; a.x = pk2(o[db][4 * g] * rstd * sg[0], o[db][4 * g + 1] * rstd * sg[1]); a.y = pk2(o[db][4 * g + 2] * rstd * sg[2], o[db][4 * g + 3] * rstd * sg[3]);
                b.x = pk2(o[db][4 * g + 4] * rstd * sh[0], o[db][4 * g + 5] * rstd * sh[1]); b.y = pk2(o[db][4 * g + 6] * rstd * sh[2], o[db][4 * g + 7] * rstd * sh[3]);
                store_pair16(dst + 32 * db + 8 * g, a, b, hi); }
    }
    __syncthreads();
}

__device__ __forceinline__ unsigned f2key(float v) { unsigned b = __float_as_uint(v); if ((b << 1) == 0u) b = 0u; return (b & 0x80000000u) ? ~b : (b | 0x80000000u); }
__device__ __forceinline__ float key2f(unsigned k) { return (k & 0x80000000u) ? __uint_as_float(k & 0x7fffffffu) : __uint_as_float(~k); }
#define ROR_(v, n) ((unsigned)__builtin_amdgcn_update_dpp(0, (int)(v), 0x120 + (n), 0xf, 0xf, false))
__device__ __forceinline__ unsigned wave_max_u32(unsigned v) {
    v = max(v, ROR_(v, 1)); v = max(v, ROR_(v, 2)); v = max(v, ROR_(v, 4)); v = max(v, ROR_(v, 8));
    { auto r = __builtin_amdgcn_permlane16_swap(v, v, false, false); v = max((unsigned)r[0], (unsigned)r[1]); }
    { auto r = __builtin_amdgcn_permlane32_swap(v, v, false, false); v = max((unsigned)r[0], (unsigned)r[1]); }
    return v;
}
__device__ __forceinline__ unsigned wave_min_u32(unsigned v) { return ~wave_max_u32(~v); }
__device__ __forceinline__ unsigned wave_add_u32(unsigned v) {
    v += ROR_(v, 1); v += ROR_(v, 2); v += ROR_(v, 4); v += ROR_(v, 8);
    { auto r = __builtin_amdgcn_permlane16_swap(v, v, false, false); v = (unsigned)r[0] + (unsigned)r[1]; }
    { auto r = __builtin_amdgcn_permlane32_swap(v, v, false, false); v = (unsigned)r[0] + (unsigned)r[1]; }
    return v;
}
__device__ __forceinline__ int count_ge(const unsigned (&u)[32], unsigned thr, int ng) {
    int c = 0;
#pragma unroll
    for (int g = 0; g < 4; ++g) if (g < ng) {
        unsigned long long m0, m1, m2, m3, m4, m5, m6, m7;
        asm("v_cmp_ge_u32_e64 %0, %8, %16\n\tv_cmp_ge_u32_e64 %1, %9, %16\n\tv_cmp_ge_u32_e64 %2, %10, %16\n\tv_cmp_ge_u32_e64 %3, %11, %16\n\t"
            "v_cmp_ge_u32_e64 %4, %12, %16\n\tv_cmp_ge_u32_e64 %5, %13, %16\n\tv_cmp_ge_u32_e64 %6, %14, %16\n\tv_cmp_ge_u32_e64 %7, %15, %16"
            : "=&s"(m0), "=&s"(m1), "=&s"(m2), "=&s"(m3), "=&s"(m4), "=&s"(m5), "=&s"(m6), "=&s"(m7)
            : "v"(u[8 * g]), "v"(u[8 * g + 1]), "v"(u[8 * g + 2]), "v"(u[8 * g + 3]), "v"(u[8 * g + 4]), "v"(u[8 * g + 5]), "v"(u[8 * g + 6]), "v"(u[8 * g + 7]), "v"(thr));
        c += (__popcll(m0) + __popcll(m1)) + (__popcll(m2) + __popcll(m3)) + (__popcll(m4) + __popcll(m5)) + (__popcll(m6) + __popcll(m7));
    }
    return c;
}
__device__ __forceinline__ unsigned pick_mid(unsigned lo, unsigned hi, int clo, int chi, int it) {
    const unsigned span = hi - lo;
    const float flo = key2f(lo << 16), fhi = key2f(((hi - 1u) << 16) | 0xffffu);
    const float fr = (it & 1) ? 0.5f : ((float)(clo - 256) - 0.5f) * fast_rcp((float)(clo - chi));
    unsigned mid = f2key(flo + fr * (fhi - flo)) >> 16;
    if ((it & 1) && it >= 8) mid = lo + (span >> 1);
    if (mid <= lo || mid >= hi) mid = lo + (span >> 1);
    return mid;
}
#define WRITELANE2(lo_, hi_, bal_, i_) asm("s_nop 1\n\tv_writelane_b32 %0, %2, %4\n\tv_writelane_b32 %1, %3, %4" : "+v"(lo_), "+v"(hi_) : "s"((unsigned)(bal_)), "s"((unsigned)((bal_) >> 32)), "n"(i_))
__device__ __forceinline__ void write_mask_row(const unsigned (&u)[32], unsigned thr, int clo, int ng, LAS unsigned* bm, int lane) {
    int wlo = 0, whi = 0;
    if (clo == 256) {
#pragma unroll
        for (int i = 0; i < 32; ++i) { const unsigned long long bal = __ballot(u[i] >= thr); WRITELANE2(wlo, whi, bal, i); }
    } else {
        const int need = 256 - count_ge(u, thr + 1u, ng);
        int run = 0; const unsigned long long below = (1ull << lane) - 1ull;
#pragma unroll
        for (int i = 0; i < 32; ++i) {
            const unsigned long long eq = __ballot(u[i] == thr); const int rank = run + __popcll(eq & below);
            const unsigned long long bal = __ballot(u[i] > thr || (u[i] == thr && rank < need)); run += __popcll(eq);
            WRITELANE2(wlo, whi, bal, i);
        }
    }
    if (lane < 32) { u32x2 w; w.x = (unsigned)wlo; w.y = (unsigned)whi; *(LAS u32x2*)(bm + 2 * lane) = w; }
}
__device__ __forceinline__ void compact_row(const unsigned (&u)[32], unsigned lo, unsigned hi, int ng, LAS unsigned* scr, int lane, unsigned& c0, unsigned& c1) {
    int base = 0;
#pragma unroll
    for (int g = 0; g < 4; ++g) if (g < ng) {
#pragma unroll
        for (int i = 8 * g; i < 8 * g + 8; ++i) {
            const bool inb = u[i] >= lo && u[i] < hi;
            const unsigned long long bal = __ballot(inb);
            const int pos = base + (int)__builtin_amdgcn_mbcnt_hi((unsigned)(bal >> 32), __builtin_amdgcn_mbcnt_lo((unsigned)bal, 0u));
            if (inb) scr[pos] = u[i];
            base += __popcll(bal);
        }
    }
    asm volatile("s_waitcnt lgkmcnt(0)" ::: "memory");
    c0 = lane < base ? scr[lane] : 0u; c1 = 64 + lane < base ? scr[64 + lane] : 0u;
}
__device__ __forceinline__ void select_rows2(const unsigned (&va)[32], const unsigned (&vb)[32], int ta, int tb, LAS unsigned* bma, LAS unsigned* bmb, LAS unsigned* scr, int lane) {
    const int na = ta + 1, nb = tb + 1;
    if (nb <= 256) {
        const int ca = na - 32 * lane, cb = nb - 32 * lane;
        bma[lane] = ca >= 32 ? 0xffffffffu : (ca <= 0 ? 0u : ((1u << ca) - 1u)); bmb[lane] = cb >= 32 ? 0xffffffffu : (cb <= 0 ? 0u : ((1u << cb) - 1u)); return; }
    const int ng = (nb + 511) >> 9;
    unsigned ua[32], ub[32];
    unsigned mxa = 0u, mna = 0xffffffffu, mxb = 0u, mnb = 0xffffffffu;
#pragma unroll
    for (int i = 0; i < 32; ++i) { const bool oka = 64 * i + lane <= ta, okb = 64 * i + lane <= tb; ua[i] = oka ? va[i] : 0u; ub[i] = okb ? vb[i] : 0u;
        mxa = max(mxa, ua[i]); mna = min(mna, oka ? va[i] : 0xffffffffu); mxb = max(mxb, ub[i]); mnb = min(mnb, okb ? vb[i] : 0xffffffffu); }
    mxa = (unsigned)__builtin_amdgcn_readfirstlane((int)wave_max_u32(mxa)); mna = (unsigned)__builtin_amdgcn_readfirstlane((int)wave_min_u32(mna));
    mxb = (unsigned)__builtin_amdgcn_readfirstlane((int)wave_max_u32(mxb)); mnb = (unsigned)__builtin_amdgcn_readfirstlane((int)wave_min_u32(mnb));
    unsigned loa = mna, hia = mxa + 1u, lob = mnb, hib = mxb + 1u;
    int cloa = na, chia = 0, clob = nb, chib = 0;
    bool acta = na > 256, actb = true;
    int it = 0;
    for (; it < 96 && ((acta && cloa - chia > 128) || (actb && clob - chib > 128)); ++it) {
        const unsigned mida = acta ? pick_mid(loa, hia, cloa, chia, it) : loa, midb = actb ? pick_mid(lob, hib, clob, chib, it) : lob;
        int ca = 0, cb = 0;
#pragma unroll
        for (int g = 0; g < 4; ++g) if (g < ng) {
            unsigned long long m0, m1, m2, m3, m4, m5, m6, m7, q0, q1, q2, q3, q4, q5, q6, q7;
            asm("v_cmp_ge_u32_e64 %0, %8, %16\n\tv_cmp_ge_u32_e64 %1, %9, %16\n\tv_cmp_ge_u32_e64 %2, %10, %16\n\tv_cmp_ge_u32_e64 %3, %11, %16\n\t"
                "v_cmp_ge_u32_e64 %4, %12, %16\n\tv_cmp_ge_u32_e64 %5, %13, %16\n\tv_cmp_ge_u32_e64 %6, %14, %16\n\tv_cmp_ge_u32_e64 %7, %15, %16"
                : "=&s"(m0), "=&s"(m1), "=&s"(m2), "=&s"(m3), "=&s"(m4), "=&s"(m5), "=&s"(m6), "=&s"(m7)
                : "v"(ua[8 * g]), "v"(ua[8 * g + 1]), "v"(ua[8 * g + 2]), "v"(ua[8 * g + 3]), "v"(ua[8 * g + 4]), "v"(ua[8 * g + 5]), "v"(ua[8 * g + 6]), "v"(ua[8 * g + 7]), "v"(mida));
            asm("v_cmp_ge_u32_e64 %0, %8, %16\n\tv_cmp_ge_u32_e64 %1, %9, %16\n\tv_cmp_ge_u32_e64 %2, %10, %16\n\tv_cmp_ge_u32_e64 %3, %11, %16\n\t"
                "v_cmp_ge_u32_e64 %4, %12, %16\n\tv_cmp_ge_u32_e64 %5, %13, %16\n\tv_cmp_ge_u32_e64 %6, %14, %16\n\tv_cmp_ge_u32_e64 %7, %15, %16"
                : "=&s"(q0), "=&s"(q1), "=&s"(q2), "=&s"(q3), "=&s"(q4), "=&s"(q5), "=&s"(q6), "=&s"(q7)
                : "v"(ub[8 * g]), "v"(ub[8 * g + 1]), "v"(ub[8 * g + 2]), "v"(ub[8 * g + 3]), "v"(ub[8 * g + 4]), "v"(ub[8 * g + 5]), "v"(ub[8 * g + 6]), "v"(ub[8 * g + 7]), "v"(midb));
            ca += (__popcll(m0) + __popcll(m1)) + (__popcll(m2) + __popcll(m3)) + (__popcll(m4) + __popcll(m5)) + (__popcll(m6) + __popcll(m7));
            cb += (__popcll(q0) + __popcll(q1)) + (__popcll(q2) + __popcll(q3)) + (__popcll(q4) + __popcll(q5)) + (__popcll(q6) + __popcll(q7));
        }
        if (acta) { if (ca >= 256) { loa = mida; cloa = ca; } else { hia = mida; chia = ca; } acta = ca != 256 && hia - loa > 1u; }
        if (actb) { if (cb >= 256) { lob = midb; clob = cb; } else { hib = midb; chib = cb; } actb = cb != 256 && hib - lob > 1u; }
    }
    if (acta || actb) {
        unsigned a0 = 0u, a1 = 0u, b0 = 0u, b1 = 0u;
        const int basea = chia, baseb = chib;
        if (acta) compact_row(ua, loa, hia, ng, scr, lane, a0, a1);
        if (actb) compact_row(ub, lob, hib, ng, scr + 128, lane, b0, b1);
        for (; it < 200 && (acta || actb); ++it) {
            const unsigned mida = acta ? pick_mid(loa, hia, cloa, chia, it) : loa, midb = actb ? pick_mid(lob, hib, clob, chib, it) : lob;
            const int ca = basea + __popcll(__ballot(a0 >= mida)) + __popcll(__ballot(a1 >= mida));
            const int cb = baseb + __popcll(__ballot(b0 >= midb)) + __popcll(__ballot(b1 >= midb));
            if (acta) { if (ca >= 256) { loa = mida; cloa = ca; } else { hia = mida; chia = ca; } acta = ca != 256 && hia - loa > 1u; }
            if (actb) { if (cb >= 256) { lob = midb; clob = cb; } else { hib = midb; chib = cb; } actb = cb != 256 && hib - lob > 1u; }
        }
    }
    if (na <= 256) { const int c = na - 32 * lane; bma[lane] = c >= 32 ? 0xffffffffu : (c <= 0 ? 0u : ((1u << c) - 1u)); }
    else write_mask_row(ua, loa, cloa, ng, bma, lane);
    write_mask_row(ub, lob, clob, ng, bmb, lane);
}

__device__ __forceinline__ void dsa_unit(const bf16_t* QA, const bf16_t* KA, const bf16_t* VAT, const bf16_t* QI, const bf16_t* KI, const float* WI, float* strip, bf16_t* OA,
                                         LAS unsigned char* lds, int b, int qblk) {
    const int tid = fresh_tid(), lane = tid & 63, r32 = lane & 31, hi = lane >> 5, wid = __builtin_amdgcn_readfirstlane(tid >> 6);
    const size_t tok0 = (size_t)b * SEQ;
    constexpr int BM_OFF = 4 * KT_BYTES;
    constexpr int QI_OFF = BM_OFF + 64 * 256, QI_PITCH = 1040, WI_OFF = QI_OFF + 32 * QI_PITCH, SCR_OFF = WI_OFF + 1024;
    LAS unsigned* bm = (LAS unsigned*)(lds + BM_OFF);
    constexpr int SR1_OFF = 0, SR2_OFF = SCR_OFF + 8192, SR_PITCH = 1032;
    static_assert(32 * SR_PITCH <= 4 * KT_BYTES && SR2_OFF + 32 * SR_PITCH <= 131072, "LDS strip segments");
    for (int s = 0; s < 2; ++s) {
        const int qt = 2 * qblk + s;
        {
            { const int row = tid >> 4, ch = tid & 15;
              const u32x4* src = (const u32x4*)(QI + (tok0 + 32 * qt + row) * 512 + ch * 32);
              LAS u32x4* dq = (LAS u32x4*)(lds + QI_OFF + row * QI_PITCH + ch * 64);
              const u32x4 a0 = src[0], a1 = src[1], a2 = src[2], a3 = src[3]; dq[0] = a0; dq[1] = a1; dq[2] = a2; dq[3] = a3; }
            if (tid < 256) { const int row = tid >> 3, hh = tid & 7; ((LAS float*)(lds + WI_OFF))[row * 8 + hh] = WI[(tok0 + 32 * qt + row) * 8 + hh]; }
            __syncthreads();
            const LAS unsigned char* qb = lds + QI_OFF + r32 * QI_PITCH + hi * 16;
            const LAS float* wl = (const LAS float*)(lds + WI_OFF) + r32 * 8;
            for (int rep1 = 0; rep1 < 1 + (DSA_REP & 1); ++rep1) {
            bf16x8 kfn[4];
            if (wid <= qt) {
#pragma unroll
                for (int d0 = 0; d0 < 4; ++d0) kfn[d0] = *(const bf16x8*)(KI + (tok0 + 32 * wid + r32) * 64 + d0 * 16 + hi * 8); }
            for (int kt = wid; kt <= qt; kt += NWAVES) {
                bf16x8 kf[4];
#pragma unroll
                for (int d0 = 0; d0 < 4; ++d0) kf[d0] = kfn[d0];
                if (kt + NWAVES <= qt) {
#pragma unroll
                    for (int d0 = 0; d0 < 4; ++d0) kfn[d0] = *(const bf16x8*)(KI + (tok0 + 32 * (kt + NWAVES) + r32) * 64 + d0 * 16 + hi * 8); }
                f32x16 isc;
#pragma unroll
                for (int r = 0; r < 16; ++r) isc[r] = 0.0f;
#pragma unroll 1
                for (int hh = 0; hh < 8; ++hh) {
                    f32x16 lg;
#pragma unroll
                    for (int r = 0; r < 16; ++r) lg[r] = 0.0f;
#pragma unroll
                    for (int d0 = 0; d0 < 4; ++d0) { const bf16x8 qf = *(const LAS bf16x8*)(qb + hh * 128 + d0 * 32); lg = mfma32(kf[d0], qf, lg); }
                    const float w = wl[hh];
#pragma unroll
                    for (int r = 0; r < 16; ++r) isc[r] += __int_as_float(max(__float_as_int(lg[r]), 0)) * w;
                }
                unsigned short* sp = (unsigned short*)strip + (size_t)r32 * SEQ + 32 * kt + 4 * hi;
                LAS unsigned char* sl = lds + (kt < 16 ? SR1_OFF : SR2_OFF) + r32 * SR_PITCH + (32 * (kt & 15) + 4 * hi) * 2;
#pragma unroll
                for (int g = 0; g < 4; ++g) { u32x2 w;
                    w.x = (f2key(isc[4 * g]) >> 16) | (f2key(isc[4 * g + 1]) & 0xffff0000u); w.y = (f2key(isc[4 * g + 2]) >> 16) | (f2key(isc[4 * g + 3]) & 0xffff0000u);
                    if (kt < 32) *(LAS u32x2*)(sl + 16 * g) = w; else *(u32x2*)(sp + 8 * g) = w; }
            }
            }
        }
        asm volatile("s_waitcnt vmcnt(0)" ::: "memory");
        __syncthreads();
        for (int rep2 = 0; rep2 < 1 + ((DSA_REP >> 1) & 1); ++rep2) {
#pragma unroll 1
            for (int rp = 0; rp < 2; ++rp) {
                unsigned v2[2][32];
#pragma unroll
                for (int rr = 0; rr < 2; ++rr) {
                    const int row = wid + 8 * (2 * rp + rr);
                    const LAS unsigned short* l1 = (const LAS unsigned short*)(lds + SR1_OFF + row * SR_PITCH) + lane;
                    const LAS unsigned short* l2 = (const LAS unsigned short*)(lds + SR2_OFF + row * SR_PITCH) + lane;
                    const unsigned short* gp = (const unsigned short*)strip + (size_t)row * SEQ + lane;
#pragma unroll
                    for (int i = 0; i < 8; ++i) { v2[rr][i] = l1[64 * i]; v2[rr][8 + i] = l2[64 * i]; }
#pragma unroll
                    for (int i = 16; i < 24; ++i) v2[rr][i] = qt >= 32 ? (unsigned)gp[64 * i] : 0u;
#pragma unroll
                    for (int i = 24; i < 32; ++i) v2[rr][i] = qt >= 48 ? (unsigned)gp[64 * i] : 0u;
                }
                { const int ra = wid + 16 * rp, rb = ra + 8; select_rows2(v2[0], v2[1], 32 * qt + ra, 32 * qt + rb, bm + (32 * s + ra) * 64, bm + (32 * s + rb) * 64, (LAS unsigned*)(lds + SCR_OFF) + wid * 256, lane); }
            }
        }
        __syncthreads();
    }
    const int head = wid & 3, sub = wid >> 2;
    const int q = 64 * qblk + 32 * sub + r32;
    bf16x8 qr[4];
    { const bf16_t* qp = QA + (tok0 + q) * 256 + head * 64 + hi * 8;
#pragma unroll
      for (int d0 = 0; d0 < 4; ++d0) qr[d0] = *(const bf16x8*)(qp + d0 * 16); }
    const int NT = qblk + 1;
    const int srow = tid >> 3, sch = tid & 7;
    const bf16_t* const ksrc[1] = {KA + (tok0 + srow) * 64 + sch * 8};
    const bf16_t* const vsrc[1] = {VAT + ((size_t)b * 64 + srow) * SEQ + sch * 8};
    for (int rep3 = 0; rep3 < 1 + ((DSA_REP >> 2) & 1); ++rep3) {
    f32x16 o[2]; float l = 0.0f;
#pragma unroll
    for (int db = 0; db < 2; ++db)
#pragma unroll
        for (int r = 0; r < 16; ++r) o[db][r] = 0.0f;
    const LAS unsigned* bmq = bm + (32 * sub + r32) * 64;
    struct MaskBits { const LAS unsigned* bmq; int hi;
        __device__ __forceinline__ void pre(f32x16&, f32x16&, int) const {}
        __device__ __forceinline__ void pbits(int t, unsigned& w0, unsigned& w1) const { w0 = bmq[2 * t] >> (8 * hi); w1 = bmq[2 * t + 1] >> (8 * hi); } };
    const MaskBits maskf{bmq, hi};
    flash_run<1, 1, 1>(lds, ksrc, (size_t)64 * 64, vsrc, NT, NT, 0, qr, maskf, o, l, tid, r32, hi);
    l += __shfl_xor(l, 32);
    store_o<2>(o, 1.0f / l, OA + (tok0 + q) * 256 + head * 64, hi);
    }
}
}

__device__ __forceinline__ void phase_attention(const Ctx& c, LAS unsigned char* lds, int layer) {
    unsigned char* A = c.ws + WS_A;
    const bf16_t *QA = (const bf16_t*)(A + A_QA), *KA = (const bf16_t*)(A + A_KA), *VAT = (const bf16_t*)(A + A_VAT), *QI = (const bf16_t*)(A + A_QI), *KI = (const bf16_t*)(A + A_KI);
    const float* WI = (const float*)(A + A_WI);
    const bf16_t *QB = (const bf16_t*)(A + A_QB), *KB = (const bf16_t*)(A + A_KB), *VBT = (const bf16_t*)(A + A_VBT), *QC = (const bf16_t*)(A + A_QC), *KC = (const bf16_t*)(A + A_KC), *VCT = (const bf16_t*)(A + A_VCT);
    bf16_t *OA = (bf16_t*)((unsigned char*)c.out + DO_O), *OB = OA + (size_t)T * 256, *OC = OB + (size_t)T * 256;
    const float* kmean = (const float*)(c.ws + WS_CTL + CTL_KMEAN) + (size_t)layer * (16 * 4 * 8 * 2 * 64);
    float* strip = (float*)(c.ws + WS_G) + (size_t)blockIdx.x * 32 * SEQ;
    const int GW = gridDim.x, vcu = (GW % 8 == 0) ? ((int)blockIdx.x % 8) * (GW / 8) + (int)blockIdx.x / 8 : (int)blockIdx.x;

    if (ATT_MASK & 1) for (int rep = 0; rep < 1 + (ATT_REP & 1); ++rep) for (int w = vcu; w < 256; w += GW) {
        const int b = w >> 4, p = w & 15;
        for (int k = 0; k < 2; ++k) att::dsa_unit(QA, KA, VAT, QI, KI, WI, strip, OA, lds, b, k ? 31 - p : p);
    }
    if (ATT_MASK & 2) for (int rep = 0; rep < 1 + ((ATT_REP >> 1) & 1); ++rep) for (int w = vcu; w < 256; w += GW) {
        const int b = w >> 4, h = (w >> 2) & 3, jp = w & 3;
        for (int k = 0; k < 2; ++k) att::moba_unit(QB, KB, VBT, kmean, OB, lds, b, h, k ? 7 - jp : jp);
    }
    if (ATT_MASK & 4) {
        const float* lp = c.lam_p + (size_t)layer * 4 * 64; const int lane = fresh_tid() & 63;
        const float s1 = wave_sum(lp[lane] * lp[64 + lane]), s2 = wave_sum(lp[128 + lane] * lp[192 + lane]);
        const float lam_init = 0.8f - 0.6f * expf(-0.3f * (float)layer);
        const float lam = expf(s1) - expf(s2) + lam_init;
        const float* subg = c.subln_g + (size_t)layer * 128;
        for (int rep = 0; rep < 1 + ((ATT_REP >> 2) & 1); ++rep) for (int w = vcu; w < 512; w += GW) {
            const int b = w >> 5, h = (w >> 3) & 3, qp = w & 7;
            for (int k = 0; k < 2; ++k) att::diff_unit(QC, KC, VCT, OC, lds, b, h, k ? 15 - qp : qp, lam, 1.0f - lam_init, subg);
        }
    }
}

constexpr int RING_BYTES = 131072, MISC_OFF = RING_BYTES, GAIN_LDS_OFF = MISC_OFF + 1024, LDS_BYTES = 147456;
struct Args { const void* in[12]; float* out; unsigned char* ws; int ph_lo, ph_hi; };
static_assert(sizeof(Args) == 12 * 8 + 8 + 8 + 8, "Args has no padding");

__global__ void __launch_bounds__(NTHREADS, 2) hybrid_fwd(Args args) {
    extern __shared__ __attribute__((aligned(16))) unsigned char lds_raw[];
    LAS unsigned char* lds = (LAS unsigned char*)lds_raw;
    volatile LAS unsigned* MISC = (volatile LAS unsigned*)(lds + MISC_OFF);
    const int tid = threadIdx.x;
    if (tid < 64) MISC[tid] = 0u;
    __syncthreads();
    Ctx c;
    c.x_in = (const float*)args.in[0]; c.pos = (const int*)args.in[1]; c.norm_g = (const float*)args.in[2]; c.w_in = (const float*)args.in[3]; c.qk_g = (const float*)args.in[4];
    c.lam_p = (const float*)args.in[5]; c.subln_g = (const float*)args.in[6]; c.w_branch = (const float*)args.in[7]; c.w_out = (const float*)args.in[8];
    c.w_gate = (const float*)args.in[9]; c.w_up = (const float*)args.in[10]; c.w_down = (const float*)args.in[11];
    c.out = args.out; c.ws = args.ws;
    const int lo = args.ph_lo, hi = args.ph_hi;
    unsigned* ctl = (unsigned*)(c.ws + WS_CTL);
    XcdBarrier bar; bar.bar = ctl + CW_BAR; bar.x = 0u; bar.st = MISC + 8;
    if (hi - lo > 1) bar = xcd_barrier_post(ctl + CW_BAR, MISC + 8);
#ifndef PH_MASK
#define PH_MASK 0xffu
#endif
#define PHE(id) ((PH_MASK >> (id)) & 1u)
#ifndef IN_WGM
#define IN_WGM 4
#endif
#ifndef GU_WGM
#define GU_WGM 4
#endif
#ifndef REP_MASK
#define REP_MASK 0u
#endif
#define REPN(id) (1 + (int)((REP_MASK >> (id)) & 1u))
#define IN(k) (lo <= (k) && (k) < hi)
#define SEAM(k) do { if (lo <= (k) && (k) + 1 < hi) xcd_barrier(bar); } while (0)
    const int G = gridDim.x, cb = blockIdx.x;
#define LYR() ({ int l_ = layer; asm volatile("" : "+s"(l_)); l_; })
#define WSL() ({ __attribute__((address_space(1))) unsigned char* p_ = (__attribute__((address_space(1))) unsigned char*)c.ws; asm volatile("" : "+s"(p_)); (unsigned char*)p_; })
#define OUTL() ({ __attribute__((address_space(1))) unsigned char* p_ = (__attribute__((address_space(1))) unsigned char*)c.out; asm volatile("" : "+s"(p_)); (unsigned char*)p_; })
#define H8 ((signed char*)(WSL() + WS_H8))
#define SA ((float*)(WSL() + WS_CTL + CTL_SA))
#define XB ((bf16_t*)(WSL() + WS_XB))
#define ACT ((bf16_t*)(WSL() + WS_A))
#define MRG ((bf16_t*)(WSL() + WS_A))
#define GB (WSL() + WS_G)
#define OA ((bf16_t*)(OUTL() + DO_O))
#define H ((bf16_t*)(OUTL() + DO_H))

    if (IN(0) && PHE(0)) for (int rep = 0; rep < REPN(0); ++rep) { phase_prologue(c, lds); __syncthreads(); prologue_i8_strips(c, lds); }
    for (int layer = 0; layer < 2; ++layer) {
        const int base = 1 + 11 * layer;
        bf16_t* WL = wlayer(c, layer);
        if (IN(base + 0) && PHE(1)) for (int rep = 0; rep < REPN(1); ++rep) { if (LYR() == 0) { phase_norm<false, false, true>(c.x_in, H, H8, SA); } else phase_norm<true, false, true>(XB, H, H8, SA); }
        SEAM(base + 0);
        if (IN(base + 1) && PHE(2)) for (int rep = 0; rep < REPN(2); ++rep) { pg8::Gemm g{(const bf16_t*)H8, WL + WL_GU, T, 5632, D / 2}; pg8::StaticOrder S; S.init(T, 5632, G, cb, GU_WGM);
            EpiSwigluI8 E{ACT, SA, (const float*)(c.ws + WS_CTL + CTL_CMAX) + (size_t)layer * CMAX_PER_LAYER};
            pg8::gemm_phase<EpiSwigluI8, pg8::StaticOrder, true, true, true>(lds, g, S, E); }
        SEAM(base + 1);
        if (IN(base + 2) && PHE(3)) { pg8::Gemm g{ACT, WL + WL_DN, T, D, DFF}; RevOrder S; S.init(T, D, G, cb);
            if (LYR() == 0) { EpiResid<false, true> E{c.x_in, XB, 0.5f}; pg8::gemm_phase<EpiResid<false, true>, RevOrder, true, true>(lds, g, S, E); }
            else { EpiResid<true, true> E{XB, XB, 0.5f}; pg8::gemm_phase<EpiResid<true, true>, RevOrder, true, true>(lds, g, S, E); } }
        SEAM(base + 2);
        if (IN(base + 3) && PHE(1)) for (int rep = 0; rep < REPN(1); ++rep) phase_norm<true, false, true>(XB, H, H8, SA);
        SEAM(base + 3);
        if (IN(base + 4) && PHE(4)) for (int rep = 0; rep < REPN(4); ++rep) { pg8::Gemm g{(const bf16_t*)H8, WL + WL_IN, T, NINP, D / 2}; pg8::StaticOrder S; S.init(T, NINP, G, cb, IN_WGM);
            { const int t_ = fresh_tid(); if (t_ < 384) ((LAS float*)(lds + GAIN_LDS_OFF))[t_] = c.qk_g[(size_t)layer * 6 * 64 + t_] * (((t_ >> 6) & 1) ? 1.0f : C2);
              const float* cm_ = (const float*)(WSL() + WS_CTL + CTL_CMAX) + (size_t)layer * CMAX_PER_LAYER + 2 * 5632 + 3072;
              for (int i_ = t_; i_ < NINP; i_ += NTHREADS) ((LAS float*)(lds + GAIN_LDS_OFF + 1536))[i_] = cm_[i_] * (1.0f / 127.0f);
              __syncthreads(); }
            EpiInProjT<true> E{c.ws, lds + GAIN_LDS_OFF, layer};
            pg8::gemm_phase<EpiInProjT<true>, pg8::StaticOrder, true, true, true>(lds, g, S, E); }
        SEAM(base + 4);
        if (IN(base + 5) && PHE(5)) phase_attention(c, lds, layer);
        SEAM(base + 5);
        if (IN(base + 6) && PHE(6)) for (int rep = 0; rep < REPN(6); ++rep) {
            for (int rg = 0; rg < REPN(8); ++rg) { pg8::Gemm g{(const bf16_t*)H8, WL + WL_GT, T, 3 * D, D / 2}; GateOrder S; S.base.init(T, D, G, cb);
              EpiGateI8 E{GB, SA, (const float*)(c.ws + WS_CTL + CTL_CMAX) + (size_t)layer * CMAX_PER_LAYER + 2 * 5632};
              pg8::gemm_phase<EpiGateI8, GateOrder, true, true, true>(lds, g, S, E); }
            for (int rs = 0; rs < REPN(9); ++rs) { pg8::Gemm g{OA, WL + WL_BR, T, D, 256, (size_t)T * 256 * 2, (size_t)1024 * 256 * 2}; SegOrder S; S.base.init(T, D, G, cb); EpiMergeSeg E{GB, MRG};
              pg8::gemm_phase<EpiMergeSeg, SegOrder, true, true>(lds, g, S, E); }
        }
        SEAM(base + 6);
        if (IN(base + 7) && PHE(7)) { pg8::Gemm g{MRG, WL + WL_OUT, T, D, D}; pg8::StaticOrder S; S.init(T, D, G, cb); EpiResid<true, true> E{XB, XB, 1.0f};
            pg8::gemm_phase<EpiResid<true, true>, pg8::StaticOrder, true, true>(lds, g, S, E); }
        SEAM(base + 7);
        if (IN(base + 8) && PHE(1)) for (int rep = 0; rep < REPN(1); ++rep) phase_norm<true, false, true>(XB, H, H8, SA);
        SEAM(base + 8);
        if (IN(base + 9) && PHE(2)) for (int rep = 0; rep < REPN(2); ++rep) { pg8::Gemm g{(const bf16_t*)H8, WL + WL_GU + (size_t)5632 * 1024, T, 5632, D / 2}; pg8::StaticOrder S; S.init(T, 5632, G, cb, GU_WGM);
            EpiSwigluI8 E{ACT, SA, (const float*)(c.ws + WS_CTL + CTL_CMAX) + (size_t)layer * CMAX_PER_LAYER + 5632};
            pg8::gemm_phase<EpiSwigluI8, pg8::StaticOrder, true, true, true>(lds, g, S, E); }
        SEAM(base + 9);
        if (IN(base + 10) && PHE(3)) { pg8::Gemm g{ACT, WL + WL_DN + (size_t)1024 * 2816, T, D, DFF}; RevOrder S; S.init(T, D, G, cb);
            if (LYR() == 1) { EpiResid<true, false> E{XB, c.out, 0.5f}; pg8::gemm_phase<EpiResid<true, false>, RevOrder, true, true>(lds, g, S, E); }
            else { EpiResid<true, true> E{XB, XB, 0.5f}; pg8::gemm_phase<EpiResid<true, true>, RevOrder, true, true>(lds, g, S, E); } }
        SEAM(base + 10);
    }
#undef IN
#undef SEAM
#undef WSL
#undef LYR
#undef OUTL
#undef H8
#undef SA
#undef XB
#undef ACT
#undef MRG
#undef GB
#undef OA
#undef H
}
#define MK_AFTER_PHASE(p) do {} while (0)

extern "C" void kernel_launch(void* const* d_in, const int* in_sizes, int n_in, void* d_out, int out_size, void* d_ws, size_t ws_size, hipStream_t stream) {
    static int grid = 0;
    if (grid == 0) {
        if (n_in != 12 || in_sizes[0] != T * D || out_size != T * D || ws_size < WS_END) {
            fprintf(stderr, "kernel_launch: unexpected shapes (n_in %d, in0 %d, out %d, ws %zu < %zu); nothing launched\n", n_in, n_in > 0 ? in_sizes[0] : -1, out_size, ws_size, (size_t)WS_END); grid = -1; return; }
        int dev = 0, cus = 0, per_cu = 0;
        if (hipGetDevice(&dev) != hipSuccess || hipDeviceGetAttribute(&cus, hipDeviceAttributeMultiprocessorCount, dev) != hipSuccess) { grid = -1; return; }
        if (hipFuncSetAttribute((const void*)hybrid_fwd, hipFuncAttributeMaxDynamicSharedMemorySize, LDS_BYTES) != hipSuccess) { fprintf(stderr, "kernel_launch: hipFuncSetAttribute failed\n"); grid = -1; return; }
        if (hipOccupancyMaxActiveBlocksPerMultiprocessor(&per_cu, (const void*)hybrid_fwd, NTHREADS, LDS_BYTES) != hipSuccess || per_cu < 1)
            fprintf(stderr, "kernel_launch: occupancy query reports %d workgroups per CU\n", per_cu);
        (void)hipGetLastError();
        grid = cus > 0 ? cus : 256;
        if (grid > 256) grid = 256;
    }
    if (grid < 0) return;
    (void)hipMemsetAsync((char*)d_ws + WS_CTL, 0, CTL_BYTES, stream);
    Args a{};
    for (int i = 0; i < 12; ++i) a.in[i] = d_in[i];
    a.out = (float*)d_out; a.ws = (unsigned char*)d_ws;
#if MK_N_LAUNCHES == 1
    a.ph_lo = 0; a.ph_hi = NPHASE;
    hipLaunchKernelGGL(hybrid_fwd, dim3(grid), dim3(NTHREADS), LDS_BYTES, stream, a);
#else
    for (int p = 0; p < NPHASE; ++p) {
        a.ph_lo = p; a.ph_hi = p + 1;
        hipLaunchKernelGGL(hybrid_fwd, dim3(grid), dim3(NTHREADS), LDS_BYTES, stream, a);
        MK_AFTER_PHASE(p);
    }
#endif
}
```
